# Optimizing an MI355X kernel written in HIP

```python
import math
import jax, jax.numpy as jnp
from jax import lax
import numpy as np

D_MODEL = 2048
BATCH = 4
SEQ = 4096
DEPTH = 4

N_MEM = 256
RMS_EPS = 1e-5
CONV_WIDTH = 3
A_WIDTH = D_MODEL // 2
S5_WIDTH = D_MODEL // 2
S5_GROUP = 16
S5_GROUPS = S5_WIDTH // S5_GROUP
S5_STATE = 64
EVEN_IN = 3 * A_WIDTH + S5_WIDTH
HEAD_DIM = 64
N_Q_HEADS = D_MODEL // HEAD_DIM
Q_PER_KV = 8
N_KV_HEADS = N_Q_HEADS // Q_PER_KV
WINDOW = 128
BLOCK = 128
ODD_IN = (N_Q_HEADS + 2 * N_KV_HEADS) * HEAD_DIM
N_BUCKETS = 32
MAX_DISTANCE = 128
X_HEADS = 4
X_HEAD_DIM = D_MODEL // X_HEADS
D_FF = 5632
NEG_INF = -1e30
N_EVEN = (DEPTH + 1) // 2
N_ODD = DEPTH // 2

kernel_name = "hybrid_shortconv_s5_swa_sink_trunk"


def rms_norm(x, g):
    xf = x.astype(jnp.float32)
    y = xf * lax.rsqrt(jnp.mean(xf * xf, axis=-1, keepdims=True) + RMS_EPS)
    return (y * g.astype(jnp.float32)).astype(x.dtype)


def causal_dwconv(u, w):
    L = u.shape[1]
    up = jnp.pad(u, ((0, 0), (CONV_WIDTH - 1, 0), (0, 0)))
    y = up[:, 0:L] * w[0]
    for k in range(1, CONV_WIDTH):
        y = y + up[:, k:k + L] * w[k]
    return y


def t5_causal_bucket(rel):
    max_exact = N_BUCKETS // 2
    n = jnp.maximum(rel, 0)
    nf = jnp.maximum(n, max_exact).astype(jnp.float32)
    large = max_exact + (jnp.log(nf / max_exact) / math.log(MAX_DISTANCE / max_exact)
                         * (N_BUCKETS - max_exact)).astype(jnp.int32)
    large = jnp.minimum(large, N_BUCKETS - 1)
    return jnp.where(n < max_exact, n, large)


def s5_branch(u, a_re, a_im, log_dt, b_re, b_im, c_re, c_im, d, glu_w):
    f32 = jnp.float32
    Bsz, L, _ = u.shape
    ug = u.astype(f32).reshape(Bsz, L, S5_GROUPS, S5_GROUP)
    lam = lax.complex(a_re.astype(f32), a_im.astype(f32))
    dt = jnp.exp(log_dt.astype(f32))[:, None]
    a_bar = jnp.exp(lam * dt)
    b = lax.complex(b_re.astype(f32), b_im.astype(f32))
    b_bar = ((a_bar - 1.0) / lam)[..., None] * b
    bu = jnp.einsum('gph,blgh->blgp', b_bar, ug.astype(jnp.complex64))
    a_elems = jnp.broadcast_to(a_bar, (1, L) + a_bar.shape)

    def combine(e1, e2):
        a1, s1 = e1
        a2, s2 = e2
        return a1 * a2, a2 * s1 + s2

    _, states = lax.associative_scan(combine, (a_elems, bu), axis=1)
    c = lax.complex(c_re.astype(f32), c_im.astype(f32))
    y = jnp.real(jnp.einsum('ghp,blgp->blgh', c, states)) \
        + d.astype(f32).reshape(S5_GROUPS, S5_GROUP) * ug
    yg = jax.nn.gelu(y)
    gate = jnp.einsum('blgh,gho->blgo', yg, glu_w.astype(f32))
    out = yg * jax.nn.sigmoid(gate)
    return out.reshape(Bsz, L, S5_WIDTH).astype(u.dtype)


def conv_ssm_mixer(h, w_in, conv_w, a_re, a_im, log_dt, b_re, b_im, c_re, c_im, d, glu_w, w_out):
    z = h @ w_in
    gate_b, gate_c, xa, u = jnp.split(z, [A_WIDTH, 2 * A_WIDTH, 3 * A_WIDTH], axis=-1)
    ya = gate_b * causal_dwconv(gate_c * xa, conv_w)
    ys = s5_branch(u, a_re, a_im, log_dt, b_re, b_im, c_re, c_im, d, glu_w)
    return jnp.concatenate([ya, ys], axis=-1) @ w_out


def swa_sink_attention(h, w_qkv, b_qkv, sinks, rel_bias, w_out):
    Bsz, L, _ = h.shape
    nblk = L // BLOCK
    z = h @ w_qkv + b_qkv
    q, k, v = jnp.split(z, [N_Q_HEADS * HEAD_DIM, (N_Q_HEADS + N_KV_HEADS) * HEAD_DIM], axis=-1)
    q = q.reshape(Bsz, nblk, BLOCK, N_KV_HEADS, Q_PER_KV, HEAD_DIM)
    k = k.reshape(Bsz, nblk, BLOCK, N_KV_HEADS, HEAD_DIM)
    v = v.reshape(Bsz, nblk, BLOCK, N_KV_HEADS, HEAD_DIM)

    def with_prev(t):
        prev = jnp.pad(t, ((0, 0), (1, 0), (0, 0), (0, 0), (0, 0)))[:, :-1]
        return jnp.concatenate([prev, t], axis=2)

    kb, vb = with_prev(k), with_prev(v)
    s = jnp.einsum('bnqkgd,bnskd->bnkgqs', q, kb).astype(jnp.float32) * (HEAD_DIM ** -0.5)
    qi = jnp.arange(BLOCK, dtype=jnp.int32)[:, None]
    kj = jnp.arange(2 * BLOCK, dtype=jnp.int32)[None, :]
    rel = qi + BLOCK - kj
    bias = rel_bias.astype(jnp.float32)[t5_causal_bucket(rel)]
    bias = jnp.transpose(bias, (2, 0, 1)).reshape(N_KV_HEADS, Q_PER_KV, BLOCK, 2 * BLOCK)
    blk = jnp.arange(nblk, dtype=jnp.int32)[:, None, None]
    valid = (rel >= 0)[None] & (rel < WINDOW)[None] & (blk * BLOCK + kj[None] - BLOCK >= 0)
    s = jnp.where(valid[None, :, None, None], s + bias[None, None], NEG_INF)
    sink = jnp.broadcast_to(sinks.astype(jnp.float32).reshape(N_KV_HEADS, Q_PER_KV)[None, None, :, :, None, None],
                            s.shape[:-1] + (1,))
    p = jax.nn.softmax(jnp.concatenate([s, sink], axis=-1), axis=-1)[..., :-1]
    o = jnp.einsum('bnkgqs,bnskd->bnqkgd', p.astype(vb.dtype), vb)
    return o.reshape(Bsz, L, N_Q_HEADS * HEAD_DIM) @ w_out


def memory_cross_attention(h, mem_n, w_q, w_kv, w_o):
    Bsz, L, _ = h.shape
    q = (h @ w_q).reshape(Bsz, L, X_HEADS, X_HEAD_DIM)
    k, v = jnp.split(mem_n @ w_kv, 2, axis=-1)
    k = k.reshape(Bsz, -1, X_HEADS, X_HEAD_DIM)
    v = v.reshape(Bsz, -1, X_HEADS, X_HEAD_DIM)
    s = jnp.einsum('blhd,bmhd->bhlm', q, k).astype(jnp.float32) * (X_HEAD_DIM ** -0.5)
    p = jax.nn.softmax(s, axis=-1).astype(v.dtype)
    o = jnp.einsum('bhlm,bmhd->blhd', p, v).reshape(Bsz, L, D_MODEL)
    return o @ w_o


def conv_gated_mlp(h, w_gate, w_up, conv_w, conv_b, w_down):
    g = causal_dwconv(h @ w_gate, conv_w) + conv_b
    return (jax.nn.silu(g) * (h @ w_up)) @ w_down


def setup_inputs(seed: int = 0) -> dict:
    key = jax.random.key(seed)
    ks = jax.random.split(key, 40)
    f32 = jnp.float32
    D = D_MODEL

    def nrm(k, shape, fan_in):
        return jax.random.normal(k, shape, f32) * (fan_in ** -0.5)

    def gain(k, shape):
        return 1.0 + 0.02 * jax.random.normal(k, shape, f32)

    a_re = -0.5 * jnp.exp(0.05 * jax.random.normal(ks[8], (N_EVEN, S5_GROUPS, S5_STATE), f32))
    a_im = math.pi * jnp.arange(S5_STATE, dtype=f32) + 0.01 * jax.random.normal(ks[9], (N_EVEN, S5_GROUPS, S5_STATE), f32)
    log_dt = jax.random.uniform(ks[10], (N_EVEN, S5_GROUPS), f32, math.log(1e-3), math.log(1e-1))
    return {
        "x": jax.random.normal(ks[0], (BATCH, SEQ, D), f32),
        "mem": jax.random.normal(ks[1], (BATCH, N_MEM, D), f32),
        "norm_mix": gain(ks[2], (DEPTH, D)),
        "norm_xattn": gain(ks[3], (DEPTH, D)),
        "norm_ffn": gain(ks[4], (DEPTH, D)),
        "norm_final": gain(ks[5], (D,)),
        "norm_mem": gain(ks[6], (D,)),
        "rel_bias": 0.5 * jax.random.normal(ks[7], (N_BUCKETS, N_Q_HEADS), f32),
        "ev_w_in": nrm(ks[11], (N_EVEN, D, EVEN_IN), D),
        "ev_conv_w": nrm(ks[12], (N_EVEN, CONV_WIDTH, A_WIDTH), CONV_WIDTH),
        "s5_a_re": a_re,
        "s5_a_im": a_im,
        "s5_log_dt": log_dt,
        "s5_b_re": nrm(ks[13], (N_EVEN, S5_GROUPS, S5_STATE, S5_GROUP), 2 * S5_GROUP),
        "s5_b_im": nrm(ks[14], (N_EVEN, S5_GROUPS, S5_STATE, S5_GROUP), 2 * S5_GROUP),
        "s5_c_re": nrm(ks[15], (N_EVEN, S5_GROUPS, S5_GROUP, S5_STATE), 2 * S5_STATE),
        "s5_c_im": nrm(ks[16], (N_EVEN, S5_GROUPS, S5_GROUP, S5_STATE), 2 * S5_STATE),
        "s5_d": jax.random.normal(ks[17], (N_EVEN, S5_WIDTH), f32),
        "s5_glu_w": nrm(ks[18], (N_EVEN, S5_GROUPS, S5_GROUP, S5_GROUP), S5_GROUP),
        "ev_w_out": nrm(ks[19], (N_EVEN, D, D), D),
        "od_w_qkv": nrm(ks[20], (N_ODD, D, ODD_IN), D),
        "od_b_qkv": 0.02 * jax.random.normal(ks[21], (N_ODD, ODD_IN), f32),
        "od_sinks": jax.random.normal(ks[22], (N_ODD, N_Q_HEADS), f32),
        "od_w_out": nrm(ks[23], (N_ODD, N_Q_HEADS * HEAD_DIM, D), D),
        "xa_w_q": nrm(ks[24], (DEPTH, D, D), D),
        "xa_w_kv": nrm(ks[25], (DEPTH, D, 2 * D), D),
        "xa_w_o": nrm(ks[26], (DEPTH, D, D), D),
        "ff_w_gate": nrm(ks[27], (DEPTH, D, D_FF), D),
        "ff_w_up": nrm(ks[28], (DEPTH, D, D_FF), D),
        "ff_conv_w": nrm(ks[29], (DEPTH, CONV_WIDTH, D_FF), CONV_WIDTH),
        "ff_conv_b": 0.02 * jax.random.normal(ks[30], (DEPTH, D_FF), f32),
        "ff_w_down": nrm(ks[31], (DEPTH, D_FF, D), D_FF),
    }


def reference(x, mem, norm_mix, norm_xattn, norm_ffn, norm_final, norm_mem, rel_bias,
              ev_w_in, ev_conv_w, s5_a_re, s5_a_im, s5_log_dt, s5_b_re, s5_b_im,
              s5_c_re, s5_c_im, s5_d, s5_glu_w, ev_w_out,
              od_w_qkv, od_b_qkv, od_sinks, od_w_out,
              xa_w_q, xa_w_kv, xa_w_o,
              ff_w_gate, ff_w_up, ff_conv_w, ff_conv_b, ff_w_down):
    mem_n = rms_norm(mem, norm_mem)
    h = x
    for l in range(DEPTH):
        i = l // 2
        hn = rms_norm(h, norm_mix[l])
        if l % 2 == 0:
            h = h + conv_ssm_mixer(hn, ev_w_in[i], ev_conv_w[i], s5_a_re[i], s5_a_im[i],
                                   s5_log_dt[i], s5_b_re[i], s5_b_im[i], s5_c_re[i],
                                   s5_c_im[i], s5_d[i], s5_glu_w[i], ev_w_out[i])
        else:
            h = h + swa_sink_attention(hn, od_w_qkv[i], od_b_qkv[i], od_sinks[i], rel_bias, od_w_out[i])
        h = h + memory_cross_attention(rms_norm(h, norm_xattn[l]), mem_n, xa_w_q[l], xa_w_kv[l], xa_w_o[l])
        h = h + conv_gated_mlp(rms_norm(h, norm_ffn[l]), ff_w_gate[l], ff_w_up[l],
                               ff_conv_w[l], ff_conv_b[l], ff_w_down[l])
    return rms_norm(h, norm_final)
```

```cpp
#include <hip/hip_runtime.h>
#include <stdint.h>
#include <stdio.h>

#define LAS __attribute__((address_space(3)))
#define GAS __attribute__((address_space(1)))
typedef unsigned short bf16_t;
typedef short bf16x8 __attribute__((ext_vector_type(8)));
typedef float f32x4 __attribute__((ext_vector_type(4)));
typedef float f32x2 __attribute__((ext_vector_type(2)));
typedef unsigned u32x4 __attribute__((ext_vector_type(4)));
typedef unsigned u32x2 __attribute__((ext_vector_type(2)));
typedef GAS unsigned gu32;

constexpr int D = 2048, NB = 4, L = 4096, M = NB * L, NMEM = 256, MROWS = NB * NMEM;
constexpr int AW = 1024, S5G = 64, EVEN_IN = 4096;
constexpr int HD = 64, NQH = 32, NKVH = 4, ODD_IN = 2560;
constexpr int XH = 4, XHD = 512, DFF = 5632, NGU = 2 * DFF;
constexpr float EPS = 1e-5f;
constexpr int NWAVES = 8, NTHR = 512;

constexpr size_t MiB = 1u << 20;
constexpr size_t WS_CTL = 0, CTL_ZERO_BYTES = 32768;
constexpr size_t WS_QKVB = 1 * MiB;
constexpr size_t WS_GXS = 1 * MiB + 64 * 1024;
constexpr size_t WS_WIN_T = 2 * MiB;
constexpr size_t WS_EWOUT_T = 34 * MiB;
constexpr size_t WS_WQKV_T = 50 * MiB;
constexpr size_t WS_OWOUT_T = 70 * MiB;
constexpr size_t WS_WS = 86 * MiB;
constexpr size_t WS_VW = 150 * MiB;
constexpr size_t WS_WGU_T = 214 * MiB;
constexpr size_t WS_WDOWN_T = 390 * MiB;
constexpr size_t WS_H = 478 * MiB;
constexpr size_t WS_HB = 606 * MiB;
constexpr size_t WS_YY = 670 * MiB;
constexpr size_t WS_BIG = 734 * MiB;
constexpr size_t WS_WQ_BF = WS_H;
constexpr size_t WS_WKV_T = WS_H + 32 * MiB;
constexpr size_t WS_WO_T = WS_H + 96 * MiB;
constexpr size_t WS_KVM = 952 * MiB;
constexpr size_t WS_MEMN = 984 * MiB;
constexpr size_t WS_HALO_G = 910 * MiB;
constexpr size_t WS_HALO_U = 934 * MiB;
constexpr size_t WS_S5P = 946 * MiB;
constexpr size_t WS_SS = 948 * MiB;
constexpr size_t WS_END = 990 * MiB;

constexpr int CW_BAR = 4096;

constexpr int RING_BYTES = 131072;
constexpr int LDS_BYTES = 163840;
constexpr int MISC_OFF = LDS_BYTES - 256;
constexpr int F1_CWT_OFF = RING_BYTES, F1_RST_OFF = RING_BYTES + 12 * 2048, F1_SLOT_OFF = F1_RST_OFF + 3 * 1024;

#define RLX_AGENT __ATOMIC_RELAXED, __HIP_MEMORY_SCOPE_AGENT
#define LDS_WAIT() asm volatile("s_waitcnt lgkmcnt(0)" ::: "memory")
#define VM_WAIT() asm volatile("s_waitcnt vmcnt(0)" ::: "memory")
__device__ __forceinline__ unsigned cvt_pk_bf16(float lo, float hi) { unsigned r; asm volatile("v_cvt_pk_bf16_f32 %0, %1, %2" : "=v"(r) : "v"(lo), "v"(hi)); return r; }
__device__ __forceinline__ float bf_lo(unsigned w) { return __uint_as_float(w << 16); }
__device__ __forceinline__ float bf_hi(unsigned w) { return __uint_as_float(w & 0xffff0000u); }
__device__ __forceinline__ float bf1(bf16_t b) { return __uint_as_float(((unsigned)b) << 16); }
__device__ __forceinline__ float shx(float v, int mask, int lane) { return __builtin_bit_cast(float, __builtin_amdgcn_ds_bpermute((lane ^ mask) << 2, __builtin_bit_cast(int, v))); }
__device__ __forceinline__ float shl_(float v, int src, int lane) { (void)lane; return __builtin_bit_cast(float, __builtin_amdgcn_ds_bpermute(src << 2, __builtin_bit_cast(int, v))); }
__device__ __forceinline__ float wave_sum(float v, int lane) {
#pragma unroll
    for (int o = 1; o < 64; o <<= 1) v += shx(v, o, lane);
    return v;
}
__device__ __forceinline__ float wave_max(float v, int lane) {
#pragma unroll
    for (int o = 1; o < 64; o <<= 1) v = fmaxf(v, shx(v, o, lane));
    return v;
}
__device__ __forceinline__ float fast_exp(float x) { return __builtin_amdgcn_exp2f(x * 1.4426950408889634f); }
__device__ __forceinline__ float fast_sigmoid(float x) { return __builtin_amdgcn_rcpf(1.0f + fast_exp(-x)); }
__device__ __forceinline__ float gelu_tanh_f(float y) { const float u = 0.7978845608028654f * (y + 0.044715f * y * y * y); return y * fast_sigmoid(2.0f * u); }

__device__ const unsigned char kBucket[128] = {
 0,1,2,3,4,5,6,7,8,9,10,11,12,13,14,15,
 16,16,16,17,17,18,18,18,19,19,19,20,20,20,20,21,21,21,21,22,22,22,22,22,
 23,23,23,23,23,23,24,24,24,24,24,24,25,25,25,25,25,25,25,26,26,26,26,26,
 26,26,26,27,27,27,27,27,27,27,27,27,27,28,28,28,28,28,28,28,28,28,28,29,
 29,29,29,29,29,29,29,29,29,29,29,30,30,30,30,30,30,30,30,30,30,30,30,30,
 30,31,31,31,31,31,31,31,31,31,31,31,31,31,31,31};

typedef long long i64;
constexpr float SS_SCALE = 16777216.0f, SS_INV = 1.0f / (16777216.0f * 2048.0f);
__device__ __forceinline__ float rstd_of(const i64 v) { return __builtin_amdgcn_rsqf((float)v * SS_INV + EPS); }
__device__ __forceinline__ int lane_id() { return (int)__builtin_amdgcn_mbcnt_hi(~0u, __builtin_amdgcn_mbcnt_lo(~0u, 0u)); }
#define XB_TMO      128
#define XB_XCNT(j)  (256  + 64 * (j))
#define XB_XSUB(j)  (1280 + 64 * (j))
#define XB_XGEN(j)  (2304 + 64 * (j))
#define XB_TOP      3328
#define XB_TOPGEN   3392
#define XCD_BAR_WORDS 3456
#define XB_SPIN_CAP (1u << 22)

__device__ __forceinline__ unsigned xb_ld(unsigned* p)              { return __hip_atomic_load(p, __ATOMIC_RELAXED, __HIP_MEMORY_SCOPE_AGENT); }
__device__ __forceinline__ unsigned xb_add(unsigned* p, unsigned v) { return __hip_atomic_fetch_add(p, v, __ATOMIC_RELAXED, __HIP_MEMORY_SCOPE_AGENT); }
__device__ __forceinline__ unsigned xb_xcc_id() { return (unsigned)__builtin_amdgcn_s_getreg((3 << 11) | 20) & 0xFu; }
#define XB_SPIN(cond, bar) do { unsigned _sp = 0; while (cond) { __builtin_amdgcn_s_sleep(1); \
    if ((++_sp & 255u) == 0u) { if (xb_ld(&(bar)[XB_TMO])) break; if (_sp > XB_SPIN_CAP) { atomicAdd(&(bar)[XB_TMO], 1u); break; } } } } while (0)

struct XcdBarrier { unsigned* bar; unsigned x; volatile LAS unsigned* st; int wave; };

__device__ __forceinline__ XcdBarrier xcd_barrier_post(unsigned* bar, volatile LAS unsigned* st, int wave) {
    XcdBarrier b; b.bar = bar; b.x = xb_xcc_id(); b.st = st; b.wave = wave;
    if (wave == 0 && lane_id() == 0) (void)xb_add(&bar[XB_XCNT(b.x)], 1u);
    return b;
}
__device__ __forceinline__ void xcd_barrier_complete(unsigned* bar, unsigned x, unsigned& nloc, unsigned& nx) {
    const unsigned G = gridDim.x * gridDim.y * gridDim.z;
    unsigned sum, cnt, mine, sp = 0u;
    for (;;) {
        sum = 0u; cnt = 0u; mine = 0u;
#pragma unroll
        for (unsigned j = 0; j < 16; ++j) { const unsigned c = xb_ld(&bar[XB_XCNT(j)]); sum += c; cnt += (c > 0u) ? 1u : 0u; mine = (j == x) ? c : mine; }
        if (sum == G) break;
        __builtin_amdgcn_s_sleep(1);
        if ((++sp & 255u) == 0u) { if (xb_ld(&bar[XB_TMO])) break; if (sp > XB_SPIN_CAP) { atomicAdd(&bar[XB_TMO], 1u); break; } }
    }
    nloc = mine > 0u ? mine : 1u; nx = cnt > 0u ? cnt : 1u;
}
__device__ __forceinline__ void xcd_barrier(const XcdBarrier& b) {
    asm volatile("s_waitcnt vmcnt(0)" ::: "memory");
    __syncthreads();
    int wv = b.wave; asm volatile("" : "+s"(wv));
    if (wv == 0 && lane_id() == 0) {
        unsigned* bar = b.bar; asm volatile("" : "+s"(bar));
        const unsigned bx = xb_xcc_id();
        __builtin_amdgcn_s_waitcnt(0);
        unsigned nloc = b.st[0], nx = b.st[1];
        if (nloc == 0u) { xcd_barrier_complete(bar, bx, nloc, nx); b.st[0] = nloc; b.st[1] = nx; }
        const unsigned old = xb_add(&bar[XB_XSUB(bx)], 1u);
        const unsigned gen = old / nloc;
        if (old + 1u == (gen + 1u) * nloc) {
            __builtin_amdgcn_fence(__ATOMIC_RELEASE, "agent");
            asm volatile("s_waitcnt vmcnt(0)" ::: "memory");
            const unsigned og = xb_add(&bar[XB_TOP], 1u);
            const unsigned tg = og / nx;
            if (og + 1u == (tg + 1u) * nx) xb_add(&bar[XB_TOPGEN], 1u);
            else XB_SPIN(xb_ld(&bar[XB_TOPGEN]) == tg, bar);
            __builtin_amdgcn_fence(__ATOMIC_ACQUIRE, "agent");
            xb_add(&bar[XB_XGEN(bx)], 1u);
            asm volatile("s_waitcnt vmcnt(0)" ::: "memory");
        } else {
            XB_SPIN(xb_ld(&bar[XB_XGEN(bx)]) == gen, bar);
            __builtin_amdgcn_fence(__ATOMIC_ACQUIRE, "agent");
            asm volatile("s_waitcnt vmcnt(0)" ::: "memory");
        }
    }
    __syncthreads();
}

namespace pg8 {
constexpr int BM = 256, BK = 64, HALF = 128, HTB = HALF * BK * 2, STAGE_BYTES = 8 * HTB, NXCD = 8, WGM = 8;
__host__ __device__ __forceinline__ int lds_byte(int r, int c) { const int st = (r >> 4) * 2 + (c >> 5), rr = r & 15, cc = c & 31, ob = rr * 64 + cc * 2; return st * 1024 + (ob ^ (((ob >> 9) & 1) << 5)); }
__host__ __device__ __forceinline__ void stage_rc(int b, int& R, int& C) { const int st = b / 1024, sb = b % 1024, swz = sb ^ (((sb >> 9) & 1) << 5); R = (st >> 1) * 16 + swz / 64; C = (st & 1) * 32 + (swz % 64) / 2; }
__host__ __device__ __forceinline__ int perm32(int rho) { const int n = rho >> 4, i = rho & 15; return 8 * (i >> 2) + 4 * n + (i & 3); }

struct Unit { const char* A; const char* B; char* C; const float* vec; int row0, col0, aux; };

__device__ __forceinline__ void tile_of(int wgid, int nM, int nN, int& pm, int& pn, const int WGM = 8) {
    const int nwg = nM * nN;
    { const int q = nwg / NXCD, r = nwg % NXCD, xcd = wgid % NXCD, off = wgid / NXCD; wgid = (xcd < r ? xcd * (q + 1) : r * (q + 1) + (xcd - r) * q) + off; }
    const int nig = WGM * nN, gid = wgid / nig, fm = gid * WGM, gsz = (nM - fm) < WGM ? (nM - fm) : WGM;
    pm = fm + ((wgid % nig) % gsz); pn = (wgid % nig) / gsz;
}

template <class Epi, class Sched, bool ALIGN_EPI>
__device__ __forceinline__ void gemm_phase(LAS unsigned char* lds, const int wave_, const int lda, const int ldb, const int K, const Sched& S, const Epi& E) {
    int lane_ = lane_id(); asm volatile("" : "+v"(lane_));
    int wv_ = wave_; asm volatile("" : "+s"(wv_));
    const int wid = wv_, lane = lane_, tid = wid * 64 + lane, wr = wid >> 2, wc = wid & 3, fr = lane & 15, fq = lane >> 4;
    const int nt = K / BK;
    unsigned voffA[2], voffB[2];
#pragma unroll
    for (int i = 0; i < 2; ++i) { int R, C; stage_rc(tid * 16 + i * 8192, R, C); const int Rb = (R & ~31) + perm32(R & 31);
        const int Ra = Epi::APERM ? ((R & ~63) + 4 * (R & 15) + ((R >> 4) & 3)) : R;
        voffA[i] = (unsigned)(Ra * lda + C) * 2u; voffB[i] = (unsigned)(Rb * ldb + C) * 2u; }
    const size_t kstep = (size_t)(BK * 2);
    const size_t hsA = (size_t)HALF * lda * 2, hsB = (size_t)HALF * ldb * 2;
    const unsigned ldsw = (unsigned)wid * 1024u;
    const int aoff = lds_byte(wr * 64 + fr, fq * 8), boff = lds_byte(wc * 32 + fr, fq * 8);
#define PG8_SA(b, h) (((b) * 2 + (h)) * HTB)
#define PG8_SB(b, h) ((4 + (b) * 2 + (h)) * HTB)
#define PG8_STAGE(bufoff, gbase, voff) do { _Pragma("unroll") for (int _i = 0; _i < 2; ++_i) \
        __builtin_amdgcn_global_load_lds((const unsigned*)((const char*)(gbase) + (voff)[_i]), (LAS unsigned*)(lds + (bufoff) + ldsw + _i * 8192), 16, 0, 0); } while (0)
#define PG8_LDA(dst, b, h) do { _Pragma("unroll") for (int m = 0; m < 4; ++m) _Pragma("unroll") for (int k = 0; k < 2; ++k) dst[m][k] = *(const LAS bf16x8*)(lds + PG8_SA(b, h) + aoff + m * 2048 + k * 1024); } while (0)
#define PG8_LDB(dst, b, h) do { _Pragma("unroll") for (int n = 0; n < 2; ++n) _Pragma("unroll") for (int k = 0; k < 2; ++k) dst[n][k] = *(const LAS bf16x8*)(lds + PG8_SB(b, h) + boff + n * 2048 + k * 1024); } while (0)
#ifndef MMA_ONEPRIO
#define MMA_ONEPRIO 1
#endif
#define PG8_MMA(ai, bj, At, Bt) do { if (!MMA_ONEPRIO || bj == 0) __builtin_amdgcn_s_setprio(1); _Pragma("unroll") for (int m = 0; m < 4; ++m) _Pragma("unroll") for (int n = 0; n < 2; ++n) _Pragma("unroll") for (int k = 0; k < 2; ++k) \
        acc[ai][bj][m][n] = __builtin_amdgcn_mfma_f32_16x16x32_bf16(Bt[n][k], At[m][k], acc[ai][bj][m][n], 0, 0, 0); if (!MMA_ONEPRIO || bj == 1) __builtin_amdgcn_s_setprio(0); } while (0)
#define PG8_WAIT_V(n) asm volatile("s_waitcnt vmcnt(" #n ")" ::: "memory")
#define PG8_WAIT_L(n) asm volatile("s_waitcnt lgkmcnt(" #n ")" ::: "memory")
#define PG8_BAR __builtin_amdgcn_s_barrier()
#define PG8_SCHED __builtin_amdgcn_sched_barrier(0)
    Unit cur, nxt; int ui = 0;
    if (!S.next(0, cur)) return;
    f32x4 acc[2][2][4][2];
    if constexpr (Epi::PRELOAD) E.preload(acc, cur, wr, wc);
    else {
#pragma unroll
    for (int a = 0; a < 2; ++a)
#pragma unroll
        for (int b = 0; b < 2; ++b)
#pragma unroll
            for (int m = 0; m < 4; ++m)
#pragma unroll
                for (int n = 0; n < 2; ++n) acc[a][b][m][n] = (f32x4){0.f, 0.f, 0.f, 0.f};
    }
    bf16x8 At[4][2], B0[2][2], B1[2][2];
    const char* cA = cur.A; const char* cB = cur.B;
#ifndef GEMM_SP2
#define GEMM_SP2 1
#endif
    constexpr bool SP2 = GEMM_SP2;
    if constexpr (SP2) {
    PG8_STAGE(PG8_SB(0, 0), cB, voffB); PG8_STAGE(PG8_SB(0, 1), cB + hsB, voffB); PG8_STAGE(PG8_SA(0, 0), cA, voffA); PG8_STAGE(PG8_SA(0, 1), cA + hsA, voffA);
    if (wr == 1) PG8_BAR;
    PG8_WAIT_V(2); PG8_BAR;
    PG8_STAGE(PG8_SB(1, 0), cB + kstep, voffB); PG8_STAGE(PG8_SA(1, 0), cA + kstep, voffA); PG8_STAGE(PG8_SB(1, 1), cB + hsB + kstep, voffB);
    PG8_WAIT_V(6); PG8_BAR;
    } else {
    PG8_STAGE(PG8_SB(0, 0), cB, voffB); PG8_STAGE(PG8_SA(0, 0), cA, voffA); PG8_STAGE(PG8_SB(0, 1), cB + hsB, voffB); PG8_STAGE(PG8_SA(0, 1), cA + hsA, voffA);
    if (wr == 1) PG8_BAR;
    PG8_WAIT_V(4); PG8_BAR;
    PG8_STAGE(PG8_SB(1, 0), cB + kstep, voffB); PG8_STAGE(PG8_SA(1, 0), cA + kstep, voffA); PG8_STAGE(PG8_SB(1, 1), cB + hsB + kstep, voffB);
    PG8_WAIT_V(6); PG8_BAR;
    }
    for (;;) {
        const bool has_next = S.next(ui + 1, nxt);
        const char* nA = has_next ? nxt.A : cA; const char* nB = has_next ? nxt.B : cB;
        for (int t = 0; t < nt; t += 2) {
            const bool last = (t == nt - 2);
            const char* a1 = cA + (size_t)(t + 1) * kstep;
            const char* a2 = last ? nA : cA + (size_t)(t + 2) * kstep; const char* b2 = last ? nB : cB + (size_t)(t + 2) * kstep;
            const char* a3 = a2 + kstep; const char* b3 = b2 + kstep;
            if constexpr (SP2) {
            PG8_LDB(B0, 0, 0); PG8_LDB(B1, 0, 1); PG8_SCHED; PG8_LDA(At, 0, 0); PG8_STAGE(PG8_SA(1, 1), a1 + hsA, voffA);
            PG8_WAIT_V(8); PG8_WAIT_L(0); PG8_BAR; PG8_MMA(0, 0, At, B0); PG8_MMA(0, 1, At, B1); PG8_BAR; PG8_SCHED;
            PG8_LDA(At, 0, 1); PG8_STAGE(PG8_SB(0, 0), b2, voffB); PG8_STAGE(PG8_SB(0, 1), b2 + hsB, voffB); PG8_STAGE(PG8_SA(0, 0), a2, voffA);
            PG8_WAIT_V(8); PG8_WAIT_L(0); PG8_BAR; PG8_MMA(1, 0, At, B0); PG8_MMA(1, 1, At, B1); PG8_BAR; PG8_SCHED;
            PG8_LDB(B0, 1, 0); PG8_LDB(B1, 1, 1); PG8_SCHED; PG8_LDA(At, 1, 0); PG8_STAGE(PG8_SA(0, 1), a2 + hsA, voffA);
            PG8_WAIT_V(8); PG8_WAIT_L(0); PG8_BAR; PG8_MMA(0, 0, At, B0); PG8_MMA(0, 1, At, B1); PG8_BAR; PG8_SCHED;
            PG8_LDA(At, 1, 1); PG8_STAGE(PG8_SB(1, 0), b3, voffB); PG8_STAGE(PG8_SB(1, 1), b3 + hsB, voffB); PG8_STAGE(PG8_SA(1, 0), a3, voffA);
            PG8_WAIT_V(8); PG8_WAIT_L(0); PG8_BAR; PG8_MMA(1, 0, At, B0); PG8_MMA(1, 1, At, B1); PG8_BAR; PG8_SCHED;
            } else {
            PG8_LDB(B0, 0, 0); PG8_SCHED; PG8_LDA(At, 0, 0); PG8_STAGE(PG8_SA(1, 1), a1 + hsA, voffA);
            PG8_WAIT_L(8); PG8_BAR; PG8_WAIT_L(0); PG8_MMA(0, 0, At, B0); PG8_BAR; PG8_SCHED;
            PG8_LDB(B1, 0, 1); PG8_STAGE(PG8_SB(0, 0), b2, voffB);
            PG8_BAR; PG8_WAIT_L(0); PG8_MMA(0, 1, At, B1); PG8_BAR;
            PG8_LDA(At, 0, 1); PG8_STAGE(PG8_SA(0, 0), a2, voffA);
            PG8_BAR; PG8_WAIT_L(0); PG8_MMA(1, 0, At, B0); PG8_BAR; PG8_SCHED;
            PG8_STAGE(PG8_SB(0, 1), b2 + hsB, voffB);
            PG8_WAIT_V(6); PG8_BAR; PG8_MMA(1, 1, At, B1); PG8_BAR;
            PG8_LDB(B0, 1, 0); PG8_SCHED; PG8_LDA(At, 1, 0); PG8_STAGE(PG8_SA(0, 1), a2 + hsA, voffA);
            PG8_WAIT_L(8); PG8_BAR; PG8_WAIT_L(0); PG8_MMA(0, 0, At, B0); PG8_BAR; PG8_SCHED;
            PG8_LDB(B1, 1, 1); PG8_STAGE(PG8_SB(1, 0), b3, voffB);
            PG8_BAR; PG8_WAIT_L(0); PG8_MMA(0, 1, At, B1); PG8_BAR;
            PG8_LDA(At, 1, 1); PG8_STAGE(PG8_SA(1, 0), a3, voffA);
            PG8_BAR; PG8_WAIT_L(0); PG8_MMA(1, 0, At, B0); PG8_BAR; PG8_SCHED;
            PG8_STAGE(PG8_SB(1, 1), b3 + hsB, voffB);
            PG8_WAIT_V(6); PG8_BAR; PG8_MMA(1, 1, At, B1); PG8_BAR;
            }
        }
        if constexpr (ALIGN_EPI) { if (wr == 0) PG8_BAR; }
        if constexpr (Epi::FUSEDPRE) { Unit pu = cur; if (has_next) pu = nxt; E.epi_pre(acc, cur, pu, has_next, wr, wc); if (!has_next) break; }
        else {
        if constexpr (!Epi::AFTER_DRAIN) { E(acc, cur, wr, wc, fr, fq); }
        if (!has_next) break;
        }
        if constexpr (Epi::FUSEDPRE) {}
        else if constexpr (Epi::PRELOAD) E.preload(acc, nxt, wr, wc);
        else {
#pragma unroll
        for (int a = 0; a < 2; ++a)
#pragma unroll
            for (int b = 0; b < 2; ++b)
#pragma unroll
                for (int m = 0; m < 4; ++m)
#pragma unroll
                    for (int n = 0; n < 2; ++n) acc[a][b][m][n] = (f32x4){0.f, 0.f, 0.f, 0.f};
        }
        cur = nxt; cA = nA; cB = nB; ++ui;
        if constexpr (ALIGN_EPI) { if (wr == 1) PG8_BAR; }
    }
    PG8_WAIT_V(0);
    if constexpr (!ALIGN_EPI) { if (wr == 0) PG8_BAR; }
    PG8_BAR;
    if constexpr (Epi::AFTER_DRAIN) { E.fused(acc, cur, wr, wc, fr, fq, lds, wid, lane); }
#undef PG8_SA
#undef PG8_SB
#undef PG8_STAGE
#undef PG8_LDA
#undef PG8_LDB
#undef PG8_MMA
#undef PG8_WAIT_V
#undef PG8_WAIT_L
#undef PG8_BAR
#undef PG8_SCHED
}
}
#ifndef DEF_WGM
#define DEF_WGM 4
#endif
namespace pg8 {
struct SchedMain {
    const char* A; const char* B; char* C; size_t tA, tB, bB, tC, cC; int nM, nN, bdiv, ccols, G, c, wgm = DEF_WGM;
    __device__ __forceinline__ bool next(int i, Unit& u) const {
        const long Lx = (long)i * G + c; if (Lx >= (long)nM * nN) return false;
        int pm, pn; tile_of((int)Lx, nM, nN, pm, pn, wgm);
        u.A = A + (size_t)pm * tA; u.B = B + (size_t)pn * tB + (size_t)(pm / bdiv) * bB; u.C = C + (size_t)pm * tC + (size_t)pn * cC;
        u.row0 = pm * BM; u.col0 = pn * ccols; u.aux = i; u.vec = nullptr; return true;
    }
};

struct EpiRowScale {
    static constexpr bool AFTER_DRAIN = false, PRELOAD = false, APERM = false, FUSEDPRE = false;
    const i64* ss; const float* bias; int ldc;
    __device__ __forceinline__ void operator()(f32x4 (&acc)[2][2][4][2], const Unit& u, int wr, int wc, int fr_, int fq_) const {
        int lane_ = lane_id(); asm volatile("" : "+v"(lane_)); const int fr = lane_ & 15, fq = lane_ >> 4; (void)fr_; (void)fq_;
        const int colw = wc * 32 + 8 * fq; const unsigned loff = (unsigned)((wr * 64 + fr) * ldc + colw) * 2u; const unsigned soff = (unsigned)(wr * 64 + fr) * 8u;
        i64 sv[2][4];
#pragma unroll
        for (int ai = 0; ai < 2; ++ai)
#pragma unroll
            for (int m = 0; m < 4; ++m) sv[ai][m] = *(const i64*)((const char*)(ss + u.row0 + ai * HALF + m * 16) + soff);
        f32x4 bv[2][2];
#pragma unroll
        for (int bj = 0; bj < 2; ++bj)
#pragma unroll
            for (int n = 0; n < 2; ++n) bv[bj][n] = bias ? *(const f32x4*)(bias + u.col0 + colw + bj * HALF + 4 * n) : (f32x4){0.f, 0.f, 0.f, 0.f};
#pragma unroll
        for (int ai = 0; ai < 2; ++ai)
#pragma unroll
            for (int m = 0; m < 4; ++m) {
                const int rb = ai * HALF + m * 16;
                const float rs = rstd_of(sv[ai][m]);
                char* rowp = u.C + (size_t)rb * ldc * 2 + loff;
#pragma unroll
                for (int bj = 0; bj < 2; ++bj) {
                    const f32x4 v0 = acc[ai][bj][m][0] * rs + bv[bj][0], v1 = acc[ai][bj][m][1] * rs + bv[bj][1];
                    u32x4 w; w.x = cvt_pk_bf16(v0[0], v0[1]); w.y = cvt_pk_bf16(v0[2], v0[3]); w.z = cvt_pk_bf16(v1[0], v1[1]); w.w = cvt_pk_bf16(v1[2], v1[3]);
                    *(u32x4*)(rowp + bj * HALF * 2) = w;
                }
            }
    }
};

struct EpiPlain {
    static constexpr bool AFTER_DRAIN = false, PRELOAD = false, APERM = false, FUSEDPRE = false;
    __device__ __forceinline__ void operator()(f32x4 (&acc)[2][2][4][2], const Unit& u, int wr, int wc, int fr_, int fq_) const {
        int lane_ = lane_id(); asm volatile("" : "+v"(lane_)); const int fr = lane_ & 15, fq = lane_ >> 4; (void)fr_; (void)fq_;
        const int colw = wc * 32 + 8 * fq, ldc = u.aux; const float* cs = (const float*)u.vec; const unsigned loff = (unsigned)((wr * 64 + fr) * ldc + colw) * 2u;
        f32x4 sv[2][2];
#pragma unroll
        for (int bj = 0; bj < 2; ++bj)
#pragma unroll
            for (int n = 0; n < 2; ++n) sv[bj][n] = cs ? *(const f32x4*)(cs + u.col0 + colw + bj * HALF + 4 * n) : (f32x4){1.f, 1.f, 1.f, 1.f};
#pragma unroll
        for (int ai = 0; ai < 2; ++ai)
#pragma unroll
            for (int m = 0; m < 4; ++m) {
                char* rowp = u.C + (size_t)(ai * HALF + m * 16) * ldc * 2 + loff;
#pragma unroll
                for (int bj = 0; bj < 2; ++bj) {
                    const f32x4 v0 = acc[ai][bj][m][0] * sv[bj][0], v1 = acc[ai][bj][m][1] * sv[bj][1];
                    u32x4 w; w.x = cvt_pk_bf16(v0[0], v0[1]); w.y = cvt_pk_bf16(v0[2], v0[3]); w.z = cvt_pk_bf16(v1[0], v1[1]); w.w = cvt_pk_bf16(v1[2], v1[3]);
                    *(u32x4*)(rowp + bj * HALF * 2) = w;
                }
            }
    }
};

struct EpiRes {
    static constexpr bool AFTER_DRAIN = false, PRELOAD = true, APERM = false, FUSEDPRE = true;
    bf16_t* hb; bf16_t* hbo; i64* ssout; LAS unsigned char* lds_spare;
    __device__ __forceinline__ void preload(f32x4 (&acc)[2][2][4][2], const Unit& u, int wr, int wc) const {
        int lane_ = lane_id(); asm volatile("" : "+v"(lane_)); const int fr = lane_ & 15, fq = lane_ >> 4;
        const unsigned l2 = (unsigned)((wr * 64 + fr) * D + wc * 32 + 8 * fq) * 2u;
#pragma unroll
        for (int ai = 0; ai < 2; ++ai)
#pragma unroll
            for (int m = 0; m < 4; ++m) { const char* pin = (const char*)(hb + (size_t)(u.row0 + ai * HALF + m * 16) * D + u.col0) + l2;
#pragma unroll
                for (int bj = 0; bj < 2; ++bj) { const u32x4 w = *(const u32x4*)(pin + bj * HALF * 2);
                    acc[ai][bj][m][0] = (f32x4){bf_lo(w.x), bf_hi(w.x), bf_lo(w.y), bf_hi(w.y)}; acc[ai][bj][m][1] = (f32x4){bf_lo(w.z), bf_hi(w.z), bf_lo(w.w), bf_hi(w.w)}; } }
    }
    __device__ __forceinline__ void operator()(f32x4 (&)[2][2][4][2], const Unit&, int, int, int, int) const {}
    __device__ __forceinline__ void epi_pre(f32x4 (&acc)[2][2][4][2], const Unit& u, const Unit& nu, const bool has_next, int wr, int wc) const {
        int lane_ = lane_id(); asm volatile("" : "+v"(lane_)); const int fr = lane_ & 15, fq = lane_ >> 4;
        const unsigned l2 = (unsigned)((wr * 64 + fr) * D + wc * 32 + 8 * fq) * 2u;
        LAS float* T = (LAS float*)(lds_spare);
        u32x4 raw[2][4][2];
        if (has_next) {
#pragma unroll
        for (int ai = 0; ai < 2; ++ai)
#pragma unroll
            for (int m = 0; m < 4; ++m) { const char* pin = (const char*)(hb + (size_t)(nu.row0 + ai * HALF + m * 16) * D + nu.col0) + l2;
                asm volatile("global_load_dwordx4 %0, %2, off\n\tglobal_load_dwordx4 %1, %2, off offset:256" : "=&v"(raw[ai][m][0]), "=&v"(raw[ai][m][1]) : "v"(pin) : "memory"); }
        }
#pragma unroll
        for (int ai = 0; ai < 2; ++ai)
#pragma unroll
            for (int m = 0; m < 4; ++m) {
                char* pb = (char*)(hbo + (size_t)(u.row0 + ai * HALF + m * 16) * D + u.col0) + l2;
                float s = 0.f;
#pragma unroll
                for (int bj = 0; bj < 2; ++bj) {
                    const f32x4 o0 = acc[ai][bj][m][0], o1 = acc[ai][bj][m][1];
                    u32x4 w; w.x = cvt_pk_bf16(o0[0], o0[1]); w.y = cvt_pk_bf16(o0[2], o0[3]); w.z = cvt_pk_bf16(o1[0], o1[1]); w.w = cvt_pk_bf16(o1[2], o1[3]);
                    *(u32x4*)(pb + bj * HALF * 2) = w;
                    s += (o0[0] * o0[0] + o0[1] * o0[1]) + (o0[2] * o0[2] + o0[3] * o0[3]) + (o1[0] * o1[0] + o1[1] * o1[1]) + (o1[2] * o1[2] + o1[3] * o1[3]);
                }
                s += shx(s, 16, lane_); s += shx(s, 32, lane_);
                if (fq == 0) T[(ai * HALF + wr * 64 + m * 16 + fr) * 4 + wc] = s;
            }
        asm volatile("s_waitcnt lgkmcnt(0)" ::: "memory"); __builtin_amdgcn_s_barrier(); asm volatile("" ::: "memory");
        if (lane_ < 32) { const int row = (wr * 4 + wc) * 32 + lane_; const f32x4 p = *(const LAS f32x4*)(T + row * 4);
            __hip_atomic_fetch_add(ssout + u.row0 + row, (i64)(((p[0] + p[1]) + (p[2] + p[3])) * SS_SCALE), __ATOMIC_RELAXED, __HIP_MEMORY_SCOPE_AGENT); }
        if (!has_next) return;
        asm volatile("s_waitcnt vmcnt(16)" : "+v"(raw[0][0][0]), "+v"(raw[0][0][1]), "+v"(raw[0][1][0]), "+v"(raw[0][1][1]), "+v"(raw[0][2][0]), "+v"(raw[0][2][1]), "+v"(raw[0][3][0]), "+v"(raw[0][3][1]),
                                           "+v"(raw[1][0][0]), "+v"(raw[1][0][1]), "+v"(raw[1][1][0]), "+v"(raw[1][1][1]), "+v"(raw[1][2][0]), "+v"(raw[1][2][1]), "+v"(raw[1][3][0]), "+v"(raw[1][3][1]) :: "memory");
#pragma unroll
        for (int ai = 0; ai < 2; ++ai)
#pragma unroll
            for (int m = 0; m < 4; ++m)
#pragma unroll
                for (int bj = 0; bj < 2; ++bj) { const u32x4 w = raw[ai][m][bj];
                    acc[ai][bj][m][0] = (f32x4){bf_lo(w.x), bf_hi(w.x), bf_lo(w.y), bf_hi(w.y)}; acc[ai][bj][m][1] = (f32x4){bf_lo(w.z), bf_hi(w.z), bf_lo(w.w), bf_hi(w.w)}; }
    }
};

struct EpiSoftmax {
    static constexpr bool AFTER_DRAIN = true, PRELOAD = false, APERM = false, FUSEDPRE = false;
    const i64* ss; int ldc;
    __device__ __forceinline__ void operator()(f32x4 (&)[2][2][4][2], const Unit&, int, int, int, int) const {}
    __device__ __forceinline__ void fused(f32x4 (&acc)[2][2][4][2], const Unit& u, int wr, int wc, int fr_, int fq_, LAS unsigned char* lds, int wid, int lane) const {
        int lane_ = lane_id(); asm volatile("" : "+v"(lane_)); const int fr = lane_ & 15, fq = lane_ >> 4; (void)fr_; (void)fq_;
        LAS f32x2* T = (LAS f32x2*)lds;
        const unsigned loff = (unsigned)((wr * 64 + fr) * ldc + wc * 32 + 8 * fq) * 2u, soff = (unsigned)(wr * 64 + fr) * 8u;
        float mown[2][4]; i64 sv[2][4];
#pragma unroll
        for (int ai = 0; ai < 2; ++ai)
#pragma unroll
            for (int m = 0; m < 4; ++m) sv[ai][m] = *(const i64*)((const char*)(ss + u.row0 + ai * HALF + m * 16) + soff);
#pragma unroll
        for (int ai = 0; ai < 2; ++ai)
#pragma unroll
            for (int m = 0; m < 4; ++m) {
                const int r = ai * HALF + wr * 64 + m * 16 + fr;
                const float rs = rstd_of(sv[ai][m]);
                float mx = -3.0e38f;
#pragma unroll
                for (int bj = 0; bj < 2; ++bj)
#pragma unroll
                    for (int n = 0; n < 2; ++n) { f32x4 v = acc[ai][bj][m][n] * rs; acc[ai][bj][m][n] = v; mx = fmaxf(fmaxf(mx, fmaxf(v[0], v[1])), fmaxf(v[2], v[3])); }
                mx = fmaxf(mx, shx(mx, 16, lane_)); mx = fmaxf(mx, shx(mx, 32, lane_));
                float l = 0.f;
#pragma unroll
                for (int bj = 0; bj < 2; ++bj)
#pragma unroll
                    for (int n = 0; n < 2; ++n) { f32x4 v = acc[ai][bj][m][n]; v[0] = fast_exp(v[0] - mx); v[1] = fast_exp(v[1] - mx); v[2] = fast_exp(v[2] - mx); v[3] = fast_exp(v[3] - mx); acc[ai][bj][m][n] = v; l += (v[0] + v[1]) + (v[2] + v[3]); }
                l += shx(l, 16, lane_); l += shx(l, 32, lane_);
                mown[ai][m] = mx;
                if (fq == 0) T[r * 4 + wc] = (f32x2){mx, l};
            }
        asm volatile("s_waitcnt lgkmcnt(0)" ::: "memory"); __builtin_amdgcn_s_barrier(); asm volatile("" ::: "memory");
#pragma unroll
        for (int ai = 0; ai < 2; ++ai)
#pragma unroll
            for (int m = 0; m < 4; ++m) {
                const int r = ai * HALF + wr * 64 + m * 16 + fr;
                const f32x2 a = T[r * 4 + 0], b = T[r * 4 + 1], c = T[r * 4 + 2], d = T[r * 4 + 3];
                const float Mx = fmaxf(fmaxf(a.x, b.x), fmaxf(c.x, d.x));
                const float Ls = a.y * fast_exp(a.x - Mx) + b.y * fast_exp(b.x - Mx) + c.y * fast_exp(c.x - Mx) + d.y * fast_exp(d.x - Mx);
                const float f = fast_exp(mown[ai][m] - Mx) * __builtin_amdgcn_rcpf(Ls);
                char* rowp = u.C + (size_t)(ai * HALF + m * 16) * ldc * 2 + loff;
#pragma unroll
                for (int bj = 0; bj < 2; ++bj) {
                    const f32x4 v0 = acc[ai][bj][m][0] * f, v1 = acc[ai][bj][m][1] * f;
                    u32x4 w; w.x = cvt_pk_bf16(v0[0], v0[1]); w.y = cvt_pk_bf16(v0[2], v0[3]); w.z = cvt_pk_bf16(v1[0], v1[1]); w.w = cvt_pk_bf16(v1[2], v1[3]);
                    *(u32x4*)(rowp + bj * HALF * 2) = w;
                }
            }
    }
};

__device__ __forceinline__ float dpp_shr1z(float x) { return __builtin_bit_cast(float, __builtin_amdgcn_update_dpp(0, __builtin_bit_cast(int, x), 0x111  , 0xf, 0xf, true)); }
struct EpiMLP {
    static constexpr bool AFTER_DRAIN = false, PRELOAD = false, APERM = true, FUSEDPRE = false;
    LAS unsigned char* lds; float* halo_g; float* halo_u;
    __device__ __forceinline__ void operator()(f32x4 (&acc)[2][2][4][2], const Unit& u, int wr, int wc, int fr_, int fq_) const {
        int lane_ = lane_id(); asm volatile("" : "+v"(lane_)); const int fr = lane_ & 15, fq = lane_ >> 4; (void)fr_; (void)fq_;
        const int colw = wc * 32 + 8 * fq, ch0 = u.col0 + colw;
        const unsigned loff = (unsigned)((wr * 64 + 4 * fr) * DFF + colw) * 2u;
        const float LN2 = 0.6931471805599453f;
        const LAS float* cwt = (const LAS float*)(lds + F1_CWT_OFF) + u.aux * 512 + colw;
        const int slot = *(const LAS int*)(lds + F1_SLOT_OFF + u.aux * 4);
        const LAS float* rst = (const LAS float*)(lds + F1_RST_OFF) + slot * 256 + wr * 64 + 4 * fr;
        f32x4 w0[2], w1[2], w2[2], bb[2];
#pragma unroll
        for (int n = 0; n < 2; ++n) { w0[n] = *(const LAS f32x4*)(cwt + 4 * n); w1[n] = *(const LAS f32x4*)(cwt + 128 + 4 * n); w2[n] = *(const LAS f32x4*)(cwt + 256 + 4 * n); bb[n] = *(const LAS f32x4*)(cwt + 384 + 4 * n); }
#pragma unroll
        for (int ai = 0; ai < 2; ++ai) {
            const int rb = u.row0 + ai * HALF + wr * 64, blk = rb >> 6;
            const f32x4 rsv = *(const LAS f32x4*)(rst + ai * HALF);
            float rs[4], rsu[4];
#pragma unroll
            for (int m = 0; m < 4; ++m) { rs[m] = rsv[m]; rsu[m] = rs[m] * LN2; }
#pragma unroll
            for (int n = 0; n < 2; ++n) {
                f32x4 g[4];
#pragma unroll
                for (int m = 0; m < 4; ++m) g[m] = acc[ai][0][m][n] * rs[m];
                if (fr == 15) { *(f32x4*)(halo_g + ((size_t)blk * 4 + 0) * DFF + ch0 + 4 * n) = g[2]; *(f32x4*)(halo_g + ((size_t)blk * 4 + 1) * DFF + ch0 + 4 * n) = g[3]; }
                if (fr == 0) { *(f32x4*)(halo_g + ((size_t)blk * 4 + 2) * DFF + ch0 + 4 * n) = g[0]; *(f32x4*)(halo_g + ((size_t)blk * 4 + 3) * DFF + ch0 + 4 * n) = g[1];
                               *(f32x4*)(halo_u + ((size_t)blk * 2 + 0) * DFF + ch0 + 4 * n) = acc[ai][1][0][n] * rs[0]; *(f32x4*)(halo_u + ((size_t)blk * 2 + 1) * DFF + ch0 + 4 * n) = acc[ai][1][1][n] * rs[1]; }
                f32x4 pre[4];
#pragma unroll
                for (int j = 0; j < 4; ++j) {
                    const float s3 = dpp_shr1z(g[3][j]), s2 = dpp_shr1z(g[2][j]);
                    pre[0][j] = w2[n][j] * g[0][j] + w1[n][j] * s3 + w0[n][j] * s2 + bb[n][j];
                    pre[1][j] = w2[n][j] * g[1][j] + w1[n][j] * g[0][j] + w0[n][j] * s3 + bb[n][j];
                    pre[2][j] = w2[n][j] * g[2][j] + w1[n][j] * g[1][j] + w0[n][j] * g[0][j] + bb[n][j];
                    pre[3][j] = w2[n][j] * g[3][j] + w1[n][j] * g[2][j] + w0[n][j] * g[1][j] + bb[n][j];
                }
#pragma unroll
                for (int m = 0; m < 4; ++m) {
                    f32x4 a;
#pragma unroll
                    for (int j = 0; j < 4; ++j) { const float p = pre[m][j]; a[j] = p * __builtin_amdgcn_rcpf(1.0f + __builtin_amdgcn_exp2f(-p)) * (acc[ai][1][m][n][j] * rsu[m]); }
                    acc[ai][0][m][n] = a;
                }
            }
#pragma unroll
            for (int m = 0; m < 4; ++m) {
                const f32x4 v0 = acc[ai][0][m][0], v1 = acc[ai][0][m][1];
                u32x4 w; w.x = cvt_pk_bf16(v0[0], v0[1]); w.y = cvt_pk_bf16(v0[2], v0[3]); w.z = cvt_pk_bf16(v1[0], v1[1]); w.w = cvt_pk_bf16(v1[2], v1[3]);
                *(u32x4*)(u.C + (size_t)(ai * HALF + m) * DFF * 2 + loff) = w;
            }
        }
    }
};
struct EpiEven {
    static constexpr bool AFTER_DRAIN = false, PRELOAD = false, APERM = true, FUSEDPRE = false;
    const i64* ss; const float* cw; bf16_t* YY; bf16_t* UB; float* HV; float* HGB;
    __device__ __forceinline__ void operator()(f32x4 (&acc)[2][2][4][2], const Unit& u, int wr, int wc, int fr_, int fq_) const {
        int lane_ = lane_id(); asm volatile("" : "+v"(lane_)); const int fr = lane_ & 15, fq = lane_ >> 4; (void)fr_; (void)fq_;
        const int ch = u.col0 + 16 * wc + 4 * fq, g = (u.col0 >> 4) + wc;
        const unsigned soff = (unsigned)(wr * 64 + 4 * fr) * 8u;
        i64 sv[2][4];
#pragma unroll
        for (int ai = 0; ai < 2; ++ai)
#pragma unroll
            for (int m = 0; m < 4; ++m) sv[ai][m] = *(const i64*)((const char*)(ss + u.row0 + ai * HALF + m) + soff);
        const f32x4 w0 = *(const f32x4*)(cw + ch), w1 = *(const f32x4*)(cw + AW + ch), w2 = *(const f32x4*)(cw + 2 * AW + ch);
#pragma unroll
        for (int ai = 0; ai < 2; ++ai) {
            const int rb = u.row0 + ai * HALF + wr * 64, blk = rb >> 6;
            f32x4 gb[4], v[4], y[4];
#pragma unroll
            for (int m = 0; m < 4; ++m) { const float rs = rstd_of(sv[ai][m]); gb[m] = acc[ai][0][m][0] * rs; v[m] = (acc[ai][0][m][1] * rs) * (acc[ai][1][m][0] * rs); acc[ai][1][m][1] = acc[ai][1][m][1] * rs; }
            if (fr == 15) { *(f32x4*)(HV + ((size_t)blk * 4 + 0) * AW + ch) = v[2]; *(f32x4*)(HV + ((size_t)blk * 4 + 1) * AW + ch) = v[3]; }
            if (fr == 0) { *(f32x4*)(HV + ((size_t)blk * 4 + 2) * AW + ch) = v[0]; *(f32x4*)(HV + ((size_t)blk * 4 + 3) * AW + ch) = v[1];
                           *(f32x4*)(HGB + ((size_t)blk * 2 + 0) * AW + ch) = gb[0]; *(f32x4*)(HGB + ((size_t)blk * 2 + 1) * AW + ch) = gb[1]; }
#pragma unroll
            for (int j = 0; j < 4; ++j) {
                const float s3 = dpp_shr1z(v[3][j]), s2 = dpp_shr1z(v[2][j]);
                y[0][j] = w2[j] * v[0][j] + w1[j] * s3 + w0[j] * s2;
                y[1][j] = w2[j] * v[1][j] + w1[j] * v[0][j] + w0[j] * s3;
                y[2][j] = w2[j] * v[2][j] + w1[j] * v[1][j] + w0[j] * v[0][j];
                y[3][j] = w2[j] * v[3][j] + w1[j] * v[2][j] + w0[j] * v[1][j];
            }
#pragma unroll
            for (int m = 0; m < 4; ++m) {
                const size_t row = (size_t)(rb + 4 * fr + m);
                const f32x4 a = gb[m] * y[m], uu = acc[ai][1][m][1];
                u32x2 wa; wa.x = cvt_pk_bf16(a[0], a[1]); wa.y = cvt_pk_bf16(a[2], a[3]);
                u32x2 wu; wu.x = cvt_pk_bf16(uu[0], uu[1]); wu.y = cvt_pk_bf16(uu[2], uu[3]);
                *(u32x2*)(YY + row * D + ch) = wa;
                *(u32x2*)(UB + ((size_t)g * M + row) * 16 + 4 * fq) = wu;
            }
        }
    }
};
struct EpiNull { static constexpr bool AFTER_DRAIN = false, PRELOAD = false, APERM = false, FUSEDPRE = false;
    __device__ __forceinline__ void operator()(f32x4 (&acc)[2][2][4][2], const Unit& u, int, int, int fr, int) const {
        f32x4 s = (f32x4){0.f, 0.f, 0.f, 0.f};
#pragma unroll
        for (int a = 0; a < 2; ++a)
#pragma unroll
            for (int b = 0; b < 2; ++b)
#pragma unroll
                for (int m = 0; m < 4; ++m)
#pragma unroll
                    for (int n = 0; n < 2; ++n) s += acc[a][b][m][n];
        if (s[0] + s[1] + s[2] + s[3] == 1.2345e-30f && fr == 7) *(float*)u.C = 0.f; } };
}
struct Args { const float* in[32]; float* out; unsigned char* ws; };

struct Frame {
    LAS unsigned char* lds;
    int wave, G, bid;
    int gw, ngw;
    int ngt;
};
#define PHASE_TID(F, tid, lane, gt) int lane = lane_id(); asm volatile("" : "+v"(lane)); const int tid = (F).wave * 64 + lane; const int gt = (F).bid * NTHR + tid; (void)tid; (void)gt


struct MatDesc { const float* W; const float* gk; bf16_t* WT; int K, N, rs, roff, nsplit; float nsc; int transpose, rmode; };
__device__ __forceinline__ int even_row(int ng) { const int part = ng >> 10, ch = ng & 1023, pn = ch >> 6, r = ch & 63; return 256 * pn + 128 * (part >> 1) + 32 * (r >> 4) + 8 * ((r >> 2) & 3) + 4 * (part & 1) + (r & 3); }
__device__ __forceinline__ void tr_load(const MatDesc& d, int item, int lane, f32x4 (&v)[16], float (&gs)[16]) {
    const int nblk = d.N / 64, kb = item / nblk, nb = item % nblk, k0 = 64 * kb, n0 = 64 * nb;
    const unsigned voff = (unsigned)((lane >> 4) * d.N + (lane & 15) * 4) * 4u;
    const char* sbase = (const char*)(d.W + (size_t)k0 * d.N + n0);
#pragma unroll
    for (int i = 0; i < 16; ++i) v[i] = __builtin_nontemporal_load((const f32x4*)(sbase + (size_t)(4 * i) * d.N * 4 + voff));
    if (d.gk) {
#pragma unroll
        for (int i = 0; i < 16; ++i) gs[i] = d.gk[k0 + 4 * i + (lane >> 4)];
    } else {
#pragma unroll
        for (int i = 0; i < 16; ++i) gs[i] = 1.0f;
    }
}
__device__ __forceinline__ void tr_store(const MatDesc& d, LAS float* scr, int item, int lane, const f32x4 (&v)[16], const float (&gs)[16]) {
    const int nblk = d.N / 64, kb = item / nblk, nb = item % nblk, k0 = 64 * kb, n0 = 64 * nb;
    LAS float* wp = scr + (lane >> 4) * 65 + (lane & 15) * 4;
#pragma unroll
    for (int i = 0; i < 16; ++i) { const f32x4 x = v[i] * gs[i];
        wp[(4 * i) * 65 + 0] = x[0]; wp[(4 * i) * 65 + 1] = x[1]; wp[(4 * i) * 65 + 2] = x[2]; wp[(4 * i) * 65 + 3] = x[3]; }
    LDS_WAIT(); asm volatile("" ::: "memory");
    const int c = lane & 7;
#pragma unroll
    for (int j = 0; j < 8; ++j) { const int n = (lane >> 3) + 8 * j, ng = n0 + n; const LAS float* s = scr + (8 * c) * 65 + n;
        const float sc = (ng < d.nsplit) ? d.nsc : 1.0f;
        u32x4 o; o.x = cvt_pk_bf16(s[0 * 65] * sc, s[1 * 65] * sc); o.y = cvt_pk_bf16(s[2 * 65] * sc, s[3 * 65] * sc); o.z = cvt_pk_bf16(s[4 * 65] * sc, s[5 * 65] * sc); o.w = cvt_pk_bf16(s[6 * 65] * sc, s[7 * 65] * sc);
        const int drow = d.rmode ? even_row(ng) : (ng / 128) * d.rs + d.roff + (ng % 128);
        __builtin_nontemporal_store(o, (u32x4*)(d.WT + (size_t)drow * d.K + k0 + 8 * c)); }
    LDS_WAIT(); asm volatile("" ::: "memory");
}
__device__ __forceinline__ void get_mat(const Args& a, int id, MatDesc& d) {
    unsigned char* ws = a.ws;
    d.gk = nullptr; d.rs = 128; d.roff = 0; d.nsplit = 0; d.nsc = 1.f; d.transpose = 1; d.rmode = 0; d.K = D; d.N = D;
    if (id < 2)       { const int i = id;      d.W = a.in[8] + (size_t)i * D * EVEN_IN; d.N = EVEN_IN; d.rmode = 1; d.gk = a.in[2] + (2 * i) * D; d.WT = (bf16_t*)(ws + WS_WIN_T) + (size_t)i * EVEN_IN * D; }
    else if (id < 4)  { const int i = id - 2;  d.W = a.in[19] + (size_t)i * D * D; d.WT = (bf16_t*)(ws + WS_EWOUT_T) + (size_t)i * D * D; }
    else if (id < 6)  { const int i = id - 4;  d.W = a.in[20] + (size_t)i * D * ODD_IN; d.N = ODD_IN; d.gk = a.in[2] + (2 * i + 1) * D; d.nsplit = NQH * HD; d.nsc = 0.125f; d.WT = (bf16_t*)(ws + WS_WQKV_T) + (size_t)i * ODD_IN * D; }
    else if (id < 8)  { const int i = id - 6;  d.W = a.in[23] + (size_t)i * D * D; d.WT = (bf16_t*)(ws + WS_OWOUT_T) + (size_t)i * D * D; }
    else if (id < 12) { const int l = id - 8;  d.W = a.in[25] + (size_t)l * D * 2 * D; d.N = 2 * D; d.WT = (bf16_t*)(ws + WS_WKV_T) + (size_t)l * 2 * D * D; }
    else if (id < 16) { const int l = id - 12; d.W = a.in[26] + (size_t)l * D * D; d.WT = (bf16_t*)(ws + WS_WO_T) + (size_t)l * D * D; }
    else if (id < 20) { const int l = id - 16; d.W = a.in[27] + (size_t)l * D * DFF; d.N = DFF; d.gk = a.in[4] + l * D; d.rs = 256; d.WT = (bf16_t*)(ws + WS_WGU_T) + (size_t)l * NGU * D; }
    else if (id < 24) { const int l = id - 20; d.W = a.in[28] + (size_t)l * D * DFF; d.N = DFF; d.gk = a.in[4] + l * D; d.rs = 256; d.roff = 128; d.WT = (bf16_t*)(ws + WS_WGU_T) + (size_t)l * NGU * D; }
    else if (id < 28) { const int l = id - 24; d.W = a.in[31] + (size_t)l * DFF * D; d.K = DFF; d.WT = (bf16_t*)(ws + WS_WDOWN_T) + (size_t)l * D * DFF; }
    else              { const int l = id - 28; d.W = a.in[24] + (size_t)l * D * D; d.transpose = 0; d.WT = (bf16_t*)(ws + WS_WQ_BF) + (size_t)l * D * D; }
}

__device__ __forceinline__ void p0_prologue(const Args& a, Frame& F) {
    unsigned char* ws = a.ws;
    PHASE_TID(F, tid, lane, gt);
    LAS float* scr = (LAS float*)(F.lds + F.wave * 16640);
    if (F.wave == 7) { float* sp = (float*)(ws + WS_S5P);
      for (int i = F.bid + F.G * lane; i < 2 * 64 * 64; i += F.G * 64) {
          const int g = (i >> 6) & 63, li_ = i >> 12;
          const double lr = a.in[10][i], li = a.in[11][i], dt = exp((double)a.in[12][li_ * 64 + g]);
          const double er = exp(lr * dt), abr = er * cos(li * dt), abi = er * sin(li * dt);
          const double xr_ = abr - 1.0, xi_ = abi, den = lr * lr + li * li;
          const double fr = (xr_ * lr + xi_ * li) / den, fi = (xi_ * lr - xr_ * li) / den;
          float* o = sp + (size_t)i * 34; o[0] = (float)abr; o[1] = (float)abi;
          for (int h = 0; h < 16; ++h) { const double br = a.in[13][(size_t)i * 16 + h], bi = a.in[14][(size_t)i * 16 + h]; o[2 + h] = (float)(fr * br - fi * bi); o[18 + h] = (float)(fr * bi + fi * br); } } }
    { int id = 0, base = 0; MatDesc d; get_mat(a, 0, d); int nit = (d.K / 64) * (d.N / 64);
      constexpr int TOTAL = 2 * (32 * 64 + 32 * 32 + 32 * 40 + 32 * 32) + 4 * (32 * 64 + 32 * 32 + 3 * 32 * 88);
      MatDesc dn = d; int idn = 0, basen = 0, nitn = nit;
      f32x4 vc[16], vn[16]; float gc[16], gn[16];
      int gi = F.gw;
      if (gi < TOTAL) {
          while (gi >= basen + nitn) { basen += nitn; ++idn; get_mat(a, idn, dn); nitn = (dn.K / 64) * (dn.N / 64); }
          d = dn; base = basen;
          tr_load(d, gi - base, lane, vc, gc);
          for (;;) {
              const int gnx = gi + F.ngw; const bool has_next = gnx < TOTAL;
              if (has_next) { while (gnx >= basen + nitn) { basen += nitn; ++idn; get_mat(a, idn, dn); nitn = (dn.K / 64) * (dn.N / 64); }
                              tr_load(dn, gnx - basen, lane, vn, gn); }
              tr_store(d, scr, gi - base, lane, vc, gc);
              if (!has_next) break;
#pragma unroll
              for (int i = 0; i < 16; ++i) { vc[i] = vn[i]; gc[i] = gn[i]; }
              d = dn; base = basen; gi = gnx;
          }
      } }
#if defined(PROBE_TR) && PROBE_TR
    { int id = 0, base = 0; MatDesc d; get_mat(a, 0, d); int nit = (d.K / 64) * (d.N / 64);
      constexpr int TOTAL = 2 * (32 * 64 + 32 * 32 + 32 * 40 + 32 * 32) + 4 * (32 * 64 + 32 * 32 + 3 * 32 * 88);
      f32x4 accp = (f32x4){0.f, 0.f, 0.f, 0.f};
      for (int gi = F.gw; gi < TOTAL; gi += F.ngw) {
          while (gi >= base + nit) { base += nit; ++id; get_mat(a, id, d); nit = (d.K / 64) * (d.N / 64); }
          f32x4 va[16]; float gs[16]; tr_load(d, gi - base, lane, va, gs);
          if (PROBE_TR == 1) {
#pragma unroll
              for (int i = 0; i < 16; ++i) accp += va[i] * gs[i];
          } else {
              const int item = gi - base, nblk = d.N / 64, kb = item / nblk, nb = item % nblk, k0 = 64 * kb, n0 = 64 * nb, c = lane & 7;
#pragma unroll
              for (int j = 0; j < 8; ++j) { const int n = (lane >> 3) + 8 * j, ng = n0 + n; const int drow = (ng / 128) * d.rs + d.roff + (ng % 128);
                  u32x4 o; o.x = (unsigned)gi; o.y = o.z = o.w = 0u;
                  *(u32x4*)((bf16_t*)(ws + WS_END) + ((size_t)(d.WT - (bf16_t*)(ws + WS_WIN_T)) % (32u << 20)) + (size_t)drow * d.K + k0 + 8 * c) = o; }
          } }
      if (accp[0] + accp[1] + accp[2] + accp[3] == 1.2345e-30f) *(float*)(ws + WS_END) = 0.f; }
#endif
    for (int id = 28; id < 32; ++id) {
        MatDesc d; get_mat(a, id, d);
        const size_t n8 = (size_t)d.K * d.N / 8;
        for (size_t i = gt; i < n8; i += F.ngt) { const f32x4 x0 = *(const f32x4*)(d.W + i * 8), x1 = *(const f32x4*)(d.W + i * 8 + 4);
            u32x4 o; o.x = cvt_pk_bf16(x0[0], x0[1]); o.y = cvt_pk_bf16(x0[2], x0[3]); o.z = cvt_pk_bf16(x1[0], x1[1]); o.w = cvt_pk_bf16(x1[2], x1[3]); *(u32x4*)(d.WT + i * 8) = o; }
    }
    { u32x4* z = (u32x4*)(ws + WS_SS + (size_t)M * 8); for (int i = gt; i < 13 * M * 8 / 16; i += F.ngt) z[i] = (u32x4){0u, 0u, 0u, 0u}; }
    { const float* x = a.in[0]; bf16_t* HB = (bf16_t*)(ws + WS_HB); i64* ss0 = (i64*)(ws + WS_SS);
      for (int row = F.gw; row < M; row += F.ngw) {
          const f32x4* xr = (const f32x4*)(x + (size_t)row * D); float s = 0.f;
#pragma unroll
          for (int j = 0; j < 4; ++j) { const f32x4 v0 = xr[(j * 64 + lane) * 2], v1 = xr[(j * 64 + lane) * 2 + 1];
              s += (v0[0] * v0[0] + v0[1] * v0[1]) + (v0[2] * v0[2] + v0[3] * v0[3]) + (v1[0] * v1[0] + v1[1] * v1[1]) + (v1[2] * v1[2] + v1[3] * v1[3]);
              u32x4 o; o.x = cvt_pk_bf16(v0[0], v0[1]); o.y = cvt_pk_bf16(v0[2], v0[3]); o.z = cvt_pk_bf16(v1[0], v1[1]); o.w = cvt_pk_bf16(v1[2], v1[3]);
              *(u32x4*)(HB + (size_t)row * D + (j * 64 + lane) * 8) = o; }
          s = wave_sum(s, lane); if (lane == 0) ss0[row] = (i64)(s * SS_SCALE); } }
    { const float* mem = a.in[1]; const float* gm = a.in[6]; bf16_t* MN = (bf16_t*)(ws + WS_MEMN);
      for (int row = F.gw; row < MROWS; row += F.ngw) {
          const f32x4* xr = (const f32x4*)(mem + (size_t)row * D); f32x4 v[8]; float s = 0.f;
#pragma unroll
          for (int j = 0; j < 4; ++j) { v[2 * j] = xr[(j * 64 + lane) * 2]; v[2 * j + 1] = xr[(j * 64 + lane) * 2 + 1];
              const f32x4 v0 = v[2 * j], v1 = v[2 * j + 1]; s += (v0[0] * v0[0] + v0[1] * v0[1]) + (v0[2] * v0[2] + v0[3] * v0[3]) + (v1[0] * v1[0] + v1[1] * v1[1]) + (v1[2] * v1[2] + v1[3] * v1[3]); }
          s = wave_sum(s, lane); const float r = 1.0f / sqrtf(s * (1.0f / D) + EPS);
#pragma unroll
          for (int j = 0; j < 4; ++j) { const f32x4 g0 = *(const f32x4*)(gm + (j * 64 + lane) * 8), g1 = *(const f32x4*)(gm + (j * 64 + lane) * 8 + 4);
              const f32x4 v0 = v[2 * j] * r * g0, v1 = v[2 * j + 1] * r * g1;
              u32x4 o; o.x = cvt_pk_bf16(v0[0], v0[1]); o.y = cvt_pk_bf16(v0[2], v0[3]); o.z = cvt_pk_bf16(v1[0], v1[1]); o.w = cvt_pk_bf16(v1[2], v1[3]);
              *(u32x4*)(MN + (size_t)row * D + (j * 64 + lane) * 8) = o; } } }
    { float* qb = (float*)(ws + WS_QKVB); const float* b = a.in[21];
      for (int i = gt; i < 2 * ODD_IN; i += F.ngt) qb[i] = b[i] * (((i % ODD_IN) < NQH * HD) ? 0.125f : 1.0f); }
    { float* gxs = (float*)(ws + WS_GXS); const float* gx = a.in[3];
      for (int i = gt; i < 4 * D; i += F.ngt) gxs[i] = gx[i] * 0.044194173824159216f; }
}

__device__ __forceinline__ void unpack8(const u32x4 w, float (&f)[8]) { f[0] = bf_lo(w.x); f[1] = bf_hi(w.x); f[2] = bf_lo(w.y); f[3] = bf_hi(w.y); f[4] = bf_lo(w.z); f[5] = bf_hi(w.z); f[6] = bf_lo(w.w); f[7] = bf_hi(w.w); }
__device__ __forceinline__ void phase_convgate(const bf16_t* Z, const float* cw, bf16_t* YY, Frame& F) {
    PHASE_TID(F, tid, lane, gt);
    for (int idx = gt; idx < M * (AW / 8); idx += F.ngt) {
        const int row = idx >> 7, c8 = (idx & 127) * 8, t = row & (L - 1);
        const bf16_t* zr = Z + (size_t)row * EVEN_IN + c8;
        float gb[8], a0[8], b0[8], a1[8], b1[8], a2[8], b2[8];
        unpack8(*(const u32x4*)zr, gb); unpack8(*(const u32x4*)(zr + AW), a0); unpack8(*(const u32x4*)(zr + 2 * AW), b0);
        const u32x4 zero = (u32x4){0u, 0u, 0u, 0u};
        unpack8(t >= 1 ? *(const u32x4*)(zr - EVEN_IN + AW) : zero, a1); unpack8(t >= 1 ? *(const u32x4*)(zr - EVEN_IN + 2 * AW) : zero, b1);
        unpack8(t >= 2 ? *(const u32x4*)(zr - 2 * EVEN_IN + AW) : zero, a2); unpack8(t >= 2 ? *(const u32x4*)(zr - 2 * EVEN_IN + 2 * AW) : zero, b2);
        float o[8];
#pragma unroll
        for (int j = 0; j < 8; ++j) o[j] = gb[j] * (cw[2 * AW + c8 + j] * (a0[j] * b0[j]) + cw[AW + c8 + j] * (a1[j] * b1[j]) + cw[c8 + j] * (a2[j] * b2[j]));
        u32x4 w; w.x = cvt_pk_bf16(o[0], o[1]); w.y = cvt_pk_bf16(o[2], o[3]); w.z = cvt_pk_bf16(o[4], o[5]); w.w = cvt_pk_bf16(o[6], o[7]);
        *(u32x4*)(YY + (size_t)row * D + c8) = w;
    }
}

__device__ __forceinline__ void phase_mlp_fixup(const float* HG, const float* HU, const float* cw, const float* cb, bf16_t* ACT, Frame& F) {
    PHASE_TID(F, tid, lane, gt);
    for (int idx = gt; idx < 512 * (DFF / 4); idx += F.ngt) {
        const int ri = idx / (DFF / 4), c = (idx % (DFF / 4)) * 4, blk = ri >> 1, e = ri & 1, r = blk * 64 + e, t = r & (L - 1);
        const f32x4 zero = (f32x4){0.f, 0.f, 0.f, 0.f};
        f32x4 gm2, gm1, g0;
        if (e == 0) { gm2 = (t >= 2) ? *(const f32x4*)(HG + ((size_t)(blk - 1) * 4 + 0) * DFF + c) : zero; gm1 = (t >= 1) ? *(const f32x4*)(HG + ((size_t)(blk - 1) * 4 + 1) * DFF + c) : zero; g0 = *(const f32x4*)(HG + ((size_t)blk * 4 + 2) * DFF + c); }
        else        { gm2 = (t >= 2) ? *(const f32x4*)(HG + ((size_t)(blk - 1) * 4 + 1) * DFF + c) : zero; gm1 = *(const f32x4*)(HG + ((size_t)blk * 4 + 2) * DFF + c); g0 = *(const f32x4*)(HG + ((size_t)blk * 4 + 3) * DFF + c); }
        const f32x4 up = *(const f32x4*)(HU + ((size_t)blk * 2 + e) * DFF + c);
        const f32x4 w0 = *(const f32x4*)(cw + c), w1 = *(const f32x4*)(cw + DFF + c), w2 = *(const f32x4*)(cw + 2 * DFF + c), bb = *(const f32x4*)(cb + c);
        f32x4 pre = w2 * g0 + w1 * gm1 + w0 * gm2 + bb, a;
#pragma unroll
        for (int j = 0; j < 4; ++j) a[j] = pre[j] * fast_sigmoid(pre[j]) * up[j];
        u32x2 w; w.x = cvt_pk_bf16(a[0], a[1]); w.y = cvt_pk_bf16(a[2], a[3]);
        *(u32x2*)(ACT + (size_t)r * DFF + c) = w;
    }
}

__device__ __forceinline__ void phase_ya_fixup(const float* HV, const float* HGB, const float* cw, bf16_t* YY, Frame& F) {
    PHASE_TID(F, tid, lane, gt);
    for (int idx = gt; idx < 512 * (AW / 4); idx += F.ngt) {
        const int ri = idx >> 8, c = (idx & 255) * 4, blk = ri >> 1, e = ri & 1, r = blk * 64 + e, t = r & (L - 1);
        const f32x4 zero = (f32x4){0.f, 0.f, 0.f, 0.f};
        f32x4 vm2, vm1, v0;
        if (e == 0) { vm2 = (t >= 2) ? *(const f32x4*)(HV + ((size_t)(blk - 1) * 4 + 0) * AW + c) : zero; vm1 = (t >= 1) ? *(const f32x4*)(HV + ((size_t)(blk - 1) * 4 + 1) * AW + c) : zero; v0 = *(const f32x4*)(HV + ((size_t)blk * 4 + 2) * AW + c); }
        else        { vm2 = (t >= 2) ? *(const f32x4*)(HV + ((size_t)(blk - 1) * 4 + 1) * AW + c) : zero; vm1 = *(const f32x4*)(HV + ((size_t)blk * 4 + 2) * AW + c); v0 = *(const f32x4*)(HV + ((size_t)blk * 4 + 3) * AW + c); }
        const f32x4 gb = *(const f32x4*)(HGB + ((size_t)blk * 2 + e) * AW + c);
        const f32x4 w0 = *(const f32x4*)(cw + c), w1 = *(const f32x4*)(cw + AW + c), w2 = *(const f32x4*)(cw + 2 * AW + c);
        const f32x4 a = gb * (w2 * v0 + w1 * vm1 + w0 * vm2);
        u32x2 w; w.x = cvt_pk_bf16(a[0], a[1]); w.y = cvt_pk_bf16(a[2], a[3]);
        *(u32x2*)(YY + (size_t)r * D + c) = w;
    }
}

__device__ __forceinline__ void phase_final(const bf16_t* HB, const i64* ss, const float* g, float* out, Frame& F) {
    PHASE_TID(F, tid, lane, gt);
    for (size_t i = gt; i < (size_t)M * D / 8; i += F.ngt) {
        const int row = (int)(i >> 8), c = (int)(i & 255) * 8;
        const float rs = 1.0f / sqrtf((float)ss[row] * SS_INV + EPS);
        float h[8]; unpack8(*(const u32x4*)(HB + i * 8), h);
        const f32x4 g0 = *(const f32x4*)(g + c), g1 = *(const f32x4*)(g + c + 4);
        *(f32x4*)(out + i * 8) = (f32x4){h[0], h[1], h[2], h[3]} * rs * g0; *(f32x4*)(out + i * 8 + 4) = (f32x4){h[4], h[5], h[6], h[7]} * rs * g1;
    }
}

typedef float f32x16 __attribute__((ext_vector_type(16)));
constexpr int SWA_KSTR = 144, SWA_VSTR = 520, SWA_K_OFF = 0, SWA_V_OFF = 256 * SWA_KSTR, SWA_T_OFF = SWA_V_OFF + 64 * SWA_VSTR, SWA_TLEN = 192;
__device__ __forceinline__ void phase_swa(const bf16_t* QKV, const float* rel_bias, const float* sinks, bf16_t* O, Frame& F) {
    PHASE_TID(F, tid, lane, gt);
    const float LOG2E = 1.4426950408889634f;
    LAS unsigned char* lds = F.lds;
    const int q31 = lane & 31, hf = lane >> 5;
    for (int unit = F.bid; unit < NB * 32 * NKVH; unit += F.G) {
        const int b = unit >> 7, n = (unit >> 2) & 31, kvh = unit & 3, row0 = b * L + n * 128;
#pragma unroll
        for (int i = 0; i < 4; ++i) { const int it = tid + i * NTHR, key = it >> 3, ch = it & 7;
            u32x4 v = (u32x4){0u, 0u, 0u, 0u};
            if (n > 0 || key >= 128) v = *(const u32x4*)(QKV + (size_t)(row0 - 128 + key) * ODD_IN + NQH * HD + kvh * HD + ch * 8);
            *(LAS u32x4*)(lds + SWA_K_OFF + key * SWA_KSTR + ch * 16) = v; }
#pragma unroll
        for (int i = 0; i < 2; ++i) { const int it = tid + i * NTHR, dc = it & 7, kp = it >> 3;
            u32x4 v0 = (u32x4){0u, 0u, 0u, 0u}, v1 = v0;
            if (n > 0 || kp >= 64) { const bf16_t* vp = QKV + (size_t)(row0 - 128 + 2 * kp) * ODD_IN + (NQH + NKVH) * HD + kvh * HD + dc * 8; v0 = *(const u32x4*)vp; v1 = *(const u32x4*)(vp + ODD_IN); }
            LAS unsigned char* dst = lds + SWA_V_OFF + (dc * 8) * SWA_VSTR + kp * 4;
            *(LAS unsigned*)(dst + 0 * SWA_VSTR) = (v0.x & 0xffffu) | (v1.x << 16); *(LAS unsigned*)(dst + 1 * SWA_VSTR) = (v0.x >> 16) | (v1.x & 0xffff0000u);
            *(LAS unsigned*)(dst + 2 * SWA_VSTR) = (v0.y & 0xffffu) | (v1.y << 16); *(LAS unsigned*)(dst + 3 * SWA_VSTR) = (v0.y >> 16) | (v1.y & 0xffff0000u);
            *(LAS unsigned*)(dst + 4 * SWA_VSTR) = (v0.z & 0xffffu) | (v1.z << 16); *(LAS unsigned*)(dst + 5 * SWA_VSTR) = (v0.z >> 16) | (v1.z & 0xffff0000u);
            *(LAS unsigned*)(dst + 6 * SWA_VSTR) = (v0.w & 0xffffu) | (v1.w << 16); *(LAS unsigned*)(dst + 7 * SWA_VSTR) = (v0.w >> 16) | (v1.w & 0xffff0000u); }
        for (int idx = tid; idx < 8 * SWA_TLEN; idx += NTHR) { const int g = idx / SWA_TLEN, e = idx % SWA_TLEN, rel = e - 31;
            const float v = (rel >= 0 && rel < 128) ? rel_bias[kBucket[rel] * NQH + kvh * 8 + g] * LOG2E : -1e30f;
            *(LAS float*)(lds + SWA_T_OFF + idx * 4) = v; }
        __syncthreads();
        const int hq = kvh * 8 + F.wave; const float sink2 = sinks[hq] * LOG2E;
        bf16x8 qn[4];
        { const bf16_t* qp = QKV + (size_t)(row0 + q31) * ODD_IN + hq * HD + 8 * hf;
#pragma unroll
          for (int s = 0; s < 4; ++s) qn[s] = *(const bf16x8*)(qp + 16 * s); }
#pragma unroll 1
        for (int qt = 0; qt < 4; ++qt) {
            bf16x8 qf[4];
#pragma unroll
            for (int s = 0; s < 4; ++s) qf[s] = qn[s];
            if (qt < 3) { const bf16_t* qp = QKV + (size_t)(row0 + 32 * (qt + 1) + q31) * ODD_IN + hq * HD + 8 * hf;
#pragma unroll
                for (int s = 0; s < 4; ++s) qn[s] = *(const bf16x8*)(qp + 16 * s); }
            f32x16 S[5];
#pragma unroll
            for (int dt = 0; dt < 5; ++dt) {
                const int kt = qt + dt;
                if (n == 0 && kt < 4) {
#pragma unroll
                    for (int i = 0; i < 16; ++i) S[dt][i] = -1e30f;
                } else {
                    f32x16 acc;
#pragma unroll
                    for (int i = 0; i < 16; ++i) acc[i] = 0.f;
#pragma unroll
                    for (int s = 0; s < 4; ++s) { const bf16x8 kf = *(const LAS bf16x8*)(lds + SWA_K_OFF + (32 * kt + q31) * SWA_KSTR + (16 * s + 8 * hf) * 2);
                        acc = __builtin_amdgcn_mfma_f32_32x32x16_bf16(kf, qf[s], acc, 0, 0, 0); }
                    const LAS unsigned char* tb = lds + SWA_T_OFF + (F.wave * SWA_TLEN + 159 - 32 * dt + q31 - 4 * hf - 27) * 4;
#pragma unroll
                    for (int i = 0; i < 16; ++i) S[dt][i] = acc[i] * LOG2E + *(const LAS float*)(tb + (27 - (8 * (i >> 2) + (i & 3))) * 4);
                }
            }
            float mx = sink2;
#pragma unroll
            for (int dt = 0; dt < 5; ++dt)
#pragma unroll
                for (int i = 0; i < 16; ++i) mx = fmaxf(mx, S[dt][i]);
            mx = fmaxf(mx, shx(mx, 32, lane));
            float l = 0.f;
#pragma unroll
            for (int dt = 0; dt < 5; ++dt)
#pragma unroll
                for (int i = 0; i < 16; ++i) { const float p = __builtin_amdgcn_exp2f(S[dt][i] - mx); S[dt][i] = p; l += p; }
            l += shx(l, 32, lane);
            const float inv = __builtin_amdgcn_rcpf(l + __builtin_amdgcn_exp2f(sink2 - mx));
            f32x16 oa[2];
#pragma unroll
            for (int dd = 0; dd < 2; ++dd)
#pragma unroll
                for (int i = 0; i < 16; ++i) oa[dd][i] = 0.f;
#pragma unroll
            for (int dt = 0; dt < 5; ++dt) {
                const int kt = qt + dt;
                if (!(n == 0 && kt < 4)) {
#pragma unroll
                    for (int s = 0; s < 2; ++s) {
                        u32x4 pw; pw.x = cvt_pk_bf16(S[dt][8 * s + 0], S[dt][8 * s + 1]); pw.y = cvt_pk_bf16(S[dt][8 * s + 2], S[dt][8 * s + 3]); pw.z = cvt_pk_bf16(S[dt][8 * s + 4], S[dt][8 * s + 5]); pw.w = cvt_pk_bf16(S[dt][8 * s + 6], S[dt][8 * s + 7]);
                        const bf16x8 pb = __builtin_bit_cast(bf16x8, pw);
#pragma unroll
                        for (int dd = 0; dd < 2; ++dd) {
                            const LAS unsigned char* vp = lds + SWA_V_OFF + (32 * dd + q31) * SWA_VSTR + (32 * kt + 16 * s + 4 * hf) * 2;
                            const u32x2 a0 = *(const LAS u32x2*)vp, a1 = *(const LAS u32x2*)(vp + 16);
                            const bf16x8 va = __builtin_bit_cast(bf16x8, (u32x4){a0.x, a0.y, a1.x, a1.y});
                            oa[dd] = __builtin_amdgcn_mfma_f32_32x32x16_bf16(va, pb, oa[dd], 0, 0, 0);
                        }
                    }
                }
            }
            bf16_t* op = O + (size_t)(row0 + 32 * qt + q31) * D + hq * HD + 4 * hf;
#pragma unroll
            for (int dd = 0; dd < 2; ++dd)
#pragma unroll
                for (int g4 = 0; g4 < 4; ++g4) { u32x2 w; w.x = cvt_pk_bf16(oa[dd][4 * g4 + 0] * inv, oa[dd][4 * g4 + 1] * inv); w.y = cvt_pk_bf16(oa[dd][4 * g4 + 2] * inv, oa[dd][4 * g4 + 3] * inv);
                    *(u32x2*)(op + 32 * dd + 8 * g4) = w; }
        }
        __syncthreads();
    }
}

constexpr int S5_PW_OFF = 0, S5_KC_OFF = 4608, S5_SL_OFF = 9216, S5_XB_OFF = 41984, S5_XSTR = 272;
__device__ __forceinline__ float bfe(const bf16x8& v, int j) { return __uint_as_float(((unsigned)(unsigned short)v[j]) << 16); }
template <int RT>
__device__ __forceinline__ void s5_unit(const bf16_t* Z, const float* s5p, const float* c_re, const float* c_im, const float* dvec, const float* glu, bf16_t* YY, LAS unsigned char* lds,
                                        const int b, const int g, const int wave, const int tid, const int lane) {
    const int q31 = lane & 31, hf = lane >> 5, mtl = wave >> 2;
    LAS f32x2* PW = (LAS f32x2*)(lds + S5_PW_OFF);
    { const int p = tid & 63, j = tid >> 6; const float ar = s5p[(size_t)(g * 64 + p) * 34], ai = s5p[(size_t)(g * 64 + p) * 34 + 1];
      float pr = 1.f, pi = 0.f;
      for (int k = 0; k < j; ++k) { const float nr = pr * ar - pi * ai, ni = pr * ai + pi * ar; pr = nr; pi = ni; }
      PW[j * 64 + p] = (f32x2){pr, pi};
      if (j == 7) PW[8 * 64 + p] = (f32x2){pr * ar - pi * ai, pr * ai + pi * ar}; }
    __syncthreads();
    { LAS bf16_t* KC = (LAS bf16_t*)(lds + S5_KC_OFF);
#pragma unroll 1
      for (int q = 0; q < 4; ++q) { const int e = tid + NTHR * q, jj = e >> 8, h = (e >> 4) & 15, hp = e & 15;
          const float* cr = c_re + (size_t)(g * 16 + h) * 64; const float* ci = c_im + (size_t)(g * 16 + h) * 64; const float* bb = s5p + (size_t)(g * 64) * 34 + 2 + hp;
          float sum = 0.f;
#pragma unroll 4
          for (int p = 0; p < 64; ++p) { const f32x2 pw = PW[jj * 64 + p]; const float tr = cr[p] * pw.x - ci[p] * pw.y, ti = cr[p] * pw.y + ci[p] * pw.x; sum += tr * bb[p * 34] - ti * bb[p * 34 + 16]; }
          const int pos = 8 * ((hp >> 2) & 1) + 4 * (hp >> 3) + (hp & 3);
          KC[(jj * 16 + h) * 16 + pos] = (bf16_t)(cvt_pk_bf16(sum, 0.f) & 0xffffu); }
      if (tid < 128) ((LAS unsigned*)(KC + 8 * 256))[tid] = 0u; }
    __syncthreads();
    bf16x8 pf[8], qf[8], kf[2 * RT + 2], ga[2]; float d8[8];
    {
      const int comp = 32 * RT + q31, p = comp & 63; const bool im = comp >= 64; const float* bbp = s5p + (size_t)(g * 64 + p) * 34 + 2;
      float br[8], bi[8];
#pragma unroll
      for (int j = 0; j < 8; ++j) { const int hp = 8 * (j >> 2) + 4 * hf + (j & 3); br[j] = bbp[hp]; bi[j] = bbp[16 + hp]; }
#pragma unroll
      for (int s = 0; s < 8; ++s) { const f32x2 pw = PW[(7 - s) * 64 + p]; float v[8];
#pragma unroll
          for (int j = 0; j < 8; ++j) v[j] = im ? (pw.x * bi[j] + pw.y * br[j]) : (pw.x * br[j] - pw.y * bi[j]);
          u32x4 w; w.x = cvt_pk_bf16(v[0], v[1]); w.y = cvt_pk_bf16(v[2], v[3]); w.z = cvt_pk_bf16(v[4], v[5]); w.w = cvt_pk_bf16(v[6], v[7]); pf[s] = __builtin_bit_cast(bf16x8, w); } }
    {
      const int t2 = 2 * RT + (q31 >> 4), h = q31 & 15; const float* cr = c_re + (size_t)(g * 16 + h) * 64; const float* ci = c_im + (size_t)(g * 16 + h) * 64;
#pragma unroll
      for (int ks = 0; ks < 4; ++ks) { float vr[8], vi[8];
#pragma unroll
          for (int j = 0; j < 8; ++j) { const int p = 16 * ks + 8 * hf + j; const f32x2 pw = PW[(t2 + 1) * 64 + p]; const float a = cr[p], c = ci[p]; vr[j] = a * pw.x - c * pw.y; vi[j] = -(a * pw.y + c * pw.x); }
          u32x4 w; w.x = cvt_pk_bf16(vr[0], vr[1]); w.y = cvt_pk_bf16(vr[2], vr[3]); w.z = cvt_pk_bf16(vr[4], vr[5]); w.w = cvt_pk_bf16(vr[6], vr[7]); qf[ks] = __builtin_bit_cast(bf16x8, w);
          w.x = cvt_pk_bf16(vi[0], vi[1]); w.y = cvt_pk_bf16(vi[2], vi[3]); w.z = cvt_pk_bf16(vi[4], vi[5]); w.w = cvt_pk_bf16(vi[6], vi[7]); qf[ks + 4] = __builtin_bit_cast(bf16x8, w); }
#pragma unroll
      for (int s = 0; s < 2 * RT + 2; ++s) { int jj = t2 - s; jj = jj < 0 ? 8 : jj; kf[s] = *(const LAS bf16x8*)(lds + S5_KC_OFF + ((jj * 16 + h) * 16 + 8 * hf) * 2); }
      const int o = q31 & 15, t2p = q31 >> 4;
#pragma unroll
      for (int ks = 0; ks < 2; ++ks) { float v[8];
#pragma unroll
          for (int j = 0; j < 8; ++j) { const int hh = 8 * (j >> 2) + 4 * hf + (j & 3); v[j] = (t2p == ks) ? glu[g * 256 + hh * 16 + o] : 0.f; }
          u32x4 w; w.x = cvt_pk_bf16(v[0], v[1]); w.y = cvt_pk_bf16(v[2], v[3]); w.z = cvt_pk_bf16(v[4], v[5]); w.w = cvt_pk_bf16(v[6], v[7]); ga[ks] = __builtin_bit_cast(bf16x8, w); }
#pragma unroll
      for (int j = 0; j < 8; ++j) d8[j] = dvec[g * 16 + 8 * (j >> 2) + 4 * hf + (j & 3)]; }
    const f32x2 a8 = PW[8 * 64 + lane];
    float Sre = 0.f, Sim = 0.f;
    LAS float* SL = (LAS float*)(lds + S5_SL_OFF);
#pragma unroll 1
    for (int seg = 0; seg < 8; ++seg) {
        const int mloc = mtl * 32 + q31; const size_t tok0 = (size_t)b * L + 8 * (seg * 64 + mloc);
        const bf16_t* up = Z + ((size_t)g * M + tok0) * 16 + 4 * hf;
        bf16x8 uf[8];
#pragma unroll
        for (int s = 0; s < 8; ++s) { const u32x2 lo = *(const u32x2*)(up + s * 16), hi = *(const u32x2*)(up + s * 16 + 8); uf[s] = __builtin_bit_cast(bf16x8, (u32x4){lo.x, lo.y, hi.x, hi.y}); }
        { f32x16 acc;
#pragma unroll
          for (int i = 0; i < 16; ++i) acc[i] = 0.f;
#pragma unroll
          for (int s = 0; s < 8; ++s) acc = __builtin_amdgcn_mfma_f32_32x32x16_bf16(uf[s], pf[s], acc, 0, 0, 0);
#pragma unroll
          for (int i = 0; i < 16; ++i) SL[(mtl * 32 + 8 * (i >> 2) + 4 * hf + (i & 3)) * 128 + 32 * RT + q31] = acc[i]; }
        __syncthreads();
        if (wave == 0) {
#pragma unroll 1
            for (int blk = 0; blk < 8; ++blk) { float lr[8], li[8];
#pragma unroll
                for (int k = 0; k < 8; ++k) { lr[k] = SL[(blk * 8 + k) * 128 + lane]; li[k] = SL[(blk * 8 + k) * 128 + 64 + lane]; }
#pragma unroll
                for (int k = 0; k < 8; ++k) { LAS bf16_t* xr = (LAS bf16_t*)(lds + S5_XB_OFF + (blk * 8 + k) * S5_XSTR);
                    const unsigned w = cvt_pk_bf16(Sre, Sim); xr[lane] = (bf16_t)(w & 0xffffu); xr[64 + lane] = (bf16_t)(w >> 16);
                    const float nr = a8.x * Sre - a8.y * Sim + lr[k], ni = a8.x * Sim + a8.y * Sre + li[k]; Sre = nr; Sim = ni; } } }
        __syncthreads();
        { f32x16 acc;
#pragma unroll
          for (int i = 0; i < 16; ++i) acc[i] = 0.f;
#pragma unroll
          for (int s = 0; s < 2 * RT + 2; ++s) acc = __builtin_amdgcn_mfma_f32_32x32x16_bf16(kf[s], uf[s], acc, 0, 0, 0);
#pragma unroll
          for (int ks = 0; ks < 8; ++ks) { const bf16x8 xf = *(const LAS bf16x8*)(lds + S5_XB_OFF + mloc * S5_XSTR + (16 * ks + 8 * hf) * 2); acc = __builtin_amdgcn_mfma_f32_32x32x16_bf16(qf[ks], xf, acc, 0, 0, 0); }
          float yg[16];
#pragma unroll
          for (int i = 0; i < 16; ++i) yg[i] = gelu_tanh_f(acc[i] + d8[i & 7] * bfe(uf[2 * RT + (i >> 3)], i & 7));
          f32x16 gt;
#pragma unroll
          for (int i = 0; i < 16; ++i) gt[i] = 0.f;
#pragma unroll
          for (int ks = 0; ks < 2; ++ks) { u32x4 w; w.x = cvt_pk_bf16(yg[8 * ks + 0], yg[8 * ks + 1]); w.y = cvt_pk_bf16(yg[8 * ks + 2], yg[8 * ks + 3]); w.z = cvt_pk_bf16(yg[8 * ks + 4], yg[8 * ks + 5]); w.w = cvt_pk_bf16(yg[8 * ks + 6], yg[8 * ks + 7]);
              gt = __builtin_amdgcn_mfma_f32_32x32x16_bf16(ga[ks], __builtin_bit_cast(bf16x8, w), gt, 0, 0, 0); }
          bf16_t* op = YY + (tok0 + 2 * RT) * D + AW + g * 16 + 4 * hf;
#pragma unroll
          for (int t2l = 0; t2l < 2; ++t2l)
#pragma unroll
              for (int grp = 0; grp < 2; ++grp) { const int i0 = 8 * t2l + 4 * grp; float o[4];
#pragma unroll
                  for (int r = 0; r < 4; ++r) o[r] = yg[i0 + r] * fast_sigmoid(gt[i0 + r]);
                  u32x2 w; w.x = cvt_pk_bf16(o[0], o[1]); w.y = cvt_pk_bf16(o[2], o[3]);
                  *(u32x2*)(op + (size_t)t2l * D + 8 * grp) = w; } }
    }
    __syncthreads();
}
__device__ __forceinline__ void phase_s5(const bf16_t* Z, const float* s5p, const float* c_re, const float* c_im, const float* dvec, const float* glu, bf16_t* YY, Frame& F) {
    PHASE_TID(F, tid, lane, gt);
    for (int unit = F.bid; unit < NB * S5G; unit += F.G) {
        const int b = unit / S5G, g = unit % S5G;
        switch (F.wave & 3) {
            case 0: s5_unit<0>(Z, s5p, c_re, c_im, dvec, glu, YY, F.lds, b, g, F.wave, tid, lane); break;
            case 1: s5_unit<1>(Z, s5p, c_re, c_im, dvec, glu, YY, F.lds, b, g, F.wave, tid, lane); break;
            case 2: s5_unit<2>(Z, s5p, c_re, c_im, dvec, glu, YY, F.lds, b, g, F.wave, tid, lane); break;
            default: s5_unit<3>(Z, s5p, c_re, c_im, dvec, glu, YY, F.lds, b, g, F.wave, tid, lane); break;
        }
    }
}
namespace pg8 {
struct SchedKV {
    unsigned char* ws; int G, c;
    __device__ __forceinline__ bool next(int i, Unit& u) const {
        const long Lx = (long)i * G + c; if (Lx >= 256) return false;
        const int l = (int)Lx >> 6, rem = (int)Lx & 63, pm = rem >> 4, pn = rem & 15;
        u.A = (const char*)(ws + WS_MEMN) + (size_t)pm * 256 * D * 2;
        u.B = (const char*)(ws + WS_WKV_T) + ((size_t)l * 2 * D + pn * 256) * D * 2;
        u.C = (char*)(ws + WS_KVM) + (pn >= 8 ? 16 * MiB : 0) + (((size_t)l * MROWS + pm * 256) * D + (pn & 7) * 256) * 2;
        u.vec = nullptr; u.row0 = pm * 256; u.col0 = pn * 256; u.aux = D; return true;
    }
};
struct SchedWSVW {
    unsigned char* ws; const float* gx; int G, c;
    __device__ __forceinline__ bool next(int i, Unit& u) const {
        const long Lx = (long)i * G + c; if (Lx >= 1024) return false;
        const int j = (int)Lx & 511, z = j >> 3, pt = j & 7, l = z >> 4, b = (z >> 2) & 3, head = z & 3;
        if (Lx < 512) {
            u.A = (const char*)(ws + WS_KVM) + (((size_t)l * MROWS + b * 256) * D + head * XHD) * 2;
            u.B = (const char*)(ws + WS_WQ_BF) + (((size_t)l * D + pt * 256) * D + head * XHD) * 2;
            u.C = (char*)(ws + WS_WS) + ((((size_t)(l * 4 + b) * 1024 + head * 256) * D) + pt * 256) * 2;
            u.vec = gx + l * D; u.row0 = 0; u.col0 = pt * 256; u.aux = D;
        } else {
            u.A = (const char*)(ws + WS_WO_T) + (((size_t)l * D + pt * 256) * D + head * XHD) * 2;
            u.B = (const char*)(ws + WS_KVM) + 16 * MiB + (((size_t)l * MROWS + b * 256) * D + head * XHD) * 2;
            u.C = (char*)(ws + WS_VW) + ((((size_t)(l * 4 + b) * D + pt * 256) * 1024) + head * 256) * 2;
            u.vec = nullptr; u.row0 = 0; u.col0 = 0; u.aux = 1024;
        }
        return true;
    }
};
}

#ifndef NO_PKF32
#define NO_PKF32 1
#endif
#if NO_PKF32 && defined(__HIP_DEVICE_COMPILE__)
#define MEGA_TGT __attribute__((target("no-packed-fp32-ops")))
#else
#define MEGA_TGT
#endif
__global__ void __launch_bounds__(NTHR, 2) MEGA_TGT mega_fwd(Args a) {
    extern __shared__ __attribute__((aligned(16))) unsigned char lds_raw[];
    Frame F;
    F.lds = (LAS unsigned char*)lds_raw;
    const int tid0 = threadIdx.x; F.wave = __builtin_amdgcn_readfirstlane(tid0 >> 6);
    F.G = gridDim.x; F.bid = blockIdx.x;
    F.gw = F.bid * NWAVES + F.wave; F.ngw = F.G * NWAVES; F.ngt = F.G * NTHR;
    unsigned char* ws = a.ws;
    volatile LAS unsigned* MISC = (volatile LAS unsigned*)(F.lds + MISC_OFF);
    for (int u = tid0; u < (LDS_BYTES - MISC_OFF) / 4; u += NTHR) ((LAS unsigned*)(F.lds + MISC_OFF))[u] = 0u;
    __syncthreads();
    unsigned* ctl = (unsigned*)(ws + WS_CTL);
    const XcdBarrier bar = xcd_barrier_post(ctl + CW_BAR, MISC + 8, F.wave);
    static_assert(8 * 16640 <= MISC_OFF, "prologue scratch below the control words");
    static_assert((CW_BAR + XCD_BAR_WORDS) * 4 <= (int)CTL_ZERO_BYTES, "barrier words inside the memset region");
#define GRID_BAR() do { xcd_barrier(bar); if (PROBE_BAR) xcd_barrier(bar); } while (0)

    i64* SS = (i64*)(ws + WS_SS);
    bf16_t* HB = (bf16_t*)(ws + WS_HB); bf16_t* YY = (bf16_t*)(ws + WS_YY);
    bf16_t* BIG = (bf16_t*)(ws + WS_BIG);
    float* HG = (float*)(ws + WS_HALO_G); float* HU = (float*)(ws + WS_HALO_U);
    float* DUMF = (float*)(ws + WS_END); bf16_t* DUMB = (bf16_t*)(ws + WS_END); (void)DUMF; (void)DUMB;
    const int cid = (int)blockIdx.x;

#ifndef PHMASK
#define PHMASK 0xFFFF
#endif
#ifndef PROBE_DUP
#define PROBE_DUP 0
#endif
#ifndef PROBE_KONLY
#define PROBE_KONLY 0
#endif
#ifndef F1_ALIGN
#define F1_ALIGN true
#endif
#ifndef F2_WGM
#define F2_WGM 4
#endif
#ifndef PROBE_BAR
#define PROBE_BAR 0
#endif
#define REP(bit) for (int rep_ = 0; rep_ < (((PROBE_DUP) & (bit)) ? 2 : 1); ++rep_)
    REP(1) if (PHMASK & 1) p0_prologue(a, F);
    GRID_BAR();
    for (int l = 0; l < 4; ++l) {
        const int i = l >> 1;
        if ((l & 1) == 0) {
            if (l == 0 && (PHMASK & 2)) { pg8::SchedKV S{ws, F.G, cid}; pg8::EpiPlain E;
              pg8::gemm_phase<pg8::EpiPlain, pg8::SchedKV, true>(F.lds, F.wave, D, D, D, S, E); }
            REP(8) if (PHMASK & 8) { pg8::SchedMain S{(const char*)HB, (const char*)(ws + WS_WIN_T) + (size_t)i * EVEN_IN * D * 2, nullptr, (size_t)256 * D * 2, (size_t)256 * D * 2, 0, 0, 0, 64, 16, 64, 64, F.G, cid};
              pg8::EpiEven E{SS + (size_t)(3 * l) * M, a.in[9] + (size_t)i * 3 * AW, YY, BIG, HG, HG + 2 * MiB};
              pg8::gemm_phase<pg8::EpiEven, pg8::SchedMain, true>(F.lds, F.wave, D, D, D, S, E); }
            GRID_BAR();
            if (l == 0 && (PHMASK & 4)) { pg8::SchedWSVW S{ws, (const float*)(ws + WS_GXS), F.G, cid}; pg8::EpiPlain E;
              pg8::gemm_phase<pg8::EpiPlain, pg8::SchedWSVW, true>(F.lds, F.wave, D, D, XHD, S, E); }
            REP(16) if (PHMASK & 16) phase_ya_fixup(HG, HG + 2 * MiB, a.in[9] + (size_t)i * 3 * AW, YY, F);
            REP(32) if (PHMASK & 32) phase_s5(BIG, (const float*)(ws + WS_S5P) + (size_t)i * 4096 * 34, a.in[15] + (size_t)i * 65536, a.in[16] + (size_t)i * 65536, a.in[17] + i * 1024, a.in[18] + (size_t)i * 16384, YY, F);
            GRID_BAR();
        } else {
            REP(64) if (PHMASK & 64) { pg8::SchedMain S{(const char*)HB, (const char*)(ws + WS_WQKV_T) + (size_t)i * ODD_IN * D * 2, (char*)BIG, (size_t)256 * D * 2, (size_t)256 * D * 2, 0, (size_t)256 * ODD_IN * 2, 256 * 2, 64, 10, 64, 256, F.G, cid};
              pg8::EpiRowScale E{SS + (size_t)(3 * l) * M, (const float*)(ws + WS_QKVB) + i * ODD_IN, ODD_IN};
              pg8::gemm_phase<pg8::EpiRowScale, pg8::SchedMain, true>(F.lds, F.wave, D, D, D, S, E); }
            GRID_BAR();
            REP(128) if (PHMASK & 128) phase_swa(BIG, a.in[7], a.in[22] + i * NQH, YY, F);
            GRID_BAR();
        }
        REP(256) if (PHMASK & 256) { const char* Bw = (l & 1) ? (const char*)(ws + WS_OWOUT_T) + (size_t)i * D * D * 2 : (const char*)(ws + WS_EWOUT_T) + (size_t)i * D * D * 2;
          pg8::SchedMain S{(const char*)YY, Bw, nullptr, (size_t)256 * D * 2, (size_t)256 * D * 2, 0, 0, 0, 64, 8, 64, 256, F.G, cid};
          pg8::EpiRes E{HB, rep_ ? DUMB : HB, SS + (size_t)(rep_ ? 13 : 3 * l + 1) * M, F.lds + RING_BYTES};
          pg8::gemm_phase<pg8::EpiRes, pg8::SchedMain, true>(F.lds, F.wave, D, D, D, S, E); }
        GRID_BAR();
        REP(512) if (PHMASK & 512) { pg8::SchedMain S{(const char*)HB, (const char*)(ws + WS_WS) + (size_t)l * 4 * 1024 * D * 2, (char*)BIG, (size_t)256 * D * 2, (size_t)256 * D * 2, (size_t)1024 * D * 2, (size_t)256 * 1024 * 2, 256 * 2, 64, 4, 16, 256, F.G, cid};
          pg8::EpiSoftmax E{SS + (size_t)(3 * l + 1) * M, 1024};
          pg8::gemm_phase<pg8::EpiSoftmax, pg8::SchedMain, false>(F.lds, F.wave, D, D, D, S, E); }
        GRID_BAR();
        REP(1024) if (PHMASK & 1024) { pg8::SchedMain S{(const char*)BIG, (const char*)(ws + WS_VW) + (size_t)l * 4 * D * 1024 * 2, nullptr, (size_t)256 * 1024 * 2, (size_t)256 * 1024 * 2, (size_t)D * 1024 * 2, 0, 0, 64, 8, 16, 256, F.G, cid};
          pg8::EpiRes E{HB, rep_ ? DUMB : HB, SS + (size_t)(rep_ ? 13 : 3 * l + 2) * M, F.lds + RING_BYTES};
          pg8::gemm_phase<pg8::EpiRes, pg8::SchedMain, true>(F.lds, F.wave, 1024, 1024, 1024, S, E); }
        GRID_BAR();
        REP(2048) if (PHMASK & 2048) { pg8::SchedMain S{(const char*)HB, (const char*)(ws + WS_WGU_T) + (size_t)l * NGU * D * 2, (char*)BIG, (size_t)256 * D * 2, (size_t)256 * D * 2, 0, (size_t)256 * DFF * 2, 128 * 2, 64, 44, 64, 128, F.G, cid};
          {
            PHASE_TID(F, tid, lane, gt); pg8::Unit fu; int nslots = 0, lastpm = -1;
            const float* cwp = a.in[29] + (size_t)l * 3 * DFF; const float* cbp = a.in[30] + (size_t)l * DFF; const i64* ssp = SS + (size_t)(3 * l + 2) * M;
            for (int ui = 0; ui < 12 && S.next(ui, fu); ++ui) {
                const int pm = fu.row0 >> 8;
                if (pm != lastpm && nslots < 3) { if (tid < 256) ((LAS float*)(F.lds + F1_RST_OFF))[nslots * 256 + tid] = rstd_of(ssp[pm * 256 + tid]); ++nslots; lastpm = pm; }
                if (tid == 0) ((LAS int*)(F.lds + F1_SLOT_OFF))[ui] = nslots - 1;
                const int vec = tid >> 7, ch = tid & 127;
                ((LAS float*)(F.lds + F1_CWT_OFF))[ui * 512 + tid] = (vec < 3 ? cwp[vec * DFF + fu.col0 + ch] : cbp[fu.col0 + ch]) * 1.4426950408889634f;
            }
            LDS_WAIT(); __syncthreads(); }
          pg8::EpiMLP E{F.lds, HG, HU};
          pg8::gemm_phase<pg8::EpiMLP, pg8::SchedMain, F1_ALIGN>(F.lds, F.wave, D, D, D, S, E);
          if (PROBE_KONLY & 2048) { pg8::EpiNull E0; pg8::gemm_phase<pg8::EpiNull, pg8::SchedMain, true>(F.lds, F.wave, D, D, D, S, E0); } }
        GRID_BAR();
        if (PHMASK & 4096) phase_mlp_fixup(HG, HU, a.in[29] + (size_t)l * 3 * DFF, a.in[30] + (size_t)l * DFF, BIG, F);
        GRID_BAR();
        REP(8192) if (PHMASK & 8192) { pg8::SchedMain S{(const char*)BIG, (const char*)(ws + WS_WDOWN_T) + (size_t)l * D * DFF * 2, nullptr, (size_t)256 * DFF * 2, (size_t)256 * DFF * 2, 0, 0, 0, 64, 8, 64, 256, F.G, cid, F2_WGM};
          pg8::EpiRes E{HB, rep_ ? DUMB : HB, SS + (size_t)(rep_ ? 13 : 3 * l + 3) * M, F.lds + RING_BYTES};
          pg8::gemm_phase<pg8::EpiRes, pg8::SchedMain, true>(F.lds, F.wave, DFF, DFF, DFF, S, E); }
        GRID_BAR();
    }
    if (PHMASK & 16384) phase_final(HB, SS + (size_t)12 * M, a.in[5], a.out, F);
#undef GRID_BAR
}

extern "C" void kernel_launch(void* const* d_in, const int* in_sizes, int n_in, void* d_out, int out_size, void* d_ws, size_t ws_size, hipStream_t stream) {
    static int grid = 0;
    if (grid == 0) {
        if (n_in != 32 || out_size != M * D || ws_size < WS_END) { fprintf(stderr, "kernel_launch: unexpected shapes (n_in %d out %d ws %zu)\n", n_in, out_size, ws_size); grid = -1; return; }
        int dev = 0, cus = 0, per_cu = 0;
        if (hipGetDevice(&dev) != hipSuccess || hipDeviceGetAttribute(&cus, hipDeviceAttributeMultiprocessorCount, dev) != hipSuccess) { grid = -1; return; }
        if (hipFuncSetAttribute((const void*)mega_fwd, hipFuncAttributeMaxDynamicSharedMemorySize, LDS_BYTES) != hipSuccess) { fprintf(stderr, "kernel_launch: hipFuncSetAttribute failed\n"); grid = -1; return; }
        if (hipOccupancyMaxActiveBlocksPerMultiprocessor(&per_cu, (const void*)mega_fwd, NTHR, LDS_BYTES) != hipSuccess || per_cu < 1) { fprintf(stderr, "kernel_launch: occupancy query says %d\n", per_cu); }
        (void)hipGetLastError();
        grid = cus;
    }
    if (grid < 0) return;
    if (hipMemsetAsync((char*)d_ws + WS_CTL, 0, CTL_ZERO_BYTES, stream) != hipSuccess) return;
    Args a{};
    for (int i = 0; i < 32; ++i) a.in[i] = (const float*)d_in[i];
    a.out = (float*)d_out; a.ws = (unsigned char*)d_ws;
    hipLaunchKernelGGL(mega_fwd, dim3(grid), dim3(NTHR), LDS_BYTES, stream, a);
}
```

```cpp
#include <hip/hip_runtime.h>
#include <stdint.h>
#include <stdio.h>

#define LAS __attribute__((address_space(3)))
#define GAS __attribute__((address_space(1)))
typedef unsigned short bf16_t;
typedef short bf16x8 __attribute__((ext_vector_type(8)));
typedef float f32x4 __attribute__((ext_vector_type(4)));
typedef float f32x2 __attribute__((ext_vector_type(2)));
typedef unsigned u32x4 __attribute__((ext_vector_type(4)));
typedef unsigned u32x2 __attribute__((ext_vector_type(2)));
typedef GAS unsigned gu32;

constexpr int D = 2048, NB = 4, L = 4096, M = NB * L, NMEM = 256, MROWS = NB * NMEM;
constexpr int AW = 1024, S5G = 64, EVEN_IN = 4096;
constexpr int HD = 64, NQH = 32, NKVH = 4, ODD_IN = 2560;
constexpr int XH = 4, XHD = 512, DFF = 5632, NGU = 2 * DFF;
constexpr float EPS = 1e-5f;
constexpr int NWAVES = 8, NTHR = 512;

constexpr size_t MiB = 1u << 20;
constexpr size_t WS_CTL = 0, CTL_ZERO_BYTES = 32768;
constexpr size_t WS_QKVB = 1 * MiB;
constexpr size_t WS_GXS = 1 * MiB + 64 * 1024;
constexpr size_t WS_WIN_T = 2 * MiB;
constexpr size_t WS_EWOUT_T = 34 * MiB;
constexpr size_t WS_WQKV_T = 50 * MiB;
constexpr size_t WS_OWOUT_T = 70 * MiB;
constexpr size_t WS_WS = 86 * MiB;
constexpr size_t WS_VW = 150 * MiB;
constexpr size_t WS_WGU_T = 214 * MiB;
constexpr size_t WS_WDOWN_T = 390 * MiB;
constexpr size_t WS_H = 478 * MiB;
constexpr size_t WS_HB = 606 * MiB;
constexpr size_t WS_YY = 670 * MiB;
constexpr size_t WS_BIG = 734 * MiB;
constexpr size_t WS_WQ_BF = WS_H;
constexpr size_t WS_WKV_T = WS_H + 32 * MiB;
constexpr size_t WS_WO_T = WS_H + 96 * MiB;
constexpr size_t WS_KVM = 952 * MiB;
constexpr size_t WS_MEMN = 984 * MiB;
constexpr size_t WS_HALO_G = 910 * MiB;
constexpr size_t WS_HALO_U = 934 * MiB;
constexpr size_t WS_S5P = 946 * MiB;
constexpr size_t WS_SS = 948 * MiB;
constexpr size_t WS_END = 990 * MiB;

constexpr int CW_BAR = 4096;

constexpr int RING_BYTES = 131072;
constexpr int LDS_BYTES = 163840;
constexpr int MISC_OFF = LDS_BYTES - 256;
constexpr int F1_CWT_OFF = RING_BYTES, F1_RST_OFF = RING_BYTES + 12 * 2048, F1_SLOT_OFF = F1_RST_OFF + 3 * 1024;

#define RLX_AGENT __ATOMIC_RELAXED, __HIP_MEMORY_SCOPE_AGENT
#define LDS_WAIT() asm volatile("s_waitcnt lgkmcnt(0)" ::: "memory")
#define VM_WAIT() asm volatile("s_waitcnt vmcnt(0)" ::: "memory")
__device__ __forceinline__ unsigned cvt_pk_bf16(float lo, float hi) { unsigned r; asm volatile("v_cvt_pk_bf16_f32 %0, %1, %2" : "=v"(r) : "v"(lo), "v"(hi)); return r; }
__device__ __forceinline__ float bf_lo(unsigned w) { return __uint_as_float(w << 16); }
__device__ __forceinline__ float bf_hi(unsigned w) { return __uint_as_float(w & 0xffff0000u); }
__device__ __forceinline__ float bf1(bf16_t b) { return __uint_as_float(((unsigned)b) << 16); }
__device__ __forceinline__ float shx(float v, int mask, int lane) { return __builtin_bit_cast(float, __builtin_amdgcn_ds_bpermute((lane ^ mask) << 2, __builtin_bit_cast(int, v))); }
__device__ __forceinline__ float shl_(float v, int src, int lane) { (void)lane; return __builtin_bit_cast(float, __builtin_amdgcn_ds_bpermute(src << 2, __builtin_bit_cast(int, v))); }
__device__ __forceinline__ float wave_sum(float v, int lane) {
#pragma unroll
    for (int o = 1; o < 64; o <<= 1) v += shx(v, o, lane);
    return v;
}
__device__ __forceinline__ float wave_max(float v, int lane) {
#pragma unroll
    for (int o = 1; o < 64; o <<= 1) v = fmaxf(v, shx(v, o, lane));
    return v;
}
__device__ __forceinline__ float fast_exp(float x) { return __builtin_amdgcn_exp2f(x * 1.4426950408889634f); }
__device__ __forceinline__ float fast_sigmoid(float x) { return __builtin_amdgcn_rcpf(1.0f + fast_exp(-x)); }
__device__ __forceinline__ float gelu_tanh_f(float y) { const float u = 0.7978845608028654f * (y + 0.044715f * y * y * y); return y * fast_sigmoid(2.0f * u); }

__device__ const unsigned char kBucket[128] = {
 0,1,2,3,4,5,6,7,8,9,10,11,12,13,14,15,
 16,16,16,17,17,18,18,18,19,19,19,20,20,20,20,21,21,21,21,22,22,22,22,22,
 23,23,23,23,23,23,24,24,24,24,24,24,25,25,25,25,25,25,25,26,26,26,26,26,
 26,26,26,27,27,27,27,27,27,27,27,27,27,28,28,28,28,28,28,28,28,28,28,29,
 29,29,29,29,29,29,29,29,29,29,29,30,30,30,30,30,30,30,30,30,30,30,30,30,
 30,31,31,31,31,31,31,31,31,31,31,31,31,31,31,31};

typedef long long i64;
constexpr float SS_SCALE = 16777216.0f, SS_INV = 1.0f / (16777216.0f * 2048.0f);
__device__ __forceinline__ float rstd_of(const i64 v) { return __builtin_amdgcn_rsqf((float)v * SS_INV + EPS); }
__device__ __forceinline__ int lane_id() { return (int)__builtin_amdgcn_mbcnt_hi(~0u, __builtin_amdgcn_mbcnt_lo(~0u, 0u)); }
#define XB_TMO      128
#define XB_XCNT(j)  (256  + 64 * (j))
#define XB_XSUB(j)  (1280 + 64 * (j))
#define XB_XGEN(j)  (2304 + 64 * (j))
#define XB_TOP      3328
#define XB_TOPGEN   3392
#define XCD_BAR_WORDS 3456
#define XB_SPIN_CAP (1u << 22)

__device__ __forceinline__ unsigned xb_ld(unsigned* p)              { return __hip_atomic_load(p, __ATOMIC_RELAXED, __HIP_MEMORY_SCOPE_AGENT); }
__device__ __forceinline__ unsigned xb_add(unsigned* p, unsigned v) { return __hip_atomic_fetch_add(p, v, __ATOMIC_RELAXED, __HIP_MEMORY_SCOPE_AGENT); }
__device__ __forceinline__ unsigned xb_xcc_id() { return (unsigned)__builtin_amdgcn_s_getreg((3 << 11) | 20) & 0xFu; }
#define XB_SPIN(cond, bar) do { unsigned _sp = 0; while (cond) { __builtin_amdgcn_s_sleep(1); \
    if ((++_sp & 255u) == 0u) { if (xb_ld(&(bar)[XB_TMO])) break; if (_sp > XB_SPIN_CAP) { atomicAdd(&(bar)[XB_TMO], 1u); break; } } } } while (0)

struct XcdBarrier { unsigned* bar; unsigned x; volatile LAS unsigned* st; int wave; };

__device__ __forceinline__ XcdBarrier xcd_barrier_post(unsigned* bar, volatile LAS unsigned* st, int wave) {
    XcdBarrier b; b.bar = bar; b.x = xb_xcc_id(); b.st = st; b.wave = wave;
    if (wave == 0 && lane_id() == 0) (void)xb_add(&bar[XB_XCNT(b.x)], 1u);
    return b;
}
__device__ __forceinline__ void xcd_barrier_complete(unsigned* bar, unsigned x, unsigned& nloc, unsigned& nx) {
    const unsigned G = gridDim.x * gridDim.y * gridDim.z;
    unsigned sum, cnt, mine, sp = 0u;
    for (;;) {
        sum = 0u; cnt = 0u; mine = 0u;
#pragma unroll
        for (unsigned j = 0; j < 16; ++j) { const unsigned c = xb_ld(&bar[XB_XCNT(j)]); sum += c; cnt += (c > 0u) ? 1u : 0u; mine = (j == x) ? c : mine; }
        if (sum == G) break;
        __builtin_amdgcn_s_sleep(1);
        if ((++sp & 255u) == 0u) { if (xb_ld(&bar[XB_TMO])) break; if (sp > XB_SPIN_CAP) { atomicAdd(&bar[XB_TMO], 1u); break; } }
    }
    nloc = mine > 0u ? mine : 1u; nx = cnt > 0u ? cnt : 1u;
}
__device__ __forceinline__ void xcd_barrier(const XcdBarrier& b) {
    asm volatile("s_waitcnt vmcnt(0)" ::: "memory");
    __syncthreads();
    int wv = b.wave; asm volatile("" : "+s"(wv));
    if (wv == 0 && lane_id() == 0) {
        unsigned* bar = b.bar; asm volatile("" : "+s"(bar));
        const unsigned bx = xb_xcc_id();
        __builtin_amdgcn_s_waitcnt(0);
        unsigned nloc = b.st[0], nx = b.st[1];
        if (nloc == 0u) { xcd_barrier_complete(bar, bx, nloc, nx); b.st[0] = nloc; b.st[1] = nx; }
        const unsigned old = xb_add(&bar[XB_XSUB(bx)], 1u);
        const unsigned gen = old / nloc;
        if (old + 1u == (gen + 1u) * nloc) {
            __builtin_amdgcn_fence(__ATOMIC_RELEASE, "agent");
            asm volatile("s_waitcnt vmcnt(0)" ::: "memory");
            const unsigned og = xb_add(&bar[XB_TOP], 1u);
            const unsigned tg = og / nx;
            if (og + 1u == (tg + 1u) * nx) xb_add(&bar[XB_TOPGEN], 1u);
            else XB_SPIN(xb_ld(&bar[XB_TOPGEN]) == tg, bar);
            __builtin_amdgcn_fence(__ATOMIC_ACQUIRE, "agent");
            xb_add(&bar[XB_XGEN(bx)], 1u);
            asm volatile("s_waitcnt vmcnt(0)" ::: "memory");
        } else {
            XB_SPIN(xb_ld(&bar[XB_XGEN(bx)]) == gen, bar);
            __builtin_amdgcn_fence(__ATOMIC_ACQUIRE, "agent");
            asm volatile("s_waitcnt vmcnt(0)" ::: "memory");
        }
    }
    __syncthreads();
}

namespace pg8 {
constexpr int BM = 256, BK = 64, HALF = 128, HTB = HALF * BK * 2, STAGE_BYTES = 8 * HTB, NXCD = 8, WGM = 8;
__host__ __device__ __forceinline__ int lds_byte(int r, int c) { const int st = (r >> 4) * 2 + (c >> 5), rr = r & 15, cc = c & 31, ob = rr * 64 + cc * 2; return st * 1024 + (ob ^ (((ob >> 9) & 1) << 5)); }
__host__ __device__ __forceinline__ void stage_rc(int b, int& R, int& C) { const int st = b / 1024, sb = b % 1024, swz = sb ^ (((sb >> 9) & 1) << 5); R = (st >> 1) * 16 + swz / 64; C = (st & 1) * 32 + (swz % 64) / 2; }
__host__ __device__ __forceinline__ int perm32(int rho) { const int n = rho >> 4, i = rho & 15; return 8 * (i >> 2) + 4 * n + (i & 3); }

struct Unit { const char* A; const char* B; char* C; const float* vec; int row0, col0, aux; };

__device__ __forceinline__ void tile_of(int wgid, int nM, int nN, int& pm, int& pn, const int WGM = 8) {
    const int nwg = nM * nN;
    { const int q = nwg / NXCD, r = nwg % NXCD, xcd = wgid % NXCD, off = wgid / NXCD; wgid = (xcd < r ? xcd * (q + 1) : r * (q + 1) + (xcd - r) * q) + off; }
    const int nig = WGM * nN, gid = wgid / nig, fm = gid * WGM, gsz = (nM - fm) < WGM ? (nM - fm) : WGM;
    pm = fm + ((wgid % nig) % gsz); pn = (wgid % nig) / gsz;
}

template <class Epi, class Sched, bool ALIGN_EPI>
__device__ __forceinline__ void gemm_phase(LAS unsigned char* lds, const int wave_, const int lda, const int ldb, const int K, const Sched& S, const Epi& E) {
    int lane_ = lane_id(); asm volatile("" : "+v"(lane_));
    int wv_ = wave_; asm volatile("" : "+s"(wv_));
    const int wid = wv_, lane = lane_, tid = wid * 64 + lane, wr = wid >> 2, wc = wid & 3, fr = lane & 15, fq = lane >> 4;
    const int nt = K / BK;
    unsigned voffA[2], voffB[2];
#pragma unroll
    for (int i = 0; i < 2; ++i) { int R, C; stage_rc(tid * 16 + i * 8192, R, C); const int Rb = (R & ~31) + perm32(R & 31);
        const int Ra = Epi::APERM ? ((R & ~63) + 4 * (R & 15) + ((R >> 4) & 3)) : R;
        voffA[i] = (unsigned)(Ra * lda + C) * 2u; voffB[i] = (unsigned)(Rb * ldb + C) * 2u; }
    const size_t kstep = (size_t)(BK * 2);
    const size_t hsA = (size_t)HALF * lda * 2, hsB = (size_t)HALF * ldb * 2;
    const unsigned ldsw = (unsigned)wid * 1024u;
    const int aoff = lds_byte(wr * 64 + fr, fq * 8), boff = lds_byte(wc * 32 + fr, fq * 8);
#define PG8_SA(b, h) (((b) * 2 + (h)) * HTB)
#define PG8_SB(b, h) ((4 + (b) * 2 + (h)) * HTB)
#define PG8_STAGE(bufoff, gbase, voff) do { _Pragma("unroll") for (int _i = 0; _i < 2; ++_i) \
        __builtin_amdgcn_global_load_lds((const unsigned*)((const char*)(gbase) + (voff)[_i]), (LAS unsigned*)(lds + (bufoff) + ldsw + _i * 8192), 16, 0, 0); } while (0)
#define PG8_LDA(dst, b, h) do { _Pragma("unroll") for (int m = 0; m < 4; ++m) _Pragma("unroll") for (int k = 0; k < 2; ++k) dst[m][k] = *(const LAS bf16x8*)(lds + PG8_SA(b, h) + aoff + m * 2048 + k * 1024); } while (0)
#define PG8_LDB(dst, b, h) do { _Pragma("unroll") for (int n = 0; n < 2; ++n) _Pragma("unroll") for (int k = 0; k < 2; ++k) dst[n][k] = *(const LAS bf16x8*)(lds + PG8_SB(b, h) + boff + n * 2048 + k * 1024); } while (0)
#define PG8_MMA(ai, bj, At, Bt) do { __builtin_amdgcn_s_setprio(1); _Pragma("unroll") for (int m = 0; m < 4; ++m) _Pragma("unroll") for (int n = 0; n < 2; ++n) _Pragma("unroll") for (int k = 0; k < 2; ++k) \
        acc[ai][bj][m][n] = __builtin_amdgcn_mfma_f32_16x16x32_bf16(Bt[n][k], At[m][k], acc[ai][bj][m][n], 0, 0, 0); __builtin_amdgcn_s_setprio(0); } while (0)
#define PG8_WAIT_V(n) asm volatile("s_waitcnt vmcnt(" #n ")" ::: "memory")
#define PG8_WAIT_L(n) asm volatile("s_waitcnt lgkmcnt(" #n ")" ::: "memory")
#define PG8_BAR __builtin_amdgcn_s_barrier()
#define PG8_SCHED __builtin_amdgcn_sched_barrier(0)
    Unit cur, nxt; int ui = 0;
    if (!S.next(0, cur)) return;
    f32x4 acc[2][2][4][2];
    if constexpr (Epi::PRELOAD) E.preload(acc, cur, wr, wc);
    else {
#pragma unroll
    for (int a = 0; a < 2; ++a)
#pragma unroll
        for (int b = 0; b < 2; ++b)
#pragma unroll
            for (int m = 0; m < 4; ++m)
#pragma unroll
                for (int n = 0; n < 2; ++n) acc[a][b][m][n] = (f32x4){0.f, 0.f, 0.f, 0.f};
    }
    bf16x8 At[4][2], B0[2][2], B1[2][2];
    const char* cA = cur.A; const char* cB = cur.B;
#ifndef GEMM_SP2
#define GEMM_SP2 1
#endif
    constexpr bool SP2 = GEMM_SP2;
    if constexpr (SP2) {
    PG8_STAGE(PG8_SB(0, 0), cB, voffB); PG8_STAGE(PG8_SB(0, 1), cB + hsB, voffB); PG8_STAGE(PG8_SA(0, 0), cA, voffA); PG8_STAGE(PG8_SA(0, 1), cA + hsA, voffA);
    if (wr == 1) PG8_BAR;
    PG8_WAIT_V(2); PG8_BAR;
    PG8_STAGE(PG8_SB(1, 0), cB + kstep, voffB); PG8_STAGE(PG8_SA(1, 0), cA + kstep, voffA); PG8_STAGE(PG8_SB(1, 1), cB + hsB + kstep, voffB);
    PG8_WAIT_V(6); PG8_BAR;
    } else {
    PG8_STAGE(PG8_SB(0, 0), cB, voffB); PG8_STAGE(PG8_SA(0, 0), cA, voffA); PG8_STAGE(PG8_SB(0, 1), cB + hsB, voffB); PG8_STAGE(PG8_SA(0, 1), cA + hsA, voffA);
    if (wr == 1) PG8_BAR;
    PG8_WAIT_V(4); PG8_BAR;
    PG8_STAGE(PG8_SB(1, 0), cB + kstep, voffB); PG8_STAGE(PG8_SA(1, 0), cA + kstep, voffA); PG8_STAGE(PG8_SB(1, 1), cB + hsB + kstep, voffB);
    PG8_WAIT_V(6); PG8_BAR;
    }
    for (;;) {
        const bool has_next = S.next(ui + 1, nxt);
        const char* nA = has_next ? nxt.A : cA; const char* nB = has_next ? nxt.B : cB;
        for (int t = 0; t < nt; t += 2) {
            const bool last = (t == nt - 2);
            const char* a1 = cA + (size_t)(t + 1) * kstep;
            const char* a2 = last ? nA : cA + (size_t)(t + 2) * kstep; const char* b2 = last ? nB : cB + (size_t)(t + 2) * kstep;
            const char* a3 = a2 + kstep; const char* b3 = b2 + kstep;
            if constexpr (SP2) {
            PG8_LDB(B0, 0, 0); PG8_LDB(B1, 0, 1); PG8_SCHED; PG8_LDA(At, 0, 0); PG8_STAGE(PG8_SA(1, 1), a1 + hsA, voffA);
            PG8_WAIT_V(8); PG8_WAIT_L(0); PG8_BAR; PG8_MMA(0, 0, At, B0); PG8_MMA(0, 1, At, B1); PG8_BAR; PG8_SCHED;
            PG8_LDA(At, 0, 1); PG8_STAGE(PG8_SB(0, 0), b2, voffB); PG8_STAGE(PG8_SB(0, 1), b2 + hsB, voffB); PG8_STAGE(PG8_SA(0, 0), a2, voffA);
            PG8_WAIT_V(8); PG8_WAIT_L(0); PG8_BAR; PG8_MMA(1, 0, At, B0); PG8_MMA(1, 1, At, B1); PG8_BAR; PG8_SCHED;
            PG8_LDB(B0, 1, 0); PG8_LDB(B1, 1, 1); PG8_SCHED; PG8_LDA(At, 1, 0); PG8_STAGE(PG8_SA(0, 1), a2 + hsA, voffA);
            PG8_WAIT_V(8); PG8_WAIT_L(0); PG8_BAR; PG8_MMA(0, 0, At, B0); PG8_MMA(0, 1, At, B1); PG8_BAR; PG8_SCHED;
            PG8_LDA(At, 1, 1); PG8_STAGE(PG8_SB(1, 0), b3, voffB); PG8_STAGE(PG8_SB(1, 1), b3 + hsB, voffB); PG8_STAGE(PG8_SA(1, 0), a3, voffA);
            PG8_WAIT_V(8); PG8_WAIT_L(0); PG8_BAR; PG8_MMA(1, 0, At, B0); PG8_MMA(1, 1, At, B1); PG8_BAR; PG8_SCHED;
            } else {
            PG8_LDB(B0, 0, 0); PG8_SCHED; PG8_LDA(At, 0, 0); PG8_STAGE(PG8_SA(1, 1), a1 + hsA, voffA);
            PG8_WAIT_L(8); PG8_BAR; PG8_WAIT_L(0); PG8_MMA(0, 0, At, B0); PG8_BAR; PG8_SCHED;
            PG8_LDB(B1, 0, 1); PG8_STAGE(PG8_SB(0, 0), b2, voffB);
            PG8_BAR; PG8_WAIT_L(0); PG8_MMA(0, 1, At, B1); PG8_BAR;
            PG8_LDA(At, 0, 1); PG8_STAGE(PG8_SA(0, 0), a2, voffA);
            PG8_BAR; PG8_WAIT_L(0); PG8_MMA(1, 0, At, B0); PG8_BAR; PG8_SCHED;
            PG8_STAGE(PG8_SB(0, 1), b2 + hsB, voffB);
            PG8_WAIT_V(6); PG8_BAR; PG8_MMA(1, 1, At, B1); PG8_BAR;
            PG8_LDB(B0, 1, 0); PG8_SCHED; PG8_LDA(At, 1, 0); PG8_STAGE(PG8_SA(0, 1), a2 + hsA, voffA);
            PG8_WAIT_L(8); PG8_BAR; PG8_WAIT_L(0); PG8_MMA(0, 0, At, B0); PG8_BAR; PG8_SCHED;
            PG8_LDB(B1, 1, 1); PG8_STAGE(PG8_SB(1, 0), b3, voffB);
            PG8_BAR; PG8_WAIT_L(0); PG8_MMA(0, 1, At, B1); PG8_BAR;
            PG8_LDA(At, 1, 1); PG8_STAGE(PG8_SA(1, 0), a3, voffA);
            PG8_BAR; PG8_WAIT_L(0); PG8_MMA(1, 0, At, B0); PG8_BAR; PG8_SCHED;
            PG8_STAGE(PG8_SB(1, 1), b3 + hsB, voffB);
            PG8_WAIT_V(6); PG8_BAR; PG8_MMA(1, 1, At, B1); PG8_BAR;
            }
        }
        if constexpr (ALIGN_EPI) { if (wr == 0) PG8_BAR; }
        if constexpr (Epi::FUSEDPRE) { Unit pu = cur; if (has_next) pu = nxt; E.epi_pre(acc, cur, pu, has_next, wr, wc); if (!has_next) break; }
        else {
        if constexpr (!Epi::AFTER_DRAIN) { E(acc, cur, wr, wc, fr, fq); }
        if (!has_next) break;
        }
        if constexpr (Epi::FUSEDPRE) {}
        else if constexpr (Epi::PRELOAD) E.preload(acc, nxt, wr, wc);
        else {
#pragma unroll
        for (int a = 0; a < 2; ++a)
#pragma unroll
            for (int b = 0; b < 2; ++b)
#pragma unroll
                for (int m = 0; m < 4; ++m)
#pragma unroll
                    for (int n = 0; n < 2; ++n) acc[a][b][m][n] = (f32x4){0.f, 0.f, 0.f, 0.f};
        }
        cur = nxt; cA = nA; cB = nB; ++ui;
        if constexpr (ALIGN_EPI) { if (wr == 1) PG8_BAR; }
    }
    PG8_WAIT_V(0);
    if constexpr (!ALIGN_EPI) { if (wr == 0) PG8_BAR; }
    PG8_BAR;
    if constexpr (Epi::AFTER_DRAIN) { E.fused(acc, cur, wr, wc, fr, fq, lds, wid, lane); }
#undef PG8_SA
#undef PG8_SB
#undef PG8_STAGE
#undef PG8_LDA
#undef PG8_LDB
#undef PG8_MMA
#undef PG8_WAIT_V
#undef PG8_WAIT_L
#undef PG8_BAR
#undef PG8_SCHED
}
}
#ifndef DEF_WGM
#define DEF_WGM 4
#endif
namespace pg8 {
struct SchedMain {
    const char* A; const char* B; char* C; size_t tA, tB, bB, tC, cC; int nM, nN, bdiv, ccols, G, c, wgm = DEF_WGM;
    __device__ __forceinline__ bool next(int i, Unit& u) const {
        const long Lx = (long)i * G + c; if (Lx >= (long)nM * nN) return false;
        int pm, pn; tile_of((int)Lx, nM, nN, pm, pn, wgm);
        u.A = A + (size_t)pm * tA; u.B = B + (size_t)pn * tB + (size_t)(pm / bdiv) * bB; u.C = C + (size_t)pm * tC + (size_t)pn * cC;
        u.row0 = pm * BM; u.col0 = pn * ccols; u.aux = i; u.vec = nullptr; return true;
    }
};

struct EpiRowScale {
    static constexpr bool AFTER_DRAIN = false, PRELOAD = false, APERM = false, FUSEDPRE = false;
    const i64* ss; const float* bias; int ldc;
    __device__ __forceinline__ void operator()(f32x4 (&acc)[2][2][4][2], const Unit& u, int wr, int wc, int fr_, int fq_) const {
        int lane_ = lane_id(); asm volatile("" : "+v"(lane_)); const int fr = lane_ & 15, fq = lane_ >> 4; (void)fr_; (void)fq_;
        const int colw = wc * 32 + 8 * fq; const unsigned loff = (unsigned)((wr * 64 + fr) * ldc + colw) * 2u; const unsigned soff = (unsigned)(wr * 64 + fr) * 8u;
        i64 sv[2][4];
#pragma unroll
        for (int ai = 0; ai < 2; ++ai)
#pragma unroll
            for (int m = 0; m < 4; ++m) sv[ai][m] = *(const i64*)((const char*)(ss + u.row0 + ai * HALF + m * 16) + soff);
        f32x4 bv[2][2];
#pragma unroll
        for (int bj = 0; bj < 2; ++bj)
#pragma unroll
            for (int n = 0; n < 2; ++n) bv[bj][n] = bias ? *(const f32x4*)(bias + u.col0 + colw + bj * HALF + 4 * n) : (f32x4){0.f, 0.f, 0.f, 0.f};
#pragma unroll
        for (int ai = 0; ai < 2; ++ai)
#pragma unroll
            for (int m = 0; m < 4; ++m) {
                const int rb = ai * HALF + m * 16;
                const float rs = rstd_of(sv[ai][m]);
                char* rowp = u.C + (size_t)rb * ldc * 2 + loff;
#pragma unroll
                for (int bj = 0; bj < 2; ++bj) {
                    const f32x4 v0 = acc[ai][bj][m][0] * rs + bv[bj][0], v1 = acc[ai][bj][m][1] * rs + bv[bj][1];
                    u32x4 w; w.x = cvt_pk_bf16(v0[0], v0[1]); w.y = cvt_pk_bf16(v0[2], v0[3]); w.z = cvt_pk_bf16(v1[0], v1[1]); w.w = cvt_pk_bf16(v1[2], v1[3]);
                    *(u32x4*)(rowp + bj * HALF * 2) = w;
                }
            }
    }
};

struct EpiPlain {
    static constexpr bool AFTER_DRAIN = false, PRELOAD = false, APERM = false, FUSEDPRE = false;
    __device__ __forceinline__ void operator()(f32x4 (&acc)[2][2][4][2], const Unit& u, int wr, int wc, int fr_, int fq_) const {
        int lane_ = lane_id(); asm volatile("" : "+v"(lane_)); const int fr = lane_ & 15, fq = lane_ >> 4; (void)fr_; (void)fq_;
        const int colw = wc * 32 + 8 * fq, ldc = u.aux; const float* cs = (const float*)u.vec; const unsigned loff = (unsigned)((wr * 64 + fr) * ldc + colw) * 2u;
        f32x4 sv[2][2];
#pragma unroll
        for (int bj = 0; bj < 2; ++bj)
#pragma unroll
            for (int n = 0; n < 2; ++n) sv[bj][n] = cs ? *(const f32x4*)(cs + u.col0 + colw + bj * HALF + 4 * n) : (f32x4){1.f, 1.f, 1.f, 1.f};
#pragma unroll
        for (int ai = 0; ai < 2; ++ai)
#pragma unroll
            for (int m = 0; m < 4; ++m) {
                char* rowp = u.C + (size_t)(ai * HALF + m * 16) * ldc * 2 + loff;
#pragma unroll
                for (int bj = 0; bj < 2; ++bj) {
                    const f32x4 v0 = acc[ai][bj][m][0] * sv[bj][0], v1 = acc[ai][bj][m][1] * sv[bj][1];
                    u32x4 w; w.x = cvt_pk_bf16(v0[0], v0[1]); w.y = cvt_pk_bf16(v0[2], v0[3]); w.z = cvt_pk_bf16(v1[0], v1[1]); w.w = cvt_pk_bf16(v1[2], v1[3]);
                    *(u32x4*)(rowp + bj * HALF * 2) = w;
                }
            }
    }
};

struct EpiRes {
    static constexpr bool AFTER_DRAIN = false, PRELOAD = true, APERM = false, FUSEDPRE = true;
    bf16_t* hb; bf16_t* hbo; i64* ssout; LAS unsigned char* lds_spare;
    __device__ __forceinline__ void preload(f32x4 (&acc)[2][2][4][2], const Unit& u, int wr, int wc) const {
        int lane_ = lane_id(); asm volatile("" : "+v"(lane_)); const int fr = lane_ & 15, fq = lane_ >> 4;
        const unsigned l2 = (unsigned)((wr * 64 + fr) * D + wc * 32 + 8 * fq) * 2u;
#pragma unroll
        for (int ai = 0; ai < 2; ++ai)
#pragma unroll
            for (int m = 0; m < 4; ++m) { const char* pin = (const char*)(hb + (size_t)(u.row0 + ai * HALF + m * 16) * D + u.col0) + l2;
#pragma unroll
                for (int bj = 0; bj < 2; ++bj) { const u32x4 w = *(const u32x4*)(pin + bj * HALF * 2);
                    acc[ai][bj][m][0] = (f32x4){bf_lo(w.x), bf_hi(w.x), bf_lo(w.y), bf_hi(w.y)}; acc[ai][bj][m][1] = (f32x4){bf_lo(w.z), bf_hi(w.z), bf_lo(w.w), bf_hi(w.w)}; } }
    }
    __device__ __forceinline__ void operator()(f32x4 (&)[2][2][4][2], const Unit&, int, int, int, int) const {}
    __device__ __forceinline__ void epi_pre(f32x4 (&acc)[2][2][4][2], const Unit& u, const Unit& nu, const bool has_next, int wr, int wc) const {
        int lane_ = lane_id(); asm volatile("" : "+v"(lane_)); const int fr = lane_ & 15, fq = lane_ >> 4;
        const unsigned l2 = (unsigned)((wr * 64 + fr) * D + wc * 32 + 8 * fq) * 2u;
        LAS float* T = (LAS float*)(lds_spare);
        u32x4 raw[2][4][2];
        if (has_next) {
#pragma unroll
        for (int ai = 0; ai < 2; ++ai)
#pragma unroll
            for (int m = 0; m < 4; ++m) { const char* pin = (const char*)(hb + (size_t)(nu.row0 + ai * HALF + m * 16) * D + nu.col0) + l2;
                asm volatile("global_load_dwordx4 %0, %2, off\n\tglobal_load_dwordx4 %1, %2, off offset:256" : "=&v"(raw[ai][m][0]), "=&v"(raw[ai][m][1]) : "v"(pin) : "memory"); }
        }
#pragma unroll
        for (int ai = 0; ai < 2; ++ai)
#pragma unroll
            for (int m = 0; m < 4; ++m) {
                char* pb = (char*)(hbo + (size_t)(u.row0 + ai * HALF + m * 16) * D + u.col0) + l2;
                float s = 0.f;
#pragma unroll
                for (int bj = 0; bj < 2; ++bj) {
                    const f32x4 o0 = acc[ai][bj][m][0], o1 = acc[ai][bj][m][1];
                    u32x4 w; w.x = cvt_pk_bf16(o0[0], o0[1]); w.y = cvt_pk_bf16(o0[2], o0[3]); w.z = cvt_pk_bf16(o1[0], o1[1]); w.w = cvt_pk_bf16(o1[2], o1[3]);
                    *(u32x4*)(pb + bj * HALF * 2) = w;
                    s += (o0[0] * o0[0] + o0[1] * o0[1]) + (o0[2] * o0[2] + o0[3] * o0[3]) + (o1[0] * o1[0] + o1[1] * o1[1]) + (o1[2] * o1[2] + o1[3] * o1[3]);
                }
                s += shx(s, 16, lane_); s += shx(s, 32, lane_);
                if (fq == 0) T[(ai * HALF + wr * 64 + m * 16 + fr) * 4 + wc] = s;
            }
        asm volatile("s_waitcnt lgkmcnt(0)" ::: "memory"); __builtin_amdgcn_s_barrier(); asm volatile("" ::: "memory");
        if (lane_ < 32) { const int row = (wr * 4 + wc) * 32 + lane_; const f32x4 p = *(const LAS f32x4*)(T + row * 4);
            __hip_atomic_fetch_add(ssout + u.row0 + row, (i64)(((p[0] + p[1]) + (p[2] + p[3])) * SS_SCALE), __ATOMIC_RELAXED, __HIP_MEMORY_SCOPE_AGENT); }
        if (!has_next) return;
        asm volatile("s_waitcnt vmcnt(16)" : "+v"(raw[0][0][0]), "+v"(raw[0][0][1]), "+v"(raw[0][1][0]), "+v"(raw[0][1][1]), "+v"(raw[0][2][0]), "+v"(raw[0][2][1]), "+v"(raw[0][3][0]), "+v"(raw[0][3][1]),
                                           "+v"(raw[1][0][0]), "+v"(raw[1][0][1]), "+v"(raw[1][1][0]), "+v"(raw[1][1][1]), "+v"(raw[1][2][0]), "+v"(raw[1][2][1]), "+v"(raw[1][3][0]), "+v"(raw[1][3][1]) :: "memory");
#pragma unroll
        for (int ai = 0; ai < 2; ++ai)
#pragma unroll
            for (int m = 0; m < 4; ++m)
#pragma unroll
                for (int bj = 0; bj < 2; ++bj) { const u32x4 w = raw[ai][m][bj];
                    acc[ai][bj][m][0] = (f32x4){bf_lo(w.x), bf_hi(w.x), bf_lo(w.y), bf_hi(w.y)}; acc[ai][bj][m][1] = (f32x4){bf_lo(w.z), bf_hi(w.z), bf_lo(w.w), bf_hi(w.w)}; }
    }
};

struct EpiSoftmax {
    static constexpr bool AFTER_DRAIN = true, PRELOAD = false, APERM = false, FUSEDPRE = false;
    const i64* ss; int ldc;
    __device__ __forceinline__ void operator()(f32x4 (&)[2][2][4][2], const Unit&, int, int, int, int) const {}
    __device__ __forceinline__ void fused(f32x4 (&acc)[2][2][4][2], const Unit& u, int wr, int wc, int fr_, int fq_, LAS unsigned char* lds, int wid, int lane) const {
        int lane_ = lane_id(); asm volatile("" : "+v"(lane_)); const int fr = lane_ & 15, fq = lane_ >> 4; (void)fr_; (void)fq_;
        LAS f32x2* T = (LAS f32x2*)lds;
        const unsigned loff = (unsigned)((wr * 64 + fr) * ldc + wc * 32 + 8 * fq) * 2u, soff = (unsigned)(wr * 64 + fr) * 8u;
        float mown[2][4]; i64 sv[2][4];
#pragma unroll
        for (int ai = 0; ai < 2; ++ai)
#pragma unroll
            for (int m = 0; m < 4; ++m) sv[ai][m] = *(const i64*)((const char*)(ss + u.row0 + ai * HALF + m * 16) + soff);
#pragma unroll
        for (int ai = 0; ai < 2; ++ai)
#pragma unroll
            for (int m = 0; m < 4; ++m) {
                const int r = ai * HALF + wr * 64 + m * 16 + fr;
                const float rs = rstd_of(sv[ai][m]);
                float mx = -3.0e38f;
#pragma unroll
                for (int bj = 0; bj < 2; ++bj)
#pragma unroll
                    for (int n = 0; n < 2; ++n) { f32x4 v = acc[ai][bj][m][n] * rs; acc[ai][bj][m][n] = v; mx = fmaxf(fmaxf(mx, fmaxf(v[0], v[1])), fmaxf(v[2], v[3])); }
                mx = fmaxf(mx, shx(mx, 16, lane_)); mx = fmaxf(mx, shx(mx, 32, lane_));
                float l = 0.f;
#pragma unroll
                for (int bj = 0; bj < 2; ++bj)
#pragma unroll
                    for (int n = 0; n < 2; ++n) { f32x4 v = acc[ai][bj][m][n]; v[0] = fast_exp(v[0] - mx); v[1] = fast_exp(v[1] - mx); v[2] = fast_exp(v[2] - mx); v[3] = fast_exp(v[3] - mx); acc[ai][bj][m][n] = v; l += (v[0] + v[1]) + (v[2] + v[3]); }
                l += shx(l, 16, lane_); l += shx(l, 32, lane_);
                mown[ai][m] = mx;
                if (fq == 0) T[r * 4 + wc] = (f32x2){mx, l};
            }
        asm volatile("s_waitcnt lgkmcnt(0)" ::: "memory"); __builtin_amdgcn_s_barrier(); asm volatile("" ::: "memory");
#pragma unroll
        for (int ai = 0; ai < 2; ++ai)
#pragma unroll
            for (int m = 0; m < 4; ++m) {
                const int r = ai * HALF + wr * 64 + m * 16 + fr;
                const f32x2 a = T[r * 4 + 0], b = T[r * 4 + 1], c = T[r * 4 + 2], d = T[r * 4 + 3];
                const float Mx = fmaxf(fmaxf(a.x, b.x), fmaxf(c.x, d.x));
                const float Ls = a.y * fast_exp(a.x - Mx) + b.y * fast_exp(b.x - Mx) + c.y * fast_exp(c.x - Mx) + d.y * fast_exp(d.x - Mx);
                const float f = fast_exp(mown[ai][m] - Mx) * __builtin_amdgcn_rcpf(Ls);
                char* rowp = u.C + (size_t)(ai * HALF + m * 16) * ldc * 2 + loff;
#pragma unroll
                for (int bj = 0; bj < 2; ++bj) {
                    const f32x4 v0 = acc[ai][bj][m][0] * f, v1 = acc[ai][bj][m][1] * f;
                    u32x4 w; w.x = cvt_pk_bf16(v0[0], v0[1]); w.y = cvt_pk_bf16(v0[2], v0[3]); w.z = cvt_pk_bf16(v1[0], v1[1]); w.w = cvt_pk_bf16(v1[2], v1[3]);
                    *(u32x4*)(rowp + bj * HALF * 2) = w;
                }
            }
    }
};

__device__ __forceinline__ float dpp_shr1z(float x) { return __builtin_bit_cast(float, __builtin_amdgcn_update_dpp(0, __builtin_bit_cast(int, x), 0x111  , 0xf, 0xf, true)); }
struct EpiMLP {
    static constexpr bool AFTER_DRAIN = false, PRELOAD = false, APERM = true, FUSEDPRE = false;
    LAS unsigned char* lds; float* halo_g; float* halo_u;
    __device__ __forceinline__ void operator()(f32x4 (&acc)[2][2][4][2], const Unit& u, int wr, int wc, int fr_, int fq_) const {
        int lane_ = lane_id(); asm volatile("" : "+v"(lane_)); const int fr = lane_ & 15, fq = lane_ >> 4; (void)fr_; (void)fq_;
        const int colw = wc * 32 + 8 * fq, ch0 = u.col0 + colw;
        const unsigned loff = (unsigned)((wr * 64 + 4 * fr) * DFF + colw) * 2u;
        const float LN2 = 0.6931471805599453f;
        const LAS float* cwt = (const LAS float*)(lds + F1_CWT_OFF) + u.aux * 512 + colw;
        const int slot = *(const LAS int*)(lds + F1_SLOT_OFF + u.aux * 4);
        const LAS float* rst = (const LAS float*)(lds + F1_RST_OFF) + slot * 256 + wr * 64 + 4 * fr;
        f32x4 w0[2], w1[2], w2[2], bb[2];
#pragma unroll
        for (int n = 0; n < 2; ++n) { w0[n] = *(const LAS f32x4*)(cwt + 4 * n); w1[n] = *(const LAS f32x4*)(cwt + 128 + 4 * n); w2[n] = *(const LAS f32x4*)(cwt + 256 + 4 * n); bb[n] = *(const LAS f32x4*)(cwt + 384 + 4 * n); }
#pragma unroll
        for (int ai = 0; ai < 2; ++ai) {
            const int rb = u.row0 + ai * HALF + wr * 64, blk = rb >> 6;
            const f32x4 rsv = *(const LAS f32x4*)(rst + ai * HALF);
            float rs[4], irsu[4];
#pragma unroll
            for (int m = 0; m < 4; ++m) { rs[m] = rsv[m]; irsu[m] = __builtin_amdgcn_rcpf(rs[m] * LN2); }
#pragma unroll
            for (int n = 0; n < 2; ++n) {
                f32x4 g[4];
#pragma unroll
                for (int m = 0; m < 4; ++m) g[m] = acc[ai][0][m][n] * rs[m];
                if (fr == 15) { *(f32x4*)(halo_g + ((size_t)blk * 4 + 0) * DFF + ch0 + 4 * n) = g[2]; *(f32x4*)(halo_g + ((size_t)blk * 4 + 1) * DFF + ch0 + 4 * n) = g[3]; }
                if (fr == 0) { *(f32x4*)(halo_g + ((size_t)blk * 4 + 2) * DFF + ch0 + 4 * n) = g[0]; *(f32x4*)(halo_g + ((size_t)blk * 4 + 3) * DFF + ch0 + 4 * n) = g[1];
                               *(f32x4*)(halo_u + ((size_t)blk * 2 + 0) * DFF + ch0 + 4 * n) = acc[ai][1][0][n] * rs[0]; *(f32x4*)(halo_u + ((size_t)blk * 2 + 1) * DFF + ch0 + 4 * n) = acc[ai][1][1][n] * rs[1]; }
                f32x4 pre[4];
#pragma unroll
                for (int j = 0; j < 4; ++j) {
                    const float s3 = dpp_shr1z(g[3][j]), s2 = dpp_shr1z(g[2][j]);
                    pre[0][j] = __builtin_fmaf(w2[n][j], g[0][j], __builtin_fmaf(w1[n][j], s3, __builtin_fmaf(w0[n][j], s2, bb[n][j])));
                    pre[1][j] = __builtin_fmaf(w2[n][j], g[1][j], __builtin_fmaf(w1[n][j], g[0][j], __builtin_fmaf(w0[n][j], s3, bb[n][j])));
                    pre[2][j] = __builtin_fmaf(w2[n][j], g[2][j], __builtin_fmaf(w1[n][j], g[1][j], __builtin_fmaf(w0[n][j], g[0][j], bb[n][j])));
                    pre[3][j] = __builtin_fmaf(w2[n][j], g[3][j], __builtin_fmaf(w1[n][j], g[2][j], __builtin_fmaf(w0[n][j], g[1][j], bb[n][j])));
                }
#pragma unroll
                for (int m = 0; m < 4; ++m) {
                    f32x4 a;
#pragma unroll
                    for (int j = 0; j < 4; ++j) { const float p = pre[m][j]; a[j] = (p * acc[ai][1][m][n][j]) * __builtin_amdgcn_rcpf(__builtin_fmaf(__builtin_amdgcn_exp2f(-p), irsu[m], irsu[m])); }
                    acc[ai][0][m][n] = a;
                }
            }
#pragma unroll
            for (int m = 0; m < 4; ++m) {
                const f32x4 v0 = acc[ai][0][m][0], v1 = acc[ai][0][m][1];
                u32x4 w; w.x = cvt_pk_bf16(v0[0], v0[1]); w.y = cvt_pk_bf16(v0[2], v0[3]); w.z = cvt_pk_bf16(v1[0], v1[1]); w.w = cvt_pk_bf16(v1[2], v1[3]);
                *(u32x4*)(u.C + (size_t)(ai * HALF + m) * DFF * 2 + loff) = w;
            }
        }
    }
};
struct EpiEven {
    static constexpr bool AFTER_DRAIN = false, PRELOAD = false, APERM = true, FUSEDPRE = false;
    const i64* ss; const float* cw; bf16_t* YY; bf16_t* UB; float* HV; float* HGB;
    __device__ __forceinline__ void operator()(f32x4 (&acc)[2][2][4][2], const Unit& u, int wr, int wc, int fr_, int fq_) const {
        int lane_ = lane_id(); asm volatile("" : "+v"(lane_)); const int fr = lane_ & 15, fq = lane_ >> 4; (void)fr_; (void)fq_;
        const int ch = u.col0 + 16 * wc + 4 * fq, g = (u.col0 >> 4) + wc;
        const unsigned soff = (unsigned)(wr * 64 + 4 * fr) * 8u;
        i64 sv[2][4];
#pragma unroll
        for (int ai = 0; ai < 2; ++ai)
#pragma unroll
            for (int m = 0; m < 4; ++m) sv[ai][m] = *(const i64*)((const char*)(ss + u.row0 + ai * HALF + m) + soff);
        const f32x4 w0 = *(const f32x4*)(cw + ch), w1 = *(const f32x4*)(cw + AW + ch), w2 = *(const f32x4*)(cw + 2 * AW + ch);
#pragma unroll
        for (int ai = 0; ai < 2; ++ai) {
            const int rb = u.row0 + ai * HALF + wr * 64, blk = rb >> 6;
            f32x4 gb[4], v[4], y[4];
#pragma unroll
            for (int m = 0; m < 4; ++m) { const float rs = rstd_of(sv[ai][m]); gb[m] = acc[ai][0][m][0] * rs; v[m] = (acc[ai][0][m][1] * rs) * (acc[ai][1][m][0] * rs); acc[ai][1][m][1] = acc[ai][1][m][1] * rs; }
            if (fr == 15) { *(f32x4*)(HV + ((size_t)blk * 4 + 0) * AW + ch) = v[2]; *(f32x4*)(HV + ((size_t)blk * 4 + 1) * AW + ch) = v[3]; }
            if (fr == 0) { *(f32x4*)(HV + ((size_t)blk * 4 + 2) * AW + ch) = v[0]; *(f32x4*)(HV + ((size_t)blk * 4 + 3) * AW + ch) = v[1];
                           *(f32x4*)(HGB + ((size_t)blk * 2 + 0) * AW + ch) = gb[0]; *(f32x4*)(HGB + ((size_t)blk * 2 + 1) * AW + ch) = gb[1]; }
#pragma unroll
            for (int j = 0; j < 4; ++j) {
                const float s3 = dpp_shr1z(v[3][j]), s2 = dpp_shr1z(v[2][j]);
                y[0][j] = w2[j] * v[0][j] + w1[j] * s3 + w0[j] * s2;
                y[1][j] = w2[j] * v[1][j] + w1[j] * v[0][j] + w0[j] * s3;
                y[2][j] = w2[j] * v[2][j] + w1[j] * v[1][j] + w0[j] * v[0][j];
                y[3][j] = w2[j] * v[3][j] + w1[j] * v[2][j] + w0[j] * v[1][j];
            }
#pragma unroll
            for (int m = 0; m < 4; ++m) {
                const size_t row = (size_t)(rb + 4 * fr + m);
                const f32x4 a = gb[m] * y[m], uu = acc[ai][1][m][1];
                u32x2 wa; wa.x = cvt_pk_bf16(a[0], a[1]); wa.y = cvt_pk_bf16(a[2], a[3]);
                u32x2 wu; wu.x = cvt_pk_bf16(uu[0], uu[1]); wu.y = cvt_pk_bf16(uu[2], uu[3]);
                *(u32x2*)(YY + row * D + ch) = wa;
                *(u32x2*)(UB + ((size_t)g * M + row) * 16 + 4 * fq) = wu;
            }
        }
    }
};
struct EpiNull { static constexpr bool AFTER_DRAIN = false, PRELOAD = false, APERM = false, FUSEDPRE = false;
    __device__ __forceinline__ void operator()(f32x4 (&acc)[2][2][4][2], const Unit& u, int, int, int fr, int) const {
        f32x4 s = (f32x4){0.f, 0.f, 0.f, 0.f};
#pragma unroll
        for (int a = 0; a < 2; ++a)
#pragma unroll
            for (int b = 0; b < 2; ++b)
#pragma unroll
                for (int m = 0; m < 4; ++m)
#pragma unroll
                    for (int n = 0; n < 2; ++n) s += acc[a][b][m][n];
        if (s[0] + s[1] + s[2] + s[3] == 1.2345e-30f && fr == 7) *(float*)u.C = 0.f; } };
}
struct Args { const float* in[32]; float* out; unsigned char* ws; };

struct Frame {
    LAS unsigned char* lds;
    int wave, G, bid;
    int gw, ngw;
    int ngt;
};
#define PHASE_TID(F, tid, lane, gt) int lane = lane_id(); asm volatile("" : "+v"(lane)); const int tid = (F).wave * 64 + lane; const int gt = (F).bid * NTHR + tid; (void)tid; (void)gt


struct MatDesc { const float* W; const float* gk; bf16_t* WT; int K, N, rs, roff, nsplit; float nsc; int transpose, rmode; };
__device__ __forceinline__ int even_row(int ng) { const int part = ng >> 10, ch = ng & 1023, pn = ch >> 6, r = ch & 63; return 256 * pn + 128 * (part >> 1) + 32 * (r >> 4) + 8 * ((r >> 2) & 3) + 4 * (part & 1) + (r & 3); }
__device__ __forceinline__ void tr_load(const MatDesc& d, int item, int lane, f32x4 (&v)[16], float (&gs)[16]) {
    const int nblk = d.N / 64, kb = item / nblk, nb = item % nblk, k0 = 64 * kb, n0 = 64 * nb;
    const unsigned voff = (unsigned)((lane >> 4) * d.N + (lane & 15) * 4) * 4u;
    const char* sbase = (const char*)(d.W + (size_t)k0 * d.N + n0);
#pragma unroll
    for (int i = 0; i < 16; ++i) v[i] = __builtin_nontemporal_load((const f32x4*)(sbase + (size_t)(4 * i) * d.N * 4 + voff));
    if (d.gk) {
#pragma unroll
        for (int i = 0; i < 16; ++i) gs[i] = d.gk[k0 + 4 * i + (lane >> 4)];
    } else {
#pragma unroll
        for (int i = 0; i < 16; ++i) gs[i] = 1.0f;
    }
}
__device__ __forceinline__ void tr_store(const MatDesc& d, LAS float* scr, int item, int lane, const f32x4 (&v)[16], const float (&gs)[16]) {
    const int nblk = d.N / 64, kb = item / nblk, nb = item % nblk, k0 = 64 * kb, n0 = 64 * nb;
    LAS float* wp = scr + (lane >> 4) * 65 + (lane & 15) * 4;
#pragma unroll
    for (int i = 0; i < 16; ++i) { const f32x4 x = v[i] * gs[i];
        wp[(4 * i) * 65 + 0] = x[0]; wp[(4 * i) * 65 + 1] = x[1]; wp[(4 * i) * 65 + 2] = x[2]; wp[(4 * i) * 65 + 3] = x[3]; }
    LDS_WAIT(); asm volatile("" ::: "memory");
    const int c = lane & 7;
#pragma unroll
    for (int j = 0; j < 8; ++j) { const int n = (lane >> 3) + 8 * j, ng = n0 + n; const LAS float* s = scr + (8 * c) * 65 + n;
        const float sc = (ng < d.nsplit) ? d.nsc : 1.0f;
        u32x4 o; o.x = cvt_pk_bf16(s[0 * 65] * sc, s[1 * 65] * sc); o.y = cvt_pk_bf16(s[2 * 65] * sc, s[3 * 65] * sc); o.z = cvt_pk_bf16(s[4 * 65] * sc, s[5 * 65] * sc); o.w = cvt_pk_bf16(s[6 * 65] * sc, s[7 * 65] * sc);
        const int drow = d.rmode ? even_row(ng) : (ng / 128) * d.rs + d.roff + (ng % 128);
        __builtin_nontemporal_store(o, (u32x4*)(d.WT + (size_t)drow * d.K + k0 + 8 * c)); }
    LDS_WAIT(); asm volatile("" ::: "memory");
}
__device__ __forceinline__ void get_mat(const Args& a, int id, MatDesc& d) {
    unsigned char* ws = a.ws;
    d.gk = nullptr; d.rs = 128; d.roff = 0; d.nsplit = 0; d.nsc = 1.f; d.transpose = 1; d.rmode = 0; d.K = D; d.N = D;
    if (id < 2)       { const int i = id;      d.W = a.in[8] + (size_t)i * D * EVEN_IN; d.N = EVEN_IN; d.rmode = 1; d.gk = a.in[2] + (2 * i) * D; d.WT = (bf16_t*)(ws + WS_WIN_T) + (size_t)i * EVEN_IN * D; }
    else if (id < 4)  { const int i = id - 2;  d.W = a.in[19] + (size_t)i * D * D; d.WT = (bf16_t*)(ws + WS_EWOUT_T) + (size_t)i * D * D; }
    else if (id < 6)  { const int i = id - 4;  d.W = a.in[20] + (size_t)i * D * ODD_IN; d.N = ODD_IN; d.gk = a.in[2] + (2 * i + 1) * D; d.nsplit = NQH * HD; d.nsc = 0.125f; d.WT = (bf16_t*)(ws + WS_WQKV_T) + (size_t)i * ODD_IN * D; }
    else if (id < 8)  { const int i = id - 6;  d.W = a.in[23] + (size_t)i * D * D; d.WT = (bf16_t*)(ws + WS_OWOUT_T) + (size_t)i * D * D; }
    else if (id < 12) { const int l = id - 8;  d.W = a.in[25] + (size_t)l * D * 2 * D; d.N = 2 * D; d.WT = (bf16_t*)(ws + WS_WKV_T) + (size_t)l * 2 * D * D; }
    else if (id < 16) { const int l = id - 12; d.W = a.in[26] + (size_t)l * D * D; d.WT = (bf16_t*)(ws + WS_WO_T) + (size_t)l * D * D; }
    else if (id < 20) { const int l = id - 16; d.W = a.in[27] + (size_t)l * D * DFF; d.N = DFF; d.gk = a.in[4] + l * D; d.rs = 256; d.WT = (bf16_t*)(ws + WS_WGU_T) + (size_t)l * NGU * D; }
    else if (id < 24) { const int l = id - 20; d.W = a.in[28] + (size_t)l * D * DFF; d.N = DFF; d.gk = a.in[4] + l * D; d.rs = 256; d.roff = 128; d.WT = (bf16_t*)(ws + WS_WGU_T) + (size_t)l * NGU * D; }
    else if (id < 28) { const int l = id - 24; d.W = a.in[31] + (size_t)l * DFF * D; d.K = DFF; d.WT = (bf16_t*)(ws + WS_WDOWN_T) + (size_t)l * D * DFF; }
    else              { const int l = id - 28; d.W = a.in[24] + (size_t)l * D * D; d.transpose = 0; d.WT = (bf16_t*)(ws + WS_WQ_BF) + (size_t)l * D * D; }
}

__device__ __forceinline__ void p0_prologue(const Args& a, Frame& F) {
    unsigned char* ws = a.ws;
    PHASE_TID(F, tid, lane, gt);
    LAS float* scr = (LAS float*)(F.lds + F.wave * 16640);
    if (F.wave == 7) { float* sp = (float*)(ws + WS_S5P);
      for (int i = F.bid + F.G * lane; i < 2 * 64 * 64; i += F.G * 64) {
          const int g = (i >> 6) & 63, li_ = i >> 12;
          const double lr = a.in[10][i], li = a.in[11][i], dt = exp((double)a.in[12][li_ * 64 + g]);
          const double er = exp(lr * dt), abr = er * cos(li * dt), abi = er * sin(li * dt);
          const double xr_ = abr - 1.0, xi_ = abi, den = lr * lr + li * li;
          const double fr = (xr_ * lr + xi_ * li) / den, fi = (xi_ * lr - xr_ * li) / den;
          float* o = sp + (size_t)i * 34; o[0] = (float)abr; o[1] = (float)abi;
          for (int h = 0; h < 16; ++h) { const double br = a.in[13][(size_t)i * 16 + h], bi = a.in[14][(size_t)i * 16 + h]; o[2 + h] = (float)(fr * br - fi * bi); o[18 + h] = (float)(fr * bi + fi * br); } } }
    { int id = 0, base = 0; MatDesc d; get_mat(a, 0, d); int nit = (d.K / 64) * (d.N / 64);
      constexpr int TOTAL = 2 * (32 * 64 + 32 * 32 + 32 * 40 + 32 * 32) + 4 * (32 * 64 + 32 * 32 + 3 * 32 * 88);
      MatDesc dn = d; int idn = 0, basen = 0, nitn = nit;
      f32x4 vc[16], vn[16]; float gc[16], gn[16];
      int gi = F.gw;
      if (gi < TOTAL) {
          while (gi >= basen + nitn) { basen += nitn; ++idn; get_mat(a, idn, dn); nitn = (dn.K / 64) * (dn.N / 64); }
          d = dn; base = basen;
          tr_load(d, gi - base, lane, vc, gc);
          for (;;) {
              const int gnx = gi + F.ngw; const bool has_next = gnx < TOTAL;
              if (has_next) { while (gnx >= basen + nitn) { basen += nitn; ++idn; get_mat(a, idn, dn); nitn = (dn.K / 64) * (dn.N / 64); }
                              tr_load(dn, gnx - basen, lane, vn, gn); }
              tr_store(d, scr, gi - base, lane, vc, gc);
              if (!has_next) break;
#pragma unroll
              for (int i = 0; i < 16; ++i) { vc[i] = vn[i]; gc[i] = gn[i]; }
              d = dn; base = basen; gi = gnx;
          }
      } }
#if defined(PROBE_TR) && PROBE_TR
    { int id = 0, base = 0; MatDesc d; get_mat(a, 0, d); int nit = (d.K / 64) * (d.N / 64);
      constexpr int TOTAL = 2 * (32 * 64 + 32 * 32 + 32 * 40 + 32 * 32) + 4 * (32 * 64 + 32 * 32 + 3 * 32 * 88);
      f32x4 accp = (f32x4){0.f, 0.f, 0.f, 0.f};
      for (int gi = F.gw; gi < TOTAL; gi += F.ngw) {
          while (gi >= base + nit) { base += nit; ++id; get_mat(a, id, d); nit = (d.K / 64) * (d.N / 64); }
          f32x4 va[16]; float gs[16]; tr_load(d, gi - base, lane, va, gs);
          if (PROBE_TR == 1) {
#pragma unroll
              for (int i = 0; i < 16; ++i) accp += va[i] * gs[i];
          } else {
              const int item = gi - base, nblk = d.N / 64, kb = item / nblk, nb = item % nblk, k0 = 64 * kb, n0 = 64 * nb, c = lane & 7;
#pragma unroll
              for (int j = 0; j < 8; ++j) { const int n = (lane >> 3) + 8 * j, ng = n0 + n; const int drow = (ng / 128) * d.rs + d.roff + (ng % 128);
                  u32x4 o; o.x = (unsigned)gi; o.y = o.z = o.w = 0u;
                  *(u32x4*)((bf16_t*)(ws + WS_END) + ((size_t)(d.WT - (bf16_t*)(ws + WS_WIN_T)) % (32u << 20)) + (size_t)drow * d.K + k0 + 8 * c) = o; }
          } }
      if (accp[0] + accp[1] + accp[2] + accp[3] == 1.2345e-30f) *(float*)(ws + WS_END) = 0.f; }
#endif
    for (int id = 28; id < 32; ++id) {
        MatDesc d; get_mat(a, id, d);
        const size_t n8 = (size_t)d.K * d.N / 8;
        for (size_t i = gt; i < n8; i += F.ngt) { const f32x4 x0 = *(const f32x4*)(d.W + i * 8), x1 = *(const f32x4*)(d.W + i * 8 + 4);
            u32x4 o; o.x = cvt_pk_bf16(x0[0], x0[1]); o.y = cvt_pk_bf16(x0[2], x0[3]); o.z = cvt_pk_bf16(x1[0], x1[1]); o.w = cvt_pk_bf16(x1[2], x1[3]); *(u32x4*)(d.WT + i * 8) = o; }
    }
    { u32x4* z = (u32x4*)(ws + WS_SS + (size_t)M * 8); for (int i = gt; i < 13 * M * 8 / 16; i += F.ngt) z[i] = (u32x4){0u, 0u, 0u, 0u}; }
    { const float* x = a.in[0]; bf16_t* HB = (bf16_t*)(ws + WS_HB); i64* ss0 = (i64*)(ws + WS_SS);
      for (int row = F.gw; row < M; row += F.ngw) {
          const f32x4* xr = (const f32x4*)(x + (size_t)row * D); float s = 0.f;
#pragma unroll
          for (int j = 0; j < 4; ++j) { const f32x4 v0 = xr[(j * 64 + lane) * 2], v1 = xr[(j * 64 + lane) * 2 + 1];
              s += (v0[0] * v0[0] + v0[1] * v0[1]) + (v0[2] * v0[2] + v0[3] * v0[3]) + (v1[0] * v1[0] + v1[1] * v1[1]) + (v1[2] * v1[2] + v1[3] * v1[3]);
              u32x4 o; o.x = cvt_pk_bf16(v0[0], v0[1]); o.y = cvt_pk_bf16(v0[2], v0[3]); o.z = cvt_pk_bf16(v1[0], v1[1]); o.w = cvt_pk_bf16(v1[2], v1[3]);
              *(u32x4*)(HB + (size_t)row * D + (j * 64 + lane) * 8) = o; }
          s = wave_sum(s, lane); if (lane == 0) ss0[row] = (i64)(s * SS_SCALE); } }
    { const float* mem = a.in[1]; const float* gm = a.in[6]; bf16_t* MN = (bf16_t*)(ws + WS_MEMN);
      for (int row = F.gw; row < MROWS; row += F.ngw) {
          const f32x4* xr = (const f32x4*)(mem + (size_t)row * D); f32x4 v[8]; float s = 0.f;
#pragma unroll
          for (int j = 0; j < 4; ++j) { v[2 * j] = xr[(j * 64 + lane) * 2]; v[2 * j + 1] = xr[(j * 64 + lane) * 2 + 1];
              const f32x4 v0 = v[2 * j], v1 = v[2 * j + 1]; s += (v0[0] * v0[0] + v0[1] * v0[1]) + (v0[2] * v0[2] + v0[3] * v0[3]) + (v1[0] * v1[0] + v1[1] * v1[1]) + (v1[2] * v1[2] + v1[3] * v1[3]); }
          s = wave_sum(s, lane); const float r = 1.0f / sqrtf(s * (1.0f / D) + EPS);
#pragma unroll
          for (int j = 0; j < 4; ++j) { const f32x4 g0 = *(const f32x4*)(gm + (j * 64 + lane) * 8), g1 = *(const f32x4*)(gm + (j * 64 + lane) * 8 + 4);
              const f32x4 v0 = v[2 * j] * r * g0, v1 = v[2 * j + 1] * r * g1;
              u32x4 o; o.x = cvt_pk_bf16(v0[0], v0[1]); o.y = cvt_pk_bf16(v0[2], v0[3]); o.z = cvt_pk_bf16(v1[0], v1[1]); o.w = cvt_pk_bf16(v1[2], v1[3]);
              *(u32x4*)(MN + (size_t)row * D + (j * 64 + lane) * 8) = o; } } }
    { float* qb = (float*)(ws + WS_QKVB); const float* b = a.in[21];
      for (int i = gt; i < 2 * ODD_IN; i += F.ngt) qb[i] = b[i] * (((i % ODD_IN) < NQH * HD) ? 0.125f : 1.0f); }
    { float* gxs = (float*)(ws + WS_GXS); const float* gx = a.in[3];
      for (int i = gt; i < 4 * D; i += F.ngt) gxs[i] = gx[i] * 0.044194173824159216f; }
}

__device__ __forceinline__ void unpack8(const u32x4 w, float (&f)[8]) { f[0] = bf_lo(w.x); f[1] = bf_hi(w.x); f[2] = bf_lo(w.y); f[3] = bf_hi(w.y); f[4] = bf_lo(w.z); f[5] = bf_hi(w.z); f[6] = bf_lo(w.w); f[7] = bf_hi(w.w); }
__device__ __forceinline__ void phase_convgate(const bf16_t* Z, const float* cw, bf16_t* YY, Frame& F) {
    PHASE_TID(F, tid, lane, gt);
    for (int idx = gt; idx < M * (AW / 8); idx += F.ngt) {
        const int row = idx >> 7, c8 = (idx & 127) * 8, t = row & (L - 1);
        const bf16_t* zr = Z + (size_t)row * EVEN_IN + c8;
        float gb[8], a0[8], b0[8], a1[8], b1[8], a2[8], b2[8];
        unpack8(*(const u32x4*)zr, gb); unpack8(*(const u32x4*)(zr + AW), a0); unpack8(*(const u32x4*)(zr + 2 * AW), b0);
        const u32x4 zero = (u32x4){0u, 0u, 0u, 0u};
        unpack8(t >= 1 ? *(const u32x4*)(zr - EVEN_IN + AW) : zero, a1); unpack8(t >= 1 ? *(const u32x4*)(zr - EVEN_IN + 2 * AW) : zero, b1);
        unpack8(t >= 2 ? *(const u32x4*)(zr - 2 * EVEN_IN + AW) : zero, a2); unpack8(t >= 2 ? *(const u32x4*)(zr - 2 * EVEN_IN + 2 * AW) : zero, b2);
        float o[8];
#pragma unroll
        for (int j = 0; j < 8; ++j) o[j] = gb[j] * (cw[2 * AW + c8 + j] * (a0[j] * b0[j]) + cw[AW + c8 + j] * (a1[j] * b1[j]) + cw[c8 + j] * (a2[j] * b2[j]));
        u32x4 w; w.x = cvt_pk_bf16(o[0], o[1]); w.y = cvt_pk_bf16(o[2], o[3]); w.z = cvt_pk_bf16(o[4], o[5]); w.w = cvt_pk_bf16(o[6], o[7]);
        *(u32x4*)(YY + (size_t)row * D + c8) = w;
    }
}

__device__ __forceinline__ void phase_mlp_fixup(const float* HG, const float* HU, const float* cw, const float* cb, bf16_t* ACT, Frame& F) {
    PHASE_TID(F, tid, lane, gt);
    for (int idx = gt; idx < 512 * (DFF / 4); idx += F.ngt) {
        const int ri = idx / (DFF / 4), c = (idx % (DFF / 4)) * 4, blk = ri >> 1, e = ri & 1, r = blk * 64 + e, t = r & (L - 1);
        const f32x4 zero = (f32x4){0.f, 0.f, 0.f, 0.f};
        f32x4 gm2, gm1, g0;
        if (e == 0) { gm2 = (t >= 2) ? *(const f32x4*)(HG + ((size_t)(blk - 1) * 4 + 0) * DFF + c) : zero; gm1 = (t >= 1) ? *(const f32x4*)(HG + ((size_t)(blk - 1) * 4 + 1) * DFF + c) : zero; g0 = *(const f32x4*)(HG + ((size_t)blk * 4 + 2) * DFF + c); }
        else        { gm2 = (t >= 2) ? *(const f32x4*)(HG + ((size_t)(blk - 1) * 4 + 1) * DFF + c) : zero; gm1 = *(const f32x4*)(HG + ((size_t)blk * 4 + 2) * DFF + c); g0 = *(const f32x4*)(HG + ((size_t)blk * 4 + 3) * DFF + c); }
        const f32x4 up = *(const f32x4*)(HU + ((size_t)blk * 2 + e) * DFF + c);
        const f32x4 w0 = *(const f32x4*)(cw + c), w1 = *(const f32x4*)(cw + DFF + c), w2 = *(const f32x4*)(cw + 2 * DFF + c), bb = *(const f32x4*)(cb + c);
        f32x4 pre = w2 * g0 + w1 * gm1 + w0 * gm2 + bb, a;
#pragma unroll
        for (int j = 0; j < 4; ++j) a[j] = pre[j] * fast_sigmoid(pre[j]) * up[j];
        u32x2 w; w.x = cvt_pk_bf16(a[0], a[1]); w.y = cvt_pk_bf16(a[2], a[3]);
        *(u32x2*)(ACT + (size_t)r * DFF + c) = w;
    }
}

__device__ __forceinline__ void phase_ya_fixup(const float* HV, const float* HGB, const float* cw, bf16_t* YY, Frame& F) {
    PHASE_TID(F, tid, lane, gt);
    for (int idx = gt; idx < 512 * (AW / 4); idx += F.ngt) {
        const int ri = idx >> 8, c = (idx & 255) * 4, blk = ri >> 1, e = ri & 1, r = blk * 64 + e, t = r & (L - 1);
        const f32x4 zero = (f32x4){0.f, 0.f, 0.f, 0.f};
        f32x4 vm2, vm1, v0;
        if (e == 0) { vm2 = (t >= 2) ? *(const f32x4*)(HV + ((size_t)(blk - 1) * 4 + 0) * AW + c) : zero; vm1 = (t >= 1) ? *(const f32x4*)(HV + ((size_t)(blk - 1) * 4 + 1) * AW + c) : zero; v0 = *(const f32x4*)(HV + ((size_t)blk * 4 + 2) * AW + c); }
        else        { vm2 = (t >= 2) ? *(const f32x4*)(HV + ((size_t)(blk - 1) * 4 + 1) * AW + c) : zero; vm1 = *(const f32x4*)(HV + ((size_t)blk * 4 + 2) * AW + c); v0 = *(const f32x4*)(HV + ((size_t)blk * 4 + 3) * AW + c); }
        const f32x4 gb = *(const f32x4*)(HGB + ((size_t)blk * 2 + e) * AW + c);
        const f32x4 w0 = *(const f32x4*)(cw + c), w1 = *(const f32x4*)(cw + AW + c), w2 = *(const f32x4*)(cw + 2 * AW + c);
        const f32x4 a = gb * (w2 * v0 + w1 * vm1 + w0 * vm2);
        u32x2 w; w.x = cvt_pk_bf16(a[0], a[1]); w.y = cvt_pk_bf16(a[2], a[3]);
        *(u32x2*)(YY + (size_t)r * D + c) = w;
    }
}

__device__ __forceinline__ void phase_final(const bf16_t* HB, const i64* ss, const float* g, float* out, Frame& F) {
    PHASE_TID(F, tid, lane, gt);
    for (size_t i = gt; i < (size_t)M * D / 8; i += F.ngt) {
        const int row = (int)(i >> 8), c = (int)(i & 255) * 8;
        const float rs = 1.0f / sqrtf((float)ss[row] * SS_INV + EPS);
        float h[8]; unpack8(*(const u32x4*)(HB + i * 8), h);
        const f32x4 g0 = *(const f32x4*)(g + c), g1 = *(const f32x4*)(g + c + 4);
        *(f32x4*)(out + i * 8) = (f32x4){h[0], h[1], h[2], h[3]} * rs * g0; *(f32x4*)(out + i * 8 + 4) = (f32x4){h[4], h[5], h[6], h[7]} * rs * g1;
    }
}

typedef float f32x16 __attribute__((ext_vector_type(16)));
constexpr int SWA_KSTR = 144, SWA_VSTR = 520, SWA_K_OFF = 0, SWA_V_OFF = 256 * SWA_KSTR, SWA_T_OFF = SWA_V_OFF + 64 * SWA_VSTR, SWA_TLEN = 192;
__device__ __forceinline__ void phase_swa(const bf16_t* QKV, const float* rel_bias, const float* sinks, bf16_t* O, Frame& F) {
    PHASE_TID(F, tid, lane, gt);
    const float LOG2E = 1.4426950408889634f;
    LAS unsigned char* lds = F.lds;
    const int q31 = lane & 31, hf = lane >> 5;
    for (int unit = F.bid; unit < NB * 32 * NKVH; unit += F.G) {
        const int b = unit >> 7, n = (unit >> 2) & 31, kvh = unit & 3, row0 = b * L + n * 128;
#pragma unroll
        for (int i = 0; i < 4; ++i) { const int it = tid + i * NTHR, key = it >> 3, ch = it & 7;
            u32x4 v = (u32x4){0u, 0u, 0u, 0u};
            if (n > 0 || key >= 128) v = *(const u32x4*)(QKV + (size_t)(row0 - 128 + key) * ODD_IN + NQH * HD + kvh * HD + ch * 8);
            *(LAS u32x4*)(lds + SWA_K_OFF + key * SWA_KSTR + ch * 16) = v; }
#pragma unroll
        for (int i = 0; i < 2; ++i) { const int it = tid + i * NTHR, dc = it & 7, kp = it >> 3;
            u32x4 v0 = (u32x4){0u, 0u, 0u, 0u}, v1 = v0;
            if (n > 0 || kp >= 64) { const bf16_t* vp = QKV + (size_t)(row0 - 128 + 2 * kp) * ODD_IN + (NQH + NKVH) * HD + kvh * HD + dc * 8; v0 = *(const u32x4*)vp; v1 = *(const u32x4*)(vp + ODD_IN); }
            LAS unsigned char* dst = lds + SWA_V_OFF + (dc * 8) * SWA_VSTR + kp * 4;
            *(LAS unsigned*)(dst + 0 * SWA_VSTR) = (v0.x & 0xffffu) | (v1.x << 16); *(LAS unsigned*)(dst + 1 * SWA_VSTR) = (v0.x >> 16) | (v1.x & 0xffff0000u);
            *(LAS unsigned*)(dst + 2 * SWA_VSTR) = (v0.y & 0xffffu) | (v1.y << 16); *(LAS unsigned*)(dst + 3 * SWA_VSTR) = (v0.y >> 16) | (v1.y & 0xffff0000u);
            *(LAS unsigned*)(dst + 4 * SWA_VSTR) = (v0.z & 0xffffu) | (v1.z << 16); *(LAS unsigned*)(dst + 5 * SWA_VSTR) = (v0.z >> 16) | (v1.z & 0xffff0000u);
            *(LAS unsigned*)(dst + 6 * SWA_VSTR) = (v0.w & 0xffffu) | (v1.w << 16); *(LAS unsigned*)(dst + 7 * SWA_VSTR) = (v0.w >> 16) | (v1.w & 0xffff0000u); }
        for (int idx = tid; idx < 8 * SWA_TLEN; idx += NTHR) { const int g = idx / SWA_TLEN, e = idx % SWA_TLEN, rel = e - 31;
            const float v = (rel >= 0 && rel < 128) ? rel_bias[kBucket[rel] * NQH + kvh * 8 + g] * LOG2E : -1e30f;
            *(LAS float*)(lds + SWA_T_OFF + idx * 4) = v; }
        __syncthreads();
        const int hq = kvh * 8 + F.wave; const float sink2 = sinks[hq] * LOG2E;
        bf16x8 qn[4];
        { const bf16_t* qp = QKV + (size_t)(row0 + q31) * ODD_IN + hq * HD + 8 * hf;
#pragma unroll
          for (int s = 0; s < 4; ++s) qn[s] = *(const bf16x8*)(qp + 16 * s); }
#pragma unroll 1
        for (int qt = 0; qt < 4; ++qt) {
            bf16x8 qf[4];
#pragma unroll
            for (int s = 0; s < 4; ++s) qf[s] = qn[s];
            if (qt < 3) { const bf16_t* qp = QKV + (size_t)(row0 + 32 * (qt + 1) + q31) * ODD_IN + hq * HD + 8 * hf;
#pragma unroll
                for (int s = 0; s < 4; ++s) qn[s] = *(const bf16x8*)(qp + 16 * s); }
            f32x16 S[5];
#pragma unroll
            for (int dt = 0; dt < 5; ++dt) {
                const int kt = qt + dt;
                if (n == 0 && kt < 4) {
#pragma unroll
                    for (int i = 0; i < 16; ++i) S[dt][i] = -1e30f;
                } else {
                    f32x16 acc;
#pragma unroll
                    for (int i = 0; i < 16; ++i) acc[i] = 0.f;
#pragma unroll
                    for (int s = 0; s < 4; ++s) { const bf16x8 kf = *(const LAS bf16x8*)(lds + SWA_K_OFF + (32 * kt + q31) * SWA_KSTR + (16 * s + 8 * hf) * 2);
                        acc = __builtin_amdgcn_mfma_f32_32x32x16_bf16(kf, qf[s], acc, 0, 0, 0); }
                    const LAS unsigned char* tb = lds + SWA_T_OFF + (F.wave * SWA_TLEN + 159 - 32 * dt + q31 - 4 * hf - 27) * 4;
#pragma unroll
                    for (int i = 0; i < 16; ++i) S[dt][i] = acc[i] * LOG2E + *(const LAS float*)(tb + (27 - (8 * (i >> 2) + (i & 3))) * 4);
                }
            }
            float mx = sink2;
#pragma unroll
            for (int dt = 0; dt < 5; ++dt)
#pragma unroll
                for (int i = 0; i < 16; ++i) mx = fmaxf(mx, S[dt][i]);
            mx = fmaxf(mx, shx(mx, 32, lane));
            float l = 0.f;
#pragma unroll
            for (int dt = 0; dt < 5; ++dt)
#pragma unroll
                for (int i = 0; i < 16; ++i) { const float p = __builtin_amdgcn_exp2f(S[dt][i] - mx); S[dt][i] = p; l += p; }
            l += shx(l, 32, lane);
            const float inv = __builtin_amdgcn_rcpf(l + __builtin_amdgcn_exp2f(sink2 - mx));
            f32x16 oa[2];
#pragma unroll
            for (int dd = 0; dd < 2; ++dd)
#pragma unroll
                for (int i = 0; i < 16; ++i) oa[dd][i] = 0.f;
#pragma unroll
            for (int dt = 0; dt < 5; ++dt) {
                const int kt = qt + dt;
                if (!(n == 0 && kt < 4)) {
#pragma unroll
                    for (int s = 0; s < 2; ++s) {
                        u32x4 pw; pw.x = cvt_pk_bf16(S[dt][8 * s + 0], S[dt][8 * s + 1]); pw.y = cvt_pk_bf16(S[dt][8 * s + 2], S[dt][8 * s + 3]); pw.z = cvt_pk_bf16(S[dt][8 * s + 4], S[dt][8 * s + 5]); pw.w = cvt_pk_bf16(S[dt][8 * s + 6], S[dt][8 * s + 7]);
                        const bf16x8 pb = __builtin_bit_cast(bf16x8, pw);
#pragma unroll
                        for (int dd = 0; dd < 2; ++dd) {
                            const LAS unsigned char* vp = lds + SWA_V_OFF + (32 * dd + q31) * SWA_VSTR + (32 * kt + 16 * s + 4 * hf) * 2;
                            const u32x2 a0 = *(const LAS u32x2*)vp, a1 = *(const LAS u32x2*)(vp + 16);
                            const bf16x8 va = __builtin_bit_cast(bf16x8, (u32x4){a0.x, a0.y, a1.x, a1.y});
                            oa[dd] = __builtin_amdgcn_mfma_f32_32x32x16_bf16(va, pb, oa[dd], 0, 0, 0);
                        }
                    }
                }
            }
            bf16_t* op = O + (size_t)(row0 + 32 * qt + q31) * D + hq * HD + 4 * hf;
#pragma unroll
            for (int dd = 0; dd < 2; ++dd)
#pragma unroll
                for (int g4 = 0; g4 < 4; ++g4) { u32x2 w; w.x = cvt_pk_bf16(oa[dd][4 * g4 + 0] * inv, oa[dd][4 * g4 + 1] * inv); w.y = cvt_pk_bf16(oa[dd][4 * g4 + 2] * inv, oa[dd][4 * g4 + 3] * inv);
                    *(u32x2*)(op + 32 * dd + 8 * g4) = w; }
        }
        __syncthreads();
    }
}

constexpr int S5_PW_OFF = 0, S5_KC_OFF = 4608, S5_SL_OFF = 9216, S5_XB_OFF = 41984, S5_XSTR = 272;
__device__ __forceinline__ float bfe(const bf16x8& v, int j) { return __uint_as_float(((unsigned)(unsigned short)v[j]) << 16); }
template <int RT>
__device__ __forceinline__ void s5_unit(const bf16_t* Z, const float* s5p, const float* c_re, const float* c_im, const float* dvec, const float* glu, bf16_t* YY, LAS unsigned char* lds,
                                        const int b, const int g, const int wave, const int tid, const int lane) {
    const int q31 = lane & 31, hf = lane >> 5, mtl = wave >> 2;
    LAS f32x2* PW = (LAS f32x2*)(lds + S5_PW_OFF);
    { const int p = tid & 63, j = tid >> 6; const float ar = s5p[(size_t)(g * 64 + p) * 34], ai = s5p[(size_t)(g * 64 + p) * 34 + 1];
      float pr = 1.f, pi = 0.f;
      for (int k = 0; k < j; ++k) { const float nr = pr * ar - pi * ai, ni = pr * ai + pi * ar; pr = nr; pi = ni; }
      PW[j * 64 + p] = (f32x2){pr, pi};
      if (j == 7) PW[8 * 64 + p] = (f32x2){pr * ar - pi * ai, pr * ai + pi * ar}; }
    __syncthreads();
    { LAS bf16_t* KC = (LAS bf16_t*)(lds + S5_KC_OFF);
#pragma unroll 1
      for (int q = 0; q < 4; ++q) { const int e = tid + NTHR * q, jj = e >> 8, h = (e >> 4) & 15, hp = e & 15;
          const float* cr = c_re + (size_t)(g * 16 + h) * 64; const float* ci = c_im + (size_t)(g * 16 + h) * 64; const float* bb = s5p + (size_t)(g * 64) * 34 + 2 + hp;
          float sum = 0.f;
#pragma unroll 4
          for (int p = 0; p < 64; ++p) { const f32x2 pw = PW[jj * 64 + p]; const float tr = cr[p] * pw.x - ci[p] * pw.y, ti = cr[p] * pw.y + ci[p] * pw.x; sum += tr * bb[p * 34] - ti * bb[p * 34 + 16]; }
          const int pos = 8 * ((hp >> 2) & 1) + 4 * (hp >> 3) + (hp & 3);
          KC[(jj * 16 + h) * 16 + pos] = (bf16_t)(cvt_pk_bf16(sum, 0.f) & 0xffffu); }
      if (tid < 128) ((LAS unsigned*)(KC + 8 * 256))[tid] = 0u; }
    __syncthreads();
    bf16x8 pf[8], qf[8], kf[2 * RT + 2], ga[2]; float d8[8];
    {
      const int comp = 32 * RT + q31, p = comp & 63; const bool im = comp >= 64; const float* bbp = s5p + (size_t)(g * 64 + p) * 34 + 2;
      float br[8], bi[8];
#pragma unroll
      for (int j = 0; j < 8; ++j) { const int hp = 8 * (j >> 2) + 4 * hf + (j & 3); br[j] = bbp[hp]; bi[j] = bbp[16 + hp]; }
#pragma unroll
      for (int s = 0; s < 8; ++s) { const f32x2 pw = PW[(7 - s) * 64 + p]; float v[8];
#pragma unroll
          for (int j = 0; j < 8; ++j) v[j] = im ? (pw.x * bi[j] + pw.y * br[j]) : (pw.x * br[j] - pw.y * bi[j]);
          u32x4 w; w.x = cvt_pk_bf16(v[0], v[1]); w.y = cvt_pk_bf16(v[2], v[3]); w.z = cvt_pk_bf16(v[4], v[5]); w.w = cvt_pk_bf16(v[6], v[7]); pf[s] = __builtin_bit_cast(bf16x8, w); } }
    {
      const int t2 = 2 * RT + (q31 >> 4), h = q31 & 15; const float* cr = c_re + (size_t)(g * 16 + h) * 64; const float* ci = c_im + (size_t)(g * 16 + h) * 64;
#pragma unroll
      for (int ks = 0; ks < 4; ++ks) { float vr[8], vi[8];
#pragma unroll
          for (int j = 0; j < 8; ++j) { const int p = 16 * ks + 8 * hf + j; const f32x2 pw = PW[(t2 + 1) * 64 + p]; const float a = cr[p], c = ci[p]; vr[j] = a * pw.x - c * pw.y; vi[j] = -(a * pw.y + c * pw.x); }
          u32x4 w; w.x = cvt_pk_bf16(vr[0], vr[1]); w.y = cvt_pk_bf16(vr[2], vr[3]); w.z = cvt_pk_bf16(vr[4], vr[5]); w.w = cvt_pk_bf16(vr[6], vr[7]); qf[ks] = __builtin_bit_cast(bf16x8, w);
          w.x = cvt_pk_bf16(vi[0], vi[1]); w.y = cvt_pk_bf16(vi[2], vi[3]); w.z = cvt_pk_bf16(vi[4], vi[5]); w.w = cvt_pk_bf16(vi[6], vi[7]); qf[ks + 4] = __builtin_bit_cast(bf16x8, w); }
#pragma unroll
      for (int s = 0; s < 2 * RT + 2; ++s) { int jj = t2 - s; jj = jj < 0 ? 8 : jj; kf[s] = *(const LAS bf16x8*)(lds + S5_KC_OFF + ((jj * 16 + h) * 16 + 8 * hf) * 2); }
      const int o = q31 & 15, t2p = q31 >> 4;
#pragma unroll
      for (int ks = 0; ks < 2; ++ks) { float v[8];
#pragma unroll
          for (int j = 0; j < 8; ++j) { const int hh = 8 * (j >> 2) + 4 * hf + (j & 3); v[j] = (t2p == ks) ? glu[g * 256 + hh * 16 + o] : 0.f; }
          u32x4 w; w.x = cvt_pk_bf16(v[0], v[1]); w.y = cvt_pk_bf16(v[2], v[3]); w.z = cvt_pk_bf16(v[4], v[5]); w.w = cvt_pk_bf16(v[6], v[7]); ga[ks] = __builtin_bit_cast(bf16x8, w); }
#pragma unroll
      for (int j = 0; j < 8; ++j) d8[j] = dvec[g * 16 + 8 * (j >> 2) + 4 * hf + (j & 3)]; }
    const f32x2 a8 = PW[8 * 64 + lane];
    float Sre = 0.f, Sim = 0.f;
    LAS float* SL = (LAS float*)(lds + S5_SL_OFF);
#pragma unroll 1
    for (int seg = 0; seg < 8; ++seg) {
        const int mloc = mtl * 32 + q31; const size_t tok0 = (size_t)b * L + 8 * (seg * 64 + mloc);
        const bf16_t* up = Z + ((size_t)g * M + tok0) * 16 + 4 * hf;
        bf16x8 uf[8];
#pragma unroll
        for (int s = 0; s < 8; ++s) { const u32x2 lo = *(const u32x2*)(up + s * 16), hi = *(const u32x2*)(up + s * 16 + 8); uf[s] = __builtin_bit_cast(bf16x8, (u32x4){lo.x, lo.y, hi.x, hi.y}); }
        { f32x16 acc;
#pragma unroll
          for (int i = 0; i < 16; ++i) acc[i] = 0.f;
#pragma unroll
          for (int s = 0; s < 8; ++s) acc = __builtin_amdgcn_mfma_f32_32x32x16_bf16(uf[s], pf[s], acc, 0, 0, 0);
#pragma unroll
          for (int i = 0; i < 16; ++i) SL[(mtl * 32 + 8 * (i >> 2) + 4 * hf + (i & 3)) * 128 + 32 * RT + q31] = acc[i]; }
        __syncthreads();
        if (wave == 0) {
#pragma unroll 1
            for (int blk = 0; blk < 8; ++blk) { float lr[8], li[8];
#pragma unroll
                for (int k = 0; k < 8; ++k) { lr[k] = SL[(blk * 8 + k) * 128 + lane]; li[k] = SL[(blk * 8 + k) * 128 + 64 + lane]; }
#pragma unroll
                for (int k = 0; k < 8; ++k) { LAS bf16_t* xr = (LAS bf16_t*)(lds + S5_XB_OFF + (blk * 8 + k) * S5_XSTR);
                    const unsigned w = cvt_pk_bf16(Sre, Sim); xr[lane] = (bf16_t)(w & 0xffffu); xr[64 + lane] = (bf16_t)(w >> 16);
                    const float nr = a8.x * Sre - a8.y * Sim + lr[k], ni = a8.x * Sim + a8.y * Sre + li[k]; Sre = nr; Sim = ni; } } }
        __syncthreads();
        { f32x16 acc;
#pragma unroll
          for (int i = 0; i < 16; ++i) acc[i] = 0.f;
#pragma unroll
          for (int s = 0; s < 2 * RT + 2; ++s) acc = __builtin_amdgcn_mfma_f32_32x32x16_bf16(kf[s], uf[s], acc, 0, 0, 0);
#pragma unroll
          for (int ks = 0; ks < 8; ++ks) { const bf16x8 xf = *(const LAS bf16x8*)(lds + S5_XB_OFF + mloc * S5_XSTR + (16 * ks + 8 * hf) * 2); acc = __builtin_amdgcn_mfma_f32_32x32x16_bf16(qf[ks], xf, acc, 0, 0, 0); }
          float yg[16];
#pragma unroll
          for (int i = 0; i < 16; ++i) yg[i] = gelu_tanh_f(acc[i] + d8[i & 7] * bfe(uf[2 * RT + (i >> 3)], i & 7));
          f32x16 gt;
#pragma unroll
          for (int i = 0; i < 16; ++i) gt[i] = 0.f;
#pragma unroll
          for (int ks = 0; ks < 2; ++ks) { u32x4 w; w.x = cvt_pk_bf16(yg[8 * ks + 0], yg[8 * ks + 1]); w.y = cvt_pk_bf16(yg[8 * ks + 2], yg[8 * ks + 3]); w.z = cvt_pk_bf16(yg[8 * ks + 4], yg[8 * ks + 5]); w.w = cvt_pk_bf16(yg[8 * ks + 6], yg[8 * ks + 7]);
              gt = __builtin_amdgcn_mfma_f32_32x32x16_bf16(ga[ks], __builtin_bit_cast(bf16x8, w), gt, 0, 0, 0); }
          bf16_t* op = YY + (tok0 + 2 * RT) * D + AW + g * 16 + 4 * hf;
#pragma unroll
          for (int t2l = 0; t2l < 2; ++t2l)
#pragma unroll
              for (int grp = 0; grp < 2; ++grp) { const int i0 = 8 * t2l + 4 * grp; float o[4];
#pragma unroll
                  for (int r = 0; r < 4; ++r) o[r] = yg[i0 + r] * fast_sigmoid(gt[i0 + r]);
                  u32x2 w; w.x = cvt_pk_bf16(o[0], o[1]); w.y = cvt_pk_bf16(o[2], o[3]);
                  *(u32x2*)(op + (size_t)t2l * D + 8 * grp) = w; } }
    }
    __syncthreads();
}
__device__ __forceinline__ void phase_s5(const bf16_t* Z, const float* s5p, const float* c_re, const float* c_im, const float* dvec, const float* glu, bf16_t* YY, Frame& F) {
    PHASE_TID(F, tid, lane, gt);
    for (int unit = F.bid; unit < NB * S5G; unit += F.G) {
        const int b = unit / S5G, g = unit % S5G;
        switch (F.wave & 3) {
            case 0: s5_unit<0>(Z, s5p, c_re, c_im, dvec, glu, YY, F.lds, b, g, F.wave, tid, lane); break;
            case 1: s5_unit<1>(Z, s5p, c_re, c_im, dvec, glu, YY, F.lds, b, g, F.wave, tid, lane); break;
            case 2: s5_unit<2>(Z, s5p, c_re, c_im, dvec, glu, YY, F.lds, b, g, F.wave, tid, lane); break;
            default: s5_unit<3>(Z, s5p, c_re, c_im, dvec, glu, YY, F.lds, b, g, F.wave, tid, lane); break;
        }
    }
}
namespace pg8 {
struct SchedKV {
    unsigned char* ws; int G, c;
    __device__ __forceinline__ bool next(int i, Unit& u) const {
        const long Lx = (long)i * G + c; if (Lx >= 256) return false;
        const int l = (int)Lx >> 6, rem = (int)Lx & 63, pm = rem >> 4, pn = rem & 15;
        u.A = (const char*)(ws + WS_MEMN) + (size_t)pm * 256 * D * 2;
        u.B = (const char*)(ws + WS_WKV_T) + ((size_t)l * 2 * D + pn * 256) * D * 2;
        u.C = (char*)(ws + WS_KVM) + (pn >= 8 ? 16 * MiB : 0) + (((size_t)l * MROWS + pm * 256) * D + (pn & 7) * 256) * 2;
        u.vec = nullptr; u.row0 = pm * 256; u.col0 = pn * 256; u.aux = D; return true;
    }
};
struct SchedWSVW {
    unsigned char* ws; const float* gx; int G, c;
    __device__ __forceinline__ bool next(int i, Unit& u) const {
        const long Lx = (long)i * G + c; if (Lx >= 1024) return false;
        const int j = (int)Lx & 511, z = j >> 3, pt = j & 7, l = z >> 4, b = (z >> 2) & 3, head = z & 3;
        if (Lx < 512) {
            u.A = (const char*)(ws + WS_KVM) + (((size_t)l * MROWS + b * 256) * D + head * XHD) * 2;
            u.B = (const char*)(ws + WS_WQ_BF) + (((size_t)l * D + pt * 256) * D + head * XHD) * 2;
            u.C = (char*)(ws + WS_WS) + ((((size_t)(l * 4 + b) * 1024 + head * 256) * D) + pt * 256) * 2;
            u.vec = gx + l * D; u.row0 = 0; u.col0 = pt * 256; u.aux = D;
        } else {
            u.A = (const char*)(ws + WS_WO_T) + (((size_t)l * D + pt * 256) * D + head * XHD) * 2;
            u.B = (const char*)(ws + WS_KVM) + 16 * MiB + (((size_t)l * MROWS + b * 256) * D + head * XHD) * 2;
            u.C = (char*)(ws + WS_VW) + ((((size_t)(l * 4 + b) * D + pt * 256) * 1024) + head * 256) * 2;
            u.vec = nullptr; u.row0 = 0; u.col0 = 0; u.aux = 1024;
        }
        return true;
    }
};
}

#ifndef NO_PKF32
#define NO_PKF32 1
#endif
#if NO_PKF32 && defined(__HIP_DEVICE_COMPILE__)
#define MEGA_TGT __attribute__((target("no-packed-fp32-ops")))
#else
#define MEGA_TGT
#endif
__global__ void __launch_bounds__(NTHR, 2) MEGA_TGT mega_fwd(Args a) {
    extern __shared__ __attribute__((aligned(16))) unsigned char lds_raw[];
    Frame F;
    F.lds = (LAS unsigned char*)lds_raw;
    const int tid0 = threadIdx.x; F.wave = __builtin_amdgcn_readfirstlane(tid0 >> 6);
    F.G = gridDim.x; F.bid = blockIdx.x;
    F.gw = F.bid * NWAVES + F.wave; F.ngw = F.G * NWAVES; F.ngt = F.G * NTHR;
    unsigned char* ws = a.ws;
    volatile LAS unsigned* MISC = (volatile LAS unsigned*)(F.lds + MISC_OFF);
    for (int u = tid0; u < (LDS_BYTES - MISC_OFF) / 4; u += NTHR) ((LAS unsigned*)(F.lds + MISC_OFF))[u] = 0u;
    __syncthreads();
    unsigned* ctl = (unsigned*)(ws + WS_CTL);
    const XcdBarrier bar = xcd_barrier_post(ctl + CW_BAR, MISC + 8, F.wave);
    static_assert(8 * 16640 <= MISC_OFF, "prologue scratch below the control words");
    static_assert((CW_BAR + XCD_BAR_WORDS) * 4 <= (int)CTL_ZERO_BYTES, "barrier words inside the memset region");
#define GRID_BAR() do { xcd_barrier(bar); if (PROBE_BAR) xcd_barrier(bar); } while (0)

    i64* SS = (i64*)(ws + WS_SS);
    bf16_t* HB = (bf16_t*)(ws + WS_HB); bf16_t* YY = (bf16_t*)(ws + WS_YY);
    bf16_t* BIG = (bf16_t*)(ws + WS_BIG);
    float* HG = (float*)(ws + WS_HALO_G); float* HU = (float*)(ws + WS_HALO_U);
    float* DUMF = (float*)(ws + WS_END); bf16_t* DUMB = (bf16_t*)(ws + WS_END); (void)DUMF; (void)DUMB;
    const int cid = (int)blockIdx.x;

#ifndef PHMASK
#define PHMASK 0xFFFF
#endif
#ifndef PROBE_DUP
#define PROBE_DUP 0
#endif
#ifndef PROBE_KONLY
#define PROBE_KONLY 0
#endif
#ifndef F1_ALIGN
#define F1_ALIGN true
#endif
#ifndef F2_WGM
#define F2_WGM 4
#endif
#ifndef PROBE_BAR
#define PROBE_BAR 0
#endif
#define REP(bit) for (int rep_ = 0; rep_ < (((PROBE_DUP) & (bit)) ? 2 : 1); ++rep_)
    REP(1) if (PHMASK & 1) p0_prologue(a, F);
    GRID_BAR();
    for (int l = 0; l < 4; ++l) {
        const int i = l >> 1;
        if ((l & 1) == 0) {
            if (l == 0 && (PHMASK & 2)) { pg8::SchedKV S{ws, F.G, cid}; pg8::EpiPlain E;
              pg8::gemm_phase<pg8::EpiPlain, pg8::SchedKV, true>(F.lds, F.wave, D, D, D, S, E); }
            REP(8) if (PHMASK & 8) { pg8::SchedMain S{(const char*)HB, (const char*)(ws + WS_WIN_T) + (size_t)i * EVEN_IN * D * 2, nullptr, (size_t)256 * D * 2, (size_t)256 * D * 2, 0, 0, 0, 64, 16, 64, 64, F.G, cid};
              pg8::EpiEven E{SS + (size_t)(3 * l) * M, a.in[9] + (size_t)i * 3 * AW, YY, BIG, HG, HG + 2 * MiB};
              pg8::gemm_phase<pg8::EpiEven, pg8::SchedMain, true>(F.lds, F.wave, D, D, D, S, E); }
            GRID_BAR();
            if (l == 0 && (PHMASK & 4)) { pg8::SchedWSVW S{ws, (const float*)(ws + WS_GXS), F.G, cid}; pg8::EpiPlain E;
              pg8::gemm_phase<pg8::EpiPlain, pg8::SchedWSVW, true>(F.lds, F.wave, D, D, XHD, S, E); }
            REP(16) if (PHMASK & 16) phase_ya_fixup(HG, HG + 2 * MiB, a.in[9] + (size_t)i * 3 * AW, YY, F);
            REP(32) if (PHMASK & 32) phase_s5(BIG, (const float*)(ws + WS_S5P) + (size_t)i * 4096 * 34, a.in[15] + (size_t)i * 65536, a.in[16] + (size_t)i * 65536, a.in[17] + i * 1024, a.in[18] + (size_t)i * 16384, YY, F);
            GRID_BAR();
        } else {
            REP(64) if (PHMASK & 64) { pg8::SchedMain S{(const char*)HB, (const char*)(ws + WS_WQKV_T) + (size_t)i * ODD_IN * D * 2, (char*)BIG, (size_t)256 * D * 2, (size_t)256 * D * 2, 0, (size_t)256 * ODD_IN * 2, 256 * 2, 64, 10, 64, 256, F.G, cid};
              pg8::EpiRowScale E{SS + (size_t)(3 * l) * M, (const float*)(ws + WS_QKVB) + i * ODD_IN, ODD_IN};
              pg8::gemm_phase<pg8::EpiRowScale, pg8::SchedMain, true>(F.lds, F.wave, D, D, D, S, E); }
            GRID_BAR();
            REP(128) if (PHMASK & 128) phase_swa(BIG, a.in[7], a.in[22] + i * NQH, YY, F);
            GRID_BAR();
        }
        REP(256) if (PHMASK & 256) { const char* Bw = (l & 1) ? (const char*)(ws + WS_OWOUT_T) + (size_t)i * D * D * 2 : (const char*)(ws + WS_EWOUT_T) + (size_t)i * D * D * 2;
          pg8::SchedMain S{(const char*)YY, Bw, nullptr, (size_t)256 * D * 2, (size_t)256 * D * 2, 0, 0, 0, 64, 8, 64, 256, F.G, cid};
          pg8::EpiRes E{HB, rep_ ? DUMB : HB, SS + (size_t)(rep_ ? 13 : 3 * l + 1) * M, F.lds + RING_BYTES};
          pg8::gemm_phase<pg8::EpiRes, pg8::SchedMain, true>(F.lds, F.wave, D, D, D, S, E); }
        GRID_BAR();
        REP(512) if (PHMASK & 512) { pg8::SchedMain S{(const char*)HB, (const char*)(ws + WS_WS) + (size_t)l * 4 * 1024 * D * 2, (char*)BIG, (size_t)256 * D * 2, (size_t)256 * D * 2, (size_t)1024 * D * 2, (size_t)256 * 1024 * 2, 256 * 2, 64, 4, 16, 256, F.G, cid};
          pg8::EpiSoftmax E{SS + (size_t)(3 * l + 1) * M, 1024};
          pg8::gemm_phase<pg8::EpiSoftmax, pg8::SchedMain, false>(F.lds, F.wave, D, D, D, S, E); }
        GRID_BAR();
        REP(1024) if (PHMASK & 1024) { pg8::SchedMain S{(const char*)BIG, (const char*)(ws + WS_VW) + (size_t)l * 4 * D * 1024 * 2, nullptr, (size_t)256 * 1024 * 2, (size_t)256 * 1024 * 2, (size_t)D * 1024 * 2, 0, 0, 64, 8, 16, 256, F.G, cid};
          pg8::EpiRes E{HB, rep_ ? DUMB : HB, SS + (size_t)(rep_ ? 13 : 3 * l + 2) * M, F.lds + RING_BYTES};
          pg8::gemm_phase<pg8::EpiRes, pg8::SchedMain, true>(F.lds, F.wave, 1024, 1024, 1024, S, E); }
        GRID_BAR();
        REP(2048) if (PHMASK & 2048) { pg8::SchedMain S{(const char*)HB, (const char*)(ws + WS_WGU_T) + (size_t)l * NGU * D * 2, (char*)BIG, (size_t)256 * D * 2, (size_t)256 * D * 2, 0, (size_t)256 * DFF * 2, 128 * 2, 64, 44, 64, 128, F.G, cid};
          {
            PHASE_TID(F, tid, lane, gt); pg8::Unit fu; int nslots = 0, lastpm = -1;
            const float* cwp = a.in[29] + (size_t)l * 3 * DFF; const float* cbp = a.in[30] + (size_t)l * DFF; const i64* ssp = SS + (size_t)(3 * l + 2) * M;
            for (int ui = 0; ui < 12 && S.next(ui, fu); ++ui) {
                const int pm = fu.row0 >> 8;
                if (pm != lastpm && nslots < 3) { if (tid < 256) ((LAS float*)(F.lds + F1_RST_OFF))[nslots * 256 + tid] = rstd_of(ssp[pm * 256 + tid]); ++nslots; lastpm = pm; }
                if (tid == 0) ((LAS int*)(F.lds + F1_SLOT_OFF))[ui] = nslots - 1;
                const int vec = tid >> 7, ch = tid & 127;
                ((LAS float*)(F.lds + F1_CWT_OFF))[ui * 512 + tid] = (vec < 3 ? cwp[vec * DFF + fu.col0 + ch] : cbp[fu.col0 + ch]) * 1.4426950408889634f;
            }
            LDS_WAIT(); __syncthreads(); }
          pg8::EpiMLP E{F.lds, HG, HU};
          pg8::gemm_phase<pg8::EpiMLP, pg8::SchedMain, F1_ALIGN>(F.lds, F.wave, D, D, D, S, E);
          if (PROBE_KONLY & 2048) { pg8::EpiNull E0; pg8::gemm_phase<pg8::EpiNull, pg8::SchedMain, true>(F.lds, F.wave, D, D, D, S, E0); } }
        GRID_BAR();
        if (PHMASK & 4096) phase_mlp_fixup(HG, HU, a.in[29] + (size_t)l * 3 * DFF, a.in[30] + (size_t)l * DFF, BIG, F);
        GRID_BAR();
        REP(8192) if (PHMASK & 8192) { pg8::SchedMain S{(const char*)BIG, (const char*)(ws + WS_WDOWN_T) + (size_t)l * D * DFF * 2, nullptr, (size_t)256 * DFF * 2, (size_t)256 * DFF * 2, 0, 0, 0, 64, 8, 64, 256, F.G, cid, F2_WGM};
          pg8::EpiRes E{HB, rep_ ? DUMB : HB, SS + (size_t)(rep_ ? 13 : 3 * l + 3) * M, F.lds + RING_BYTES};
          pg8::gemm_phase<pg8::EpiRes, pg8::SchedMain, true>(F.lds, F.wave, DFF, DFF, DFF, S, E); }
        GRID_BAR();
    }
    if (PHMASK & 16384) phase_final(HB, SS + (size_t)12 * M, a.in[5], a.out, F);
#undef GRID_BAR
}

extern "C" void kernel_launch(void* const* d_in, const int* in_sizes, int n_in, void* d_out, int out_size, void* d_ws, size_t ws_size, hipStream_t stream) {
    static int grid = 0;
    if (grid == 0) {
        if (n_in != 32 || out_size != M * D || ws_size < WS_END) { fprintf(stderr, "kernel_launch: unexpected shapes (n_in %d out %d ws %zu)\n", n_in, out_size, ws_size); grid = -1; return; }
        int dev = 0, cus = 0, per_cu = 0;
        if (hipGetDevice(&dev) != hipSuccess || hipDeviceGetAttribute(&cus, hipDeviceAttributeMultiprocessorCount, dev) != hipSuccess) { grid = -1; return; }
        if (hipFuncSetAttribute((const void*)mega_fwd, hipFuncAttributeMaxDynamicSharedMemorySize, LDS_BYTES) != hipSuccess) { fprintf(stderr, "kernel_launch: hipFuncSetAttribute failed\n"); grid = -1; return; }
        if (hipOccupancyMaxActiveBlocksPerMultiprocessor(&per_cu, (const void*)mega_fwd, NTHR, LDS_BYTES) != hipSuccess || per_cu < 1) { fprintf(stderr, "kernel_launch: occupancy query says %d\n", per_cu); }
        (void)hipGetLastError();
        grid = cus;
    }
    if (grid < 0) return;
    if (hipMemsetAsync((char*)d_ws + WS_CTL, 0, CTL_ZERO_BYTES, stream) != hipSuccess) return;
    Args a{};
    for (int i = 0; i < 32; ++i) a.in[i] = (const float*)d_in[i];
    a.out = (float*)d_out; a.ws = (unsigned char*)d_ws;
    hipLaunchKernelGGL(mega_fwd, dim3(grid), dim3(NTHR), LDS_BYTES, stream, a);
}
```

```cpp
#include <hip/hip_runtime.h>
#include <stdint.h>
#include <stdio.h>

#define LAS __attribute__((address_space(3)))
#define GAS __attribute__((address_space(1)))
typedef unsigned short bf16_t;
typedef short bf16x8 __attribute__((ext_vector_type(8)));
typedef float f32x4 __attribute__((ext_vector_type(4)));
typedef float f32x2 __attribute__((ext_vector_type(2)));
typedef unsigned u32x4 __attribute__((ext_vector_type(4)));
typedef unsigned u32x2 __attribute__((ext_vector_type(2)));
typedef GAS unsigned gu32;

constexpr int D = 2048, NB = 4, L = 4096, M = NB * L, NMEM = 256, MROWS = NB * NMEM;
constexpr int AW = 1024, S5G = 64, EVEN_IN = 4096;
constexpr int HD = 64, NQH = 32, NKVH = 4, ODD_IN = 2560;
constexpr int XH = 4, XHD = 512, DFF = 5632, NGU = 2 * DFF;
constexpr float EPS = 1e-5f;
constexpr int NWAVES = 8, NTHR = 512;

constexpr size_t MiB = 1u << 20;
constexpr size_t WS_CTL = 0, CTL_ZERO_BYTES = 32768;
constexpr size_t WS_QKVB = 1 * MiB;
constexpr size_t WS_GXS = 1 * MiB + 64 * 1024;
constexpr size_t WS_WIN_T = 2 * MiB;
constexpr size_t WS_EWOUT_T = 34 * MiB;
constexpr size_t WS_WQKV_T = 50 * MiB;
constexpr size_t WS_OWOUT_T = 70 * MiB;
constexpr size_t WS_WS = 86 * MiB;
constexpr size_t WS_VW = 150 * MiB;
constexpr size_t WS_WGU_T = 214 * MiB;
constexpr size_t WS_WDOWN_T = 390 * MiB;
constexpr size_t WS_H = 478 * MiB;
constexpr size_t WS_HB = 606 * MiB;
constexpr size_t WS_YY = 670 * MiB;
constexpr size_t WS_BIG = 734 * MiB;
constexpr size_t WS_WQ_BF = WS_H;
constexpr size_t WS_WKV_T = WS_H + 32 * MiB;
constexpr size_t WS_WO_T = WS_H + 96 * MiB;
constexpr size_t WS_KVM = 952 * MiB;
constexpr size_t WS_MEMN = 984 * MiB;
constexpr size_t WS_HALO_G = 910 * MiB;
constexpr size_t WS_HALO_U = 934 * MiB;
constexpr size_t WS_S5P = 946 * MiB;
constexpr size_t WS_SS = 948 * MiB;
constexpr size_t WS_END = 990 * MiB;

constexpr int CW_BAR = 4096;

constexpr int RING_BYTES = 131072;
constexpr int LDS_BYTES = 163840;
constexpr int MISC_OFF = LDS_BYTES - 256;
constexpr int F1_CWT_OFF = RING_BYTES, F1_RST_OFF = RING_BYTES + 12 * 2048, F1_SLOT_OFF = F1_RST_OFF + 3 * 1024;

#define RLX_AGENT __ATOMIC_RELAXED, __HIP_MEMORY_SCOPE_AGENT
#define LDS_WAIT() asm volatile("s_waitcnt lgkmcnt(0)" ::: "memory")
#define VM_WAIT() asm volatile("s_waitcnt vmcnt(0)" ::: "memory")
__device__ __forceinline__ unsigned cvt_pk_bf16(float lo, float hi) { unsigned r; asm volatile("v_cvt_pk_bf16_f32 %0, %1, %2" : "=v"(r) : "v"(lo), "v"(hi)); return r; }
__device__ __forceinline__ float bf_lo(unsigned w) { return __uint_as_float(w << 16); }
__device__ __forceinline__ float bf_hi(unsigned w) { return __uint_as_float(w & 0xffff0000u); }
__device__ __forceinline__ float bf1(bf16_t b) { return __uint_as_float(((unsigned)b) << 16); }
__device__ __forceinline__ float shx(float v, int mask, int lane) { return __builtin_bit_cast(float, __builtin_amdgcn_ds_bpermute((lane ^ mask) << 2, __builtin_bit_cast(int, v))); }
__device__ __forceinline__ float shl_(float v, int src, int lane) { (void)lane; return __builtin_bit_cast(float, __builtin_amdgcn_ds_bpermute(src << 2, __builtin_bit_cast(int, v))); }
__device__ __forceinline__ float wave_sum(float v, int lane) {
#pragma unroll
    for (int o = 1; o < 64; o <<= 1) v += shx(v, o, lane);
    return v;
}
__device__ __forceinline__ float wave_max(float v, int lane) {
#pragma unroll
    for (int o = 1; o < 64; o <<= 1) v = fmaxf(v, shx(v, o, lane));
    return v;
}
__device__ __forceinline__ float fast_exp(float x) { return __builtin_amdgcn_exp2f(x * 1.4426950408889634f); }
__device__ __forceinline__ float fast_sigmoid(float x) { return __builtin_amdgcn_rcpf(1.0f + fast_exp(-x)); }
__device__ __forceinline__ float gelu_tanh_f(float y) { const float u = 0.7978845608028654f * (y + 0.044715f * y * y * y); return y * fast_sigmoid(2.0f * u); }

__device__ const unsigned char kBucket[128] = {
 0,1,2,3,4,5,6,7,8,9,10,11,12,13,14,15,
 16,16,16,17,17,18,18,18,19,19,19,20,20,20,20,21,21,21,21,22,22,22,22,22,
 23,23,23,23,23,23,24,24,24,24,24,24,25,25,25,25,25,25,25,26,26,26,26,26,
 26,26,26,27,27,27,27,27,27,27,27,27,27,28,28,28,28,28,28,28,28,28,28,29,
 29,29,29,29,29,29,29,29,29,29,29,30,30,30,30,30,30,30,30,30,30,30,30,30,
 30,31,31,31,31,31,31,31,31,31,31,31,31,31,31,31};

typedef long long i64;
constexpr float SS_SCALE = 16777216.0f, SS_INV = 1.0f / (16777216.0f * 2048.0f);
__device__ __forceinline__ float rstd_of(const i64 v) { return __builtin_amdgcn_rsqf((float)v * SS_INV + EPS); }
__device__ __forceinline__ int lane_id() { return (int)__builtin_amdgcn_mbcnt_hi(~0u, __builtin_amdgcn_mbcnt_lo(~0u, 0u)); }
#define XB_TMO      128
#define XB_XCNT(j)  (256  + 64 * (j))
#define XB_XSUB(j)  (1280 + 64 * (j))
#define XB_XGEN(j)  (2304 + 64 * (j))
#define XB_TOP      3328
#define XB_TOPGEN   3392
#define XCD_BAR_WORDS 3456
#define XB_SPIN_CAP (1u << 22)

__device__ __forceinline__ unsigned xb_ld(unsigned* p)              { return __hip_atomic_load(p, __ATOMIC_RELAXED, __HIP_MEMORY_SCOPE_AGENT); }
__device__ __forceinline__ unsigned xb_add(unsigned* p, unsigned v) { return __hip_atomic_fetch_add(p, v, __ATOMIC_RELAXED, __HIP_MEMORY_SCOPE_AGENT); }
__device__ __forceinline__ unsigned xb_xcc_id() { return (unsigned)__builtin_amdgcn_s_getreg((3 << 11) | 20) & 0xFu; }
#define XB_SPIN(cond, bar) do { unsigned _sp = 0; while (cond) { __builtin_amdgcn_s_sleep(1); \
    if ((++_sp & 255u) == 0u) { if (xb_ld(&(bar)[XB_TMO])) break; if (_sp > XB_SPIN_CAP) { atomicAdd(&(bar)[XB_TMO], 1u); break; } } } } while (0)

struct XcdBarrier { unsigned* bar; unsigned x; volatile LAS unsigned* st; int wave; };

__device__ __forceinline__ XcdBarrier xcd_barrier_post(unsigned* bar, volatile LAS unsigned* st, int wave) {
    XcdBarrier b; b.bar = bar; b.x = xb_xcc_id(); b.st = st; b.wave = wave;
    if (wave == 0 && lane_id() == 0) (void)xb_add(&bar[XB_XCNT(b.x)], 1u);
    return b;
}
__device__ __forceinline__ void xcd_barrier_complete(unsigned* bar, unsigned x, unsigned& nloc, unsigned& nx) {
    const unsigned G = gridDim.x * gridDim.y * gridDim.z;
    unsigned sum, cnt, mine, sp = 0u;
    for (;;) {
        sum = 0u; cnt = 0u; mine = 0u;
#pragma unroll
        for (unsigned j = 0; j < 16; ++j) { const unsigned c = xb_ld(&bar[XB_XCNT(j)]); sum += c; cnt += (c > 0u) ? 1u : 0u; mine = (j == x) ? c : mine; }
        if (sum == G) break;
        __builtin_amdgcn_s_sleep(1);
        if ((++sp & 255u) == 0u) { if (xb_ld(&bar[XB_TMO])) break; if (sp > XB_SPIN_CAP) { atomicAdd(&bar[XB_TMO], 1u); break; } }
    }
    nloc = mine > 0u ? mine : 1u; nx = cnt > 0u ? cnt : 1u;
}
__device__ __forceinline__ void xcd_barrier(const XcdBarrier& b) {
    asm volatile("s_waitcnt vmcnt(0)" ::: "memory");
    __syncthreads();
    int wv = b.wave; asm volatile("" : "+s"(wv));
    if (wv == 0 && lane_id() == 0) {
        unsigned* bar = b.bar; asm volatile("" : "+s"(bar));
        const unsigned bx = xb_xcc_id();
        __builtin_amdgcn_s_waitcnt(0);
        unsigned nloc = b.st[0], nx = b.st[1];
        if (nloc == 0u) { xcd_barrier_complete(bar, bx, nloc, nx); b.st[0] = nloc; b.st[1] = nx; }
        const unsigned old = xb_add(&bar[XB_XSUB(bx)], 1u);
        const unsigned gen = old / nloc;
        if (old + 1u == (gen + 1u) * nloc) {
            __builtin_amdgcn_fence(__ATOMIC_RELEASE, "agent");
            asm volatile("s_waitcnt vmcnt(0)" ::: "memory");
            const unsigned og = xb_add(&bar[XB_TOP], 1u);
            const unsigned tg = og / nx;
            if (og + 1u == (tg + 1u) * nx) xb_add(&bar[XB_TOPGEN], 1u);
            else XB_SPIN(xb_ld(&bar[XB_TOPGEN]) == tg, bar);
            __builtin_amdgcn_fence(__ATOMIC_ACQUIRE, "agent");
            xb_add(&bar[XB_XGEN(bx)], 1u);
            asm volatile("s_waitcnt vmcnt(0)" ::: "memory");
        } else {
            XB_SPIN(xb_ld(&bar[XB_XGEN(bx)]) == gen, bar);
            __builtin_amdgcn_fence(__ATOMIC_ACQUIRE, "agent");
            asm volatile("s_waitcnt vmcnt(0)" ::: "memory");
        }
    }
    __syncthreads();
}

namespace pg8 {
constexpr int BM = 256, BK = 64, HALF = 128, HTB = HALF * BK * 2, STAGE_BYTES = 8 * HTB, NXCD = 8, WGM = 8;
__host__ __device__ __forceinline__ int lds_byte(int r, int c) { const int st = (r >> 4) * 2 + (c >> 5), rr = r & 15, cc = c & 31, ob = rr * 64 + cc * 2; return st * 1024 + (ob ^ (((ob >> 9) & 1) << 5)); }
__host__ __device__ __forceinline__ void stage_rc(int b, int& R, int& C) { const int st = b / 1024, sb = b % 1024, swz = sb ^ (((sb >> 9) & 1) << 5); R = (st >> 1) * 16 + swz / 64; C = (st & 1) * 32 + (swz % 64) / 2; }
__host__ __device__ __forceinline__ int perm32(int rho) { const int n = rho >> 4, i = rho & 15; return 8 * (i >> 2) + 4 * n + (i & 3); }

struct Unit { const char* A; const char* B; char* C; const float* vec; int row0, col0, aux; };

__device__ __forceinline__ void tile_of(int wgid, int nM, int nN, int& pm, int& pn, const int WGM = 8) {
    const int nwg = nM * nN;
    { const int q = nwg / NXCD, r = nwg % NXCD, xcd = wgid % NXCD, off = wgid / NXCD; wgid = (xcd < r ? xcd * (q + 1) : r * (q + 1) + (xcd - r) * q) + off; }
    const int nig = WGM * nN, gid = wgid / nig, fm = gid * WGM, gsz = (nM - fm) < WGM ? (nM - fm) : WGM;
    pm = fm + ((wgid % nig) % gsz); pn = (wgid % nig) / gsz;
}

template <class Epi, class Sched, bool ALIGN_EPI>
__device__ __forceinline__ void gemm_phase(LAS unsigned char* lds, const int wave_, const int lda, const int ldb, const int K, const Sched& S, const Epi& E) {
    int lane_ = lane_id(); asm volatile("" : "+v"(lane_));
    int wv_ = wave_; asm volatile("" : "+s"(wv_));
    const int wid = wv_, lane = lane_, tid = wid * 64 + lane, wr = wid >> 2, wc = wid & 3, fr = lane & 15, fq = lane >> 4;
    const int nt = K / BK;
    unsigned voffA[2], voffB[2];
#pragma unroll
    for (int i = 0; i < 2; ++i) { int R, C; stage_rc(tid * 16 + i * 8192, R, C); const int Rb = (R & ~31) + perm32(R & 31);
        const int Ra = Epi::APERM ? ((R & ~63) + 4 * (R & 15) + ((R >> 4) & 3)) : R;
        voffA[i] = (unsigned)(Ra * lda + C) * 2u; voffB[i] = (unsigned)(Rb * ldb + C) * 2u; }
    const size_t kstep = (size_t)(BK * 2);
    const size_t hsA = (size_t)HALF * lda * 2, hsB = (size_t)HALF * ldb * 2;
    const unsigned ldsw = (unsigned)wid * 1024u;
    const int aoff = lds_byte(wr * 64 + fr, fq * 8), boff = lds_byte(wc * 32 + fr, fq * 8);
#define PG8_SA(b, h) (((b) * 2 + (h)) * HTB)
#define PG8_SB(b, h) ((4 + (b) * 2 + (h)) * HTB)
#define PG8_STAGE(bufoff, gbase, voff) do { _Pragma("unroll") for (int _i = 0; _i < 2; ++_i) \
        __builtin_amdgcn_global_load_lds((const unsigned*)((const char*)(gbase) + (voff)[_i]), (LAS unsigned*)(lds + (bufoff) + ldsw + _i * 8192), 16, 0, 0); } while (0)
#define PG8_LDA(dst, b, h) do { _Pragma("unroll") for (int m = 0; m < 4; ++m) _Pragma("unroll") for (int k = 0; k < 2; ++k) dst[m][k] = *(const LAS bf16x8*)(lds + PG8_SA(b, h) + aoff + m * 2048 + k * 1024); } while (0)
#define PG8_LDB(dst, b, h) do { _Pragma("unroll") for (int n = 0; n < 2; ++n) _Pragma("unroll") for (int k = 0; k < 2; ++k) dst[n][k] = *(const LAS bf16x8*)(lds + PG8_SB(b, h) + boff + n * 2048 + k * 1024); } while (0)
#define PG8_MMA(ai, bj, At, Bt) do { __builtin_amdgcn_s_setprio(1); _Pragma("unroll") for (int m = 0; m < 4; ++m) _Pragma("unroll") for (int n = 0; n < 2; ++n) _Pragma("unroll") for (int k = 0; k < 2; ++k) \
        acc[ai][bj][m][n] = __builtin_amdgcn_mfma_f32_16x16x32_bf16(Bt[n][k], At[m][k], acc[ai][bj][m][n], 0, 0, 0); __builtin_amdgcn_s_setprio(0); } while (0)
#define PG8_WAIT_V(n) asm volatile("s_waitcnt vmcnt(" #n ")" ::: "memory")
#define PG8_WAIT_L(n) asm volatile("s_waitcnt lgkmcnt(" #n ")" ::: "memory")
#define PG8_BAR __builtin_amdgcn_s_barrier()
#define PG8_SCHED __builtin_amdgcn_sched_barrier(0)
    Unit cur, nxt; int ui = 0;
    if (!S.next(0, cur)) return;
    f32x4 acc[2][2][4][2];
    if constexpr (Epi::PRELOAD) E.preload(acc, cur, wr, wc);
    else {
#pragma unroll
    for (int a = 0; a < 2; ++a)
#pragma unroll
        for (int b = 0; b < 2; ++b)
#pragma unroll
            for (int m = 0; m < 4; ++m)
#pragma unroll
                for (int n = 0; n < 2; ++n) acc[a][b][m][n] = (f32x4){0.f, 0.f, 0.f, 0.f};
    }
    bf16x8 At[4][2], B0[2][2], B1[2][2];
    const char* cA = cur.A; const char* cB = cur.B;
#ifndef GEMM_SP2
#define GEMM_SP2 1
#endif
    constexpr bool SP2 = GEMM_SP2;
    if constexpr (SP2) {
    PG8_STAGE(PG8_SB(0, 0), cB, voffB); PG8_STAGE(PG8_SB(0, 1), cB + hsB, voffB); PG8_STAGE(PG8_SA(0, 0), cA, voffA); PG8_STAGE(PG8_SA(0, 1), cA + hsA, voffA);
    if (wr == 1) PG8_BAR;
    PG8_WAIT_V(2); PG8_BAR;
    PG8_STAGE(PG8_SB(1, 0), cB + kstep, voffB); PG8_STAGE(PG8_SA(1, 0), cA + kstep, voffA); PG8_STAGE(PG8_SB(1, 1), cB + hsB + kstep, voffB);
    PG8_WAIT_V(6); PG8_BAR;
    } else {
    PG8_STAGE(PG8_SB(0, 0), cB, voffB); PG8_STAGE(PG8_SA(0, 0), cA, voffA); PG8_STAGE(PG8_SB(0, 1), cB + hsB, voffB); PG8_STAGE(PG8_SA(0, 1), cA + hsA, voffA);
    if (wr == 1) PG8_BAR;
    PG8_WAIT_V(4); PG8_BAR;
    PG8_STAGE(PG8_SB(1, 0), cB + kstep, voffB); PG8_STAGE(PG8_SA(1, 0), cA + kstep, voffA); PG8_STAGE(PG8_SB(1, 1), cB + hsB + kstep, voffB);
    PG8_WAIT_V(6); PG8_BAR;
    }
    for (;;) {
        const bool has_next = S.next(ui + 1, nxt);
        const char* nA = has_next ? nxt.A : cA; const char* nB = has_next ? nxt.B : cB;
#ifndef KLOOP_ALIGN
#define KLOOP_ALIGN 8
#endif
#define PG8_STR2(x) #x
#define PG8_STR(x) PG8_STR2(x)
        asm volatile(".p2align " PG8_STR(KLOOP_ALIGN));
        for (int t = 0; t < nt; t += 2) {
            const bool last = (t == nt - 2);
            const char* a1 = cA + (size_t)(t + 1) * kstep;
            const char* a2 = last ? nA : cA + (size_t)(t + 2) * kstep; const char* b2 = last ? nB : cB + (size_t)(t + 2) * kstep;
            const char* a3 = a2 + kstep; const char* b3 = b2 + kstep;
            if constexpr (SP2) {
            PG8_LDB(B0, 0, 0); PG8_LDB(B1, 0, 1); PG8_SCHED; PG8_LDA(At, 0, 0); PG8_STAGE(PG8_SA(1, 1), a1 + hsA, voffA);
            PG8_WAIT_V(8); PG8_WAIT_L(0); PG8_BAR; PG8_MMA(0, 0, At, B0); PG8_MMA(0, 1, At, B1); PG8_BAR; PG8_SCHED;
            PG8_LDA(At, 0, 1); PG8_STAGE(PG8_SB(0, 0), b2, voffB); PG8_STAGE(PG8_SB(0, 1), b2 + hsB, voffB); PG8_STAGE(PG8_SA(0, 0), a2, voffA);
            PG8_WAIT_V(8); PG8_WAIT_L(0); PG8_BAR; PG8_MMA(1, 0, At, B0); PG8_MMA(1, 1, At, B1); PG8_BAR; PG8_SCHED;
            PG8_LDB(B0, 1, 0); PG8_LDB(B1, 1, 1); PG8_SCHED; PG8_LDA(At, 1, 0); PG8_STAGE(PG8_SA(0, 1), a2 + hsA, voffA);
            PG8_WAIT_V(8); PG8_WAIT_L(0); PG8_BAR; PG8_MMA(0, 0, At, B0); PG8_MMA(0, 1, At, B1); PG8_BAR; PG8_SCHED;
            PG8_LDA(At, 1, 1); PG8_STAGE(PG8_SB(1, 0), b3, voffB); PG8_STAGE(PG8_SB(1, 1), b3 + hsB, voffB); PG8_STAGE(PG8_SA(1, 0), a3, voffA);
            PG8_WAIT_V(8); PG8_WAIT_L(0); PG8_BAR; PG8_MMA(1, 0, At, B0); PG8_MMA(1, 1, At, B1); PG8_BAR; PG8_SCHED;
            } else {
            PG8_LDB(B0, 0, 0); PG8_SCHED; PG8_LDA(At, 0, 0); PG8_STAGE(PG8_SA(1, 1), a1 + hsA, voffA);
            PG8_WAIT_L(8); PG8_BAR; PG8_WAIT_L(0); PG8_MMA(0, 0, At, B0); PG8_BAR; PG8_SCHED;
            PG8_LDB(B1, 0, 1); PG8_STAGE(PG8_SB(0, 0), b2, voffB);
            PG8_BAR; PG8_WAIT_L(0); PG8_MMA(0, 1, At, B1); PG8_BAR;
            PG8_LDA(At, 0, 1); PG8_STAGE(PG8_SA(0, 0), a2, voffA);
            PG8_BAR; PG8_WAIT_L(0); PG8_MMA(1, 0, At, B0); PG8_BAR; PG8_SCHED;
            PG8_STAGE(PG8_SB(0, 1), b2 + hsB, voffB);
            PG8_WAIT_V(6); PG8_BAR; PG8_MMA(1, 1, At, B1); PG8_BAR;
            PG8_LDB(B0, 1, 0); PG8_SCHED; PG8_LDA(At, 1, 0); PG8_STAGE(PG8_SA(0, 1), a2 + hsA, voffA);
            PG8_WAIT_L(8); PG8_BAR; PG8_WAIT_L(0); PG8_MMA(0, 0, At, B0); PG8_BAR; PG8_SCHED;
            PG8_LDB(B1, 1, 1); PG8_STAGE(PG8_SB(1, 0), b3, voffB);
            PG8_BAR; PG8_WAIT_L(0); PG8_MMA(0, 1, At, B1); PG8_BAR;
            PG8_LDA(At, 1, 1); PG8_STAGE(PG8_SA(1, 0), a3, voffA);
            PG8_BAR; PG8_WAIT_L(0); PG8_MMA(1, 0, At, B0); PG8_BAR; PG8_SCHED;
            PG8_STAGE(PG8_SB(1, 1), b3 + hsB, voffB);
            PG8_WAIT_V(6); PG8_BAR; PG8_MMA(1, 1, At, B1); PG8_BAR;
            }
        }
        if constexpr (ALIGN_EPI) { if (wr == 0) PG8_BAR; }
        if constexpr (Epi::FUSEDPRE) { Unit pu = cur; if (has_next) pu = nxt; E.epi_pre(acc, cur, pu, has_next, wr, wc); if (!has_next) break; }
        else {
        if constexpr (!Epi::AFTER_DRAIN) { E(acc, cur, wr, wc, fr, fq); }
        if (!has_next) break;
        }
        if constexpr (Epi::FUSEDPRE) {}
        else if constexpr (Epi::PRELOAD) E.preload(acc, nxt, wr, wc);
        else {
#pragma unroll
        for (int a = 0; a < 2; ++a)
#pragma unroll
            for (int b = 0; b < 2; ++b)
#pragma unroll
                for (int m = 0; m < 4; ++m)
#pragma unroll
                    for (int n = 0; n < 2; ++n) acc[a][b][m][n] = (f32x4){0.f, 0.f, 0.f, 0.f};
        }
        cur = nxt; cA = nA; cB = nB; ++ui;
        if constexpr (ALIGN_EPI) { if (wr == 1) PG8_BAR; }
    }
    PG8_WAIT_V(0);
    if constexpr (!ALIGN_EPI) { if (wr == 0) PG8_BAR; }
    PG8_BAR;
    if constexpr (Epi::AFTER_DRAIN) { E.fused(acc, cur, wr, wc, fr, fq, lds, wid, lane); }
#undef PG8_SA
#undef PG8_SB
#undef PG8_STAGE
#undef PG8_LDA
#undef PG8_LDB
#undef PG8_MMA
#undef PG8_WAIT_V
#undef PG8_WAIT_L
#undef PG8_BAR
#undef PG8_SCHED
}
}
#ifndef DEF_WGM
#define DEF_WGM 4
#endif
namespace pg8 {
struct SchedMain {
    const char* A; const char* B; char* C; size_t tA, tB, bB, tC, cC; int nM, nN, bdiv, ccols, G, c, wgm = DEF_WGM;
    __device__ __forceinline__ bool next(int i, Unit& u) const {
        const long Lx = (long)i * G + c; if (Lx >= (long)nM * nN) return false;
        int pm, pn; tile_of((int)Lx, nM, nN, pm, pn, wgm);
        u.A = A + (size_t)pm * tA; u.B = B + (size_t)pn * tB + (size_t)(pm / bdiv) * bB; u.C = C + (size_t)pm * tC + (size_t)pn * cC;
        u.row0 = pm * BM; u.col0 = pn * ccols; u.aux = i; u.vec = nullptr; return true;
    }
};

struct EpiRowScale {
    static constexpr bool AFTER_DRAIN = false, PRELOAD = false, APERM = false, FUSEDPRE = false;
    const i64* ss; const float* bias; int ldc;
    __device__ __forceinline__ void operator()(f32x4 (&acc)[2][2][4][2], const Unit& u, int wr, int wc, int fr_, int fq_) const {
        int lane_ = lane_id(); asm volatile("" : "+v"(lane_)); const int fr = lane_ & 15, fq = lane_ >> 4; (void)fr_; (void)fq_;
        const int colw = wc * 32 + 8 * fq; const unsigned loff = (unsigned)((wr * 64 + fr) * ldc + colw) * 2u; const unsigned soff = (unsigned)(wr * 64 + fr) * 8u;
        i64 sv[2][4];
#pragma unroll
        for (int ai = 0; ai < 2; ++ai)
#pragma unroll
            for (int m = 0; m < 4; ++m) sv[ai][m] = *(const i64*)((const char*)(ss + u.row0 + ai * HALF + m * 16) + soff);
        f32x4 bv[2][2];
#pragma unroll
        for (int bj = 0; bj < 2; ++bj)
#pragma unroll
            for (int n = 0; n < 2; ++n) bv[bj][n] = bias ? *(const f32x4*)(bias + u.col0 + colw + bj * HALF + 4 * n) : (f32x4){0.f, 0.f, 0.f, 0.f};
#pragma unroll
        for (int ai = 0; ai < 2; ++ai)
#pragma unroll
            for (int m = 0; m < 4; ++m) {
                const int rb = ai * HALF + m * 16;
                const float rs = rstd_of(sv[ai][m]);
                char* rowp = u.C + (size_t)rb * ldc * 2 + loff;
#pragma unroll
                for (int bj = 0; bj < 2; ++bj) {
                    const f32x4 v0 = acc[ai][bj][m][0] * rs + bv[bj][0], v1 = acc[ai][bj][m][1] * rs + bv[bj][1];
                    u32x4 w; w.x = cvt_pk_bf16(v0[0], v0[1]); w.y = cvt_pk_bf16(v0[2], v0[3]); w.z = cvt_pk_bf16(v1[0], v1[1]); w.w = cvt_pk_bf16(v1[2], v1[3]);
                    *(u32x4*)(rowp + bj * HALF * 2) = w;
                }
            }
    }
};

struct EpiPlain {
    static constexpr bool AFTER_DRAIN = false, PRELOAD = false, APERM = false, FUSEDPRE = false;
    __device__ __forceinline__ void operator()(f32x4 (&acc)[2][2][4][2], const Unit& u, int wr, int wc, int fr_, int fq_) const {
        int lane_ = lane_id(); asm volatile("" : "+v"(lane_)); const int fr = lane_ & 15, fq = lane_ >> 4; (void)fr_; (void)fq_;
        const int colw = wc * 32 + 8 * fq, ldc = u.aux; const float* cs = (const float*)u.vec; const unsigned loff = (unsigned)((wr * 64 + fr) * ldc + colw) * 2u;
        f32x4 sv[2][2];
#pragma unroll
        for (int bj = 0; bj < 2; ++bj)
#pragma unroll
            for (int n = 0; n < 2; ++n) sv[bj][n] = cs ? *(const f32x4*)(cs + u.col0 + colw + bj * HALF + 4 * n) : (f32x4){1.f, 1.f, 1.f, 1.f};
#pragma unroll
        for (int ai = 0; ai < 2; ++ai)
#pragma unroll
            for (int m = 0; m < 4; ++m) {
                char* rowp = u.C + (size_t)(ai * HALF + m * 16) * ldc * 2 + loff;
#pragma unroll
                for (int bj = 0; bj < 2; ++bj) {
                    const f32x4 v0 = acc[ai][bj][m][0] * sv[bj][0], v1 = acc[ai][bj][m][1] * sv[bj][1];
                    u32x4 w; w.x = cvt_pk_bf16(v0[0], v0[1]); w.y = cvt_pk_bf16(v0[2], v0[3]); w.z = cvt_pk_bf16(v1[0], v1[1]); w.w = cvt_pk_bf16(v1[2], v1[3]);
                    *(u32x4*)(rowp + bj * HALF * 2) = w;
                }
            }
    }
};

struct EpiRes {
    static constexpr bool AFTER_DRAIN = false, PRELOAD = true, APERM = false, FUSEDPRE = true;
    bf16_t* hb; bf16_t* hbo; i64* ssout; LAS unsigned char* lds_spare;
    __device__ __forceinline__ void preload(f32x4 (&acc)[2][2][4][2], const Unit& u, int wr, int wc) const {
        int lane_ = lane_id(); asm volatile("" : "+v"(lane_)); const int fr = lane_ & 15, fq = lane_ >> 4;
        const unsigned l2 = (unsigned)((wr * 64 + fr) * D + wc * 32 + 8 * fq) * 2u;
#pragma unroll
        for (int ai = 0; ai < 2; ++ai)
#pragma unroll
            for (int m = 0; m < 4; ++m) { const char* pin = (const char*)(hb + (size_t)(u.row0 + ai * HALF + m * 16) * D + u.col0) + l2;
#pragma unroll
                for (int bj = 0; bj < 2; ++bj) { const u32x4 w = *(const u32x4*)(pin + bj * HALF * 2);
                    acc[ai][bj][m][0] = (f32x4){bf_lo(w.x), bf_hi(w.x), bf_lo(w.y), bf_hi(w.y)}; acc[ai][bj][m][1] = (f32x4){bf_lo(w.z), bf_hi(w.z), bf_lo(w.w), bf_hi(w.w)}; } }
    }
    __device__ __forceinline__ void operator()(f32x4 (&)[2][2][4][2], const Unit&, int, int, int, int) const {}
    __device__ __forceinline__ void epi_pre(f32x4 (&acc)[2][2][4][2], const Unit& u, const Unit& nu, const bool has_next, int wr, int wc) const {
        int lane_ = lane_id(); asm volatile("" : "+v"(lane_)); const int fr = lane_ & 15, fq = lane_ >> 4;
        const unsigned l2 = (unsigned)((wr * 64 + fr) * D + wc * 32 + 8 * fq) * 2u;
        LAS float* T = (LAS float*)(lds_spare);
        u32x4 raw[2][4][2];
        if (has_next) {
#pragma unroll
        for (int ai = 0; ai < 2; ++ai)
#pragma unroll
            for (int m = 0; m < 4; ++m) { const char* pin = (const char*)(hb + (size_t)(nu.row0 + ai * HALF + m * 16) * D + nu.col0) + l2;
                asm volatile("global_load_dwordx4 %0, %2, off\n\tglobal_load_dwordx4 %1, %2, off offset:256" : "=&v"(raw[ai][m][0]), "=&v"(raw[ai][m][1]) : "v"(pin) : "memory"); }
        }
#pragma unroll
        for (int ai = 0; ai < 2; ++ai)
#pragma unroll
            for (int m = 0; m < 4; ++m) {
                char* pb = (char*)(hbo + (size_t)(u.row0 + ai * HALF + m * 16) * D + u.col0) + l2;
                float s = 0.f;
#pragma unroll
                for (int bj = 0; bj < 2; ++bj) {
                    const f32x4 o0 = acc[ai][bj][m][0], o1 = acc[ai][bj][m][1];
                    u32x4 w; w.x = cvt_pk_bf16(o0[0], o0[1]); w.y = cvt_pk_bf16(o0[2], o0[3]); w.z = cvt_pk_bf16(o1[0], o1[1]); w.w = cvt_pk_bf16(o1[2], o1[3]);
                    *(u32x4*)(pb + bj * HALF * 2) = w;
                    s += (o0[0] * o0[0] + o0[1] * o0[1]) + (o0[2] * o0[2] + o0[3] * o0[3]) + (o1[0] * o1[0] + o1[1] * o1[1]) + (o1[2] * o1[2] + o1[3] * o1[3]);
                }
                s += shx(s, 16, lane_); s += shx(s, 32, lane_);
                if (fq == 0) T[(ai * HALF + wr * 64 + m * 16 + fr) * 4 + wc] = s;
            }
        asm volatile("s_waitcnt lgkmcnt(0)" ::: "memory"); __builtin_amdgcn_s_barrier(); asm volatile("" ::: "memory");
        if (lane_ < 32) { const int row = (wr * 4 + wc) * 32 + lane_; const f32x4 p = *(const LAS f32x4*)(T + row * 4);
            __hip_atomic_fetch_add(ssout + u.row0 + row, (i64)(((p[0] + p[1]) + (p[2] + p[3])) * SS_SCALE), __ATOMIC_RELAXED, __HIP_MEMORY_SCOPE_AGENT); }
        if (!has_next) return;
        asm volatile("s_waitcnt vmcnt(16)" : "+v"(raw[0][0][0]), "+v"(raw[0][0][1]), "+v"(raw[0][1][0]), "+v"(raw[0][1][1]), "+v"(raw[0][2][0]), "+v"(raw[0][2][1]), "+v"(raw[0][3][0]), "+v"(raw[0][3][1]),
                                           "+v"(raw[1][0][0]), "+v"(raw[1][0][1]), "+v"(raw[1][1][0]), "+v"(raw[1][1][1]), "+v"(raw[1][2][0]), "+v"(raw[1][2][1]), "+v"(raw[1][3][0]), "+v"(raw[1][3][1]) :: "memory");
#pragma unroll
        for (int ai = 0; ai < 2; ++ai)
#pragma unroll
            for (int m = 0; m < 4; ++m)
#pragma unroll
                for (int bj = 0; bj < 2; ++bj) { const u32x4 w = raw[ai][m][bj];
                    acc[ai][bj][m][0] = (f32x4){bf_lo(w.x), bf_hi(w.x), bf_lo(w.y), bf_hi(w.y)}; acc[ai][bj][m][1] = (f32x4){bf_lo(w.z), bf_hi(w.z), bf_lo(w.w), bf_hi(w.w)}; }
    }
};

struct EpiSoftmax {
    static constexpr bool AFTER_DRAIN = true, PRELOAD = false, APERM = false, FUSEDPRE = false;
    const i64* ss; int ldc;
    __device__ __forceinline__ void operator()(f32x4 (&)[2][2][4][2], const Unit&, int, int, int, int) const {}
    __device__ __forceinline__ void fused(f32x4 (&acc)[2][2][4][2], const Unit& u, int wr, int wc, int fr_, int fq_, LAS unsigned char* lds, int wid, int lane) const {
        int lane_ = lane_id(); asm volatile("" : "+v"(lane_)); const int fr = lane_ & 15, fq = lane_ >> 4; (void)fr_; (void)fq_;
        LAS f32x2* T = (LAS f32x2*)lds;
        const unsigned loff = (unsigned)((wr * 64 + fr) * ldc + wc * 32 + 8 * fq) * 2u, soff = (unsigned)(wr * 64 + fr) * 8u;
        float mown[2][4]; i64 sv[2][4];
#pragma unroll
        for (int ai = 0; ai < 2; ++ai)
#pragma unroll
            for (int m = 0; m < 4; ++m) sv[ai][m] = *(const i64*)((const char*)(ss + u.row0 + ai * HALF + m * 16) + soff);
#pragma unroll
        for (int ai = 0; ai < 2; ++ai)
#pragma unroll
            for (int m = 0; m < 4; ++m) {
                const int r = ai * HALF + wr * 64 + m * 16 + fr;
                const float rs = rstd_of(sv[ai][m]);
                float mx = -3.0e38f;
#pragma unroll
                for (int bj = 0; bj < 2; ++bj)
#pragma unroll
                    for (int n = 0; n < 2; ++n) { f32x4 v = acc[ai][bj][m][n] * rs; acc[ai][bj][m][n] = v; mx = fmaxf(fmaxf(mx, fmaxf(v[0], v[1])), fmaxf(v[2], v[3])); }
                mx = fmaxf(mx, shx(mx, 16, lane_)); mx = fmaxf(mx, shx(mx, 32, lane_));
                float l = 0.f;
#pragma unroll
                for (int bj = 0; bj < 2; ++bj)
#pragma unroll
                    for (int n = 0; n < 2; ++n) { f32x4 v = acc[ai][bj][m][n]; v[0] = fast_exp(v[0] - mx); v[1] = fast_exp(v[1] - mx); v[2] = fast_exp(v[2] - mx); v[3] = fast_exp(v[3] - mx); acc[ai][bj][m][n] = v; l += (v[0] + v[1]) + (v[2] + v[3]); }
                l += shx(l, 16, lane_); l += shx(l, 32, lane_);
                mown[ai][m] = mx;
                if (fq == 0) T[r * 4 + wc] = (f32x2){mx, l};
            }
        asm volatile("s_waitcnt lgkmcnt(0)" ::: "memory"); __builtin_amdgcn_s_barrier(); asm volatile("" ::: "memory");
#pragma unroll
        for (int ai = 0; ai < 2; ++ai)
#pragma unroll
            for (int m = 0; m < 4; ++m) {
                const int r = ai * HALF + wr * 64 + m * 16 + fr;
                const f32x2 a = T[r * 4 + 0], b = T[r * 4 + 1], c = T[r * 4 + 2], d = T[r * 4 + 3];
                const float Mx = fmaxf(fmaxf(a.x, b.x), fmaxf(c.x, d.x));
                const float Ls = a.y * fast_exp(a.x - Mx) + b.y * fast_exp(b.x - Mx) + c.y * fast_exp(c.x - Mx) + d.y * fast_exp(d.x - Mx);
                const float f = fast_exp(mown[ai][m] - Mx) * __builtin_amdgcn_rcpf(Ls);
                char* rowp = u.C + (size_t)(ai * HALF + m * 16) * ldc * 2 + loff;
#pragma unroll
                for (int bj = 0; bj < 2; ++bj) {
                    const f32x4 v0 = acc[ai][bj][m][0] * f, v1 = acc[ai][bj][m][1] * f;
                    u32x4 w; w.x = cvt_pk_bf16(v0[0], v0[1]); w.y = cvt_pk_bf16(v0[2], v0[3]); w.z = cvt_pk_bf16(v1[0], v1[1]); w.w = cvt_pk_bf16(v1[2], v1[3]);
                    *(u32x4*)(rowp + bj * HALF * 2) = w;
                }
            }
    }
};

__device__ __forceinline__ float dpp_shr1z(float x) { return __builtin_bit_cast(float, __builtin_amdgcn_update_dpp(0, __builtin_bit_cast(int, x), 0x111  , 0xf, 0xf, true)); }
struct EpiMLP {
    static constexpr bool AFTER_DRAIN = false, PRELOAD = false, APERM = true, FUSEDPRE = false;
    LAS unsigned char* lds; float* halo_g; float* halo_u;
    __device__ __forceinline__ void operator()(f32x4 (&acc)[2][2][4][2], const Unit& u, int wr, int wc, int fr_, int fq_) const {
        int lane_ = lane_id(); asm volatile("" : "+v"(lane_)); const int fr = lane_ & 15, fq = lane_ >> 4; (void)fr_; (void)fq_;
        const int colw = wc * 32 + 8 * fq, ch0 = u.col0 + colw;
        const unsigned loff = (unsigned)((wr * 64 + 4 * fr) * DFF + colw) * 2u;
        const float LN2 = 0.6931471805599453f;
        const LAS float* cwt = (const LAS float*)(lds + F1_CWT_OFF) + u.aux * 512 + colw;
        const int slot = *(const LAS int*)(lds + F1_SLOT_OFF + u.aux * 4);
        const LAS float* rst = (const LAS float*)(lds + F1_RST_OFF) + slot * 256 + wr * 64 + 4 * fr;
        f32x4 w0[2], w1[2], w2[2], bb[2];
#pragma unroll
        for (int n = 0; n < 2; ++n) { w0[n] = *(const LAS f32x4*)(cwt + 4 * n); w1[n] = *(const LAS f32x4*)(cwt + 128 + 4 * n); w2[n] = *(const LAS f32x4*)(cwt + 256 + 4 * n); bb[n] = *(const LAS f32x4*)(cwt + 384 + 4 * n); }
#pragma unroll
        for (int ai = 0; ai < 2; ++ai) {
            const int rb = u.row0 + ai * HALF + wr * 64, blk = rb >> 6;
            const f32x4 rsv = *(const LAS f32x4*)(rst + ai * HALF);
            float rs[4], irsu[4];
#pragma unroll
            for (int m = 0; m < 4; ++m) { rs[m] = rsv[m]; irsu[m] = __builtin_amdgcn_rcpf(rs[m] * LN2); }
#pragma unroll
            for (int n = 0; n < 2; ++n) {
                f32x4 g[4];
#pragma unroll
                for (int m = 0; m < 4; ++m) g[m] = acc[ai][0][m][n] * rs[m];
                if (fr == 15) { *(f32x4*)(halo_g + ((size_t)blk * 4 + 0) * DFF + ch0 + 4 * n) = g[2]; *(f32x4*)(halo_g + ((size_t)blk * 4 + 1) * DFF + ch0 + 4 * n) = g[3]; }
                if (fr == 0) { *(f32x4*)(halo_g + ((size_t)blk * 4 + 2) * DFF + ch0 + 4 * n) = g[0]; *(f32x4*)(halo_g + ((size_t)blk * 4 + 3) * DFF + ch0 + 4 * n) = g[1];
                               *(f32x4*)(halo_u + ((size_t)blk * 2 + 0) * DFF + ch0 + 4 * n) = acc[ai][1][0][n] * rs[0]; *(f32x4*)(halo_u + ((size_t)blk * 2 + 1) * DFF + ch0 + 4 * n) = acc[ai][1][1][n] * rs[1]; }
                f32x4 pre[4];
#pragma unroll
                for (int j = 0; j < 4; ++j) {
                    const float s3 = dpp_shr1z(g[3][j]), s2 = dpp_shr1z(g[2][j]);
                    pre[0][j] = __builtin_fmaf(w2[n][j], g[0][j], __builtin_fmaf(w1[n][j], s3, __builtin_fmaf(w0[n][j], s2, bb[n][j])));
                    pre[1][j] = __builtin_fmaf(w2[n][j], g[1][j], __builtin_fmaf(w1[n][j], g[0][j], __builtin_fmaf(w0[n][j], s3, bb[n][j])));
                    pre[2][j] = __builtin_fmaf(w2[n][j], g[2][j], __builtin_fmaf(w1[n][j], g[1][j], __builtin_fmaf(w0[n][j], g[0][j], bb[n][j])));
                    pre[3][j] = __builtin_fmaf(w2[n][j], g[3][j], __builtin_fmaf(w1[n][j], g[2][j], __builtin_fmaf(w0[n][j], g[1][j], bb[n][j])));
                }
#pragma unroll
                for (int m = 0; m < 4; ++m) {
                    f32x4 a;
#pragma unroll
                    for (int j = 0; j < 4; ++j) { const float p = pre[m][j]; a[j] = (p * acc[ai][1][m][n][j]) * __builtin_amdgcn_rcpf(__builtin_fmaf(__builtin_amdgcn_exp2f(-p), irsu[m], irsu[m])); }
                    acc[ai][0][m][n] = a;
                }
            }
#pragma unroll
            for (int m = 0; m < 4; ++m) {
                const f32x4 v0 = acc[ai][0][m][0], v1 = acc[ai][0][m][1];
                u32x4 w; w.x = cvt_pk_bf16(v0[0], v0[1]); w.y = cvt_pk_bf16(v0[2], v0[3]); w.z = cvt_pk_bf16(v1[0], v1[1]); w.w = cvt_pk_bf16(v1[2], v1[3]);
                *(u32x4*)(u.C + (size_t)(ai * HALF + m) * DFF * 2 + loff) = w;
            }
        }
    }
};
struct EpiEven {
    static constexpr bool AFTER_DRAIN = false, PRELOAD = false, APERM = true, FUSEDPRE = false;
    const i64* ss; const float* cw; bf16_t* YY; bf16_t* UB; float* HV; float* HGB;
    __device__ __forceinline__ void operator()(f32x4 (&acc)[2][2][4][2], const Unit& u, int wr, int wc, int fr_, int fq_) const {
        int lane_ = lane_id(); asm volatile("" : "+v"(lane_)); const int fr = lane_ & 15, fq = lane_ >> 4; (void)fr_; (void)fq_;
        const int ch = u.col0 + 16 * wc + 4 * fq, g = (u.col0 >> 4) + wc;
        const unsigned soff = (unsigned)(wr * 64 + 4 * fr) * 8u;
        i64 sv[2][4];
#pragma unroll
        for (int ai = 0; ai < 2; ++ai)
#pragma unroll
            for (int m = 0; m < 4; ++m) sv[ai][m] = *(const i64*)((const char*)(ss + u.row0 + ai * HALF + m) + soff);
        const f32x4 w0 = *(const f32x4*)(cw + ch), w1 = *(const f32x4*)(cw + AW + ch), w2 = *(const f32x4*)(cw + 2 * AW + ch);
#pragma unroll
        for (int ai = 0; ai < 2; ++ai) {
            const int rb = u.row0 + ai * HALF + wr * 64, blk = rb >> 6;
            f32x4 gb[4], v[4], y[4];
#pragma unroll
            for (int m = 0; m < 4; ++m) { const float rs = rstd_of(sv[ai][m]); gb[m] = acc[ai][0][m][0] * rs; v[m] = (acc[ai][0][m][1] * rs) * (acc[ai][1][m][0] * rs); acc[ai][1][m][1] = acc[ai][1][m][1] * rs; }
            if (fr == 15) { *(f32x4*)(HV + ((size_t)blk * 4 + 0) * AW + ch) = v[2]; *(f32x4*)(HV + ((size_t)blk * 4 + 1) * AW + ch) = v[3]; }
            if (fr == 0) { *(f32x4*)(HV + ((size_t)blk * 4 + 2) * AW + ch) = v[0]; *(f32x4*)(HV + ((size_t)blk * 4 + 3) * AW + ch) = v[1];
                           *(f32x4*)(HGB + ((size_t)blk * 2 + 0) * AW + ch) = gb[0]; *(f32x4*)(HGB + ((size_t)blk * 2 + 1) * AW + ch) = gb[1]; }
#pragma unroll
            for (int j = 0; j < 4; ++j) {
                const float s3 = dpp_shr1z(v[3][j]), s2 = dpp_shr1z(v[2][j]);
                y[0][j] = w2[j] * v[0][j] + w1[j] * s3 + w0[j] * s2;
                y[1][j] = w2[j] * v[1][j] + w1[j] * v[0][j] + w0[j] * s3;
                y[2][j] = w2[j] * v[2][j] + w1[j] * v[1][j] + w0[j] * v[0][j];
                y[3][j] = w2[j] * v[3][j] + w1[j] * v[2][j] + w0[j] * v[1][j];
            }
#pragma unroll
            for (int m = 0; m < 4; ++m) {
                const size_t row = (size_t)(rb + 4 * fr + m);
                const f32x4 a = gb[m] * y[m], uu = acc[ai][1][m][1];
                u32x2 wa; wa.x = cvt_pk_bf16(a[0], a[1]); wa.y = cvt_pk_bf16(a[2], a[3]);
                u32x2 wu; wu.x = cvt_pk_bf16(uu[0], uu[1]); wu.y = cvt_pk_bf16(uu[2], uu[3]);
                *(u32x2*)(YY + row * D + ch) = wa;
                *(u32x2*)(UB + ((size_t)g * M + row) * 16 + 4 * fq) = wu;
            }
        }
    }
};
struct EpiNull { static constexpr bool AFTER_DRAIN = false, PRELOAD = false, APERM = false, FUSEDPRE = false;
    __device__ __forceinline__ void operator()(f32x4 (&acc)[2][2][4][2], const Unit& u, int, int, int fr, int) const {
        f32x4 s = (f32x4){0.f, 0.f, 0.f, 0.f};
#pragma unroll
        for (int a = 0; a < 2; ++a)
#pragma unroll
            for (int b = 0; b < 2; ++b)
#pragma unroll
                for (int m = 0; m < 4; ++m)
#pragma unroll
                    for (int n = 0; n < 2; ++n) s += acc[a][b][m][n];
        if (s[0] + s[1] + s[2] + s[3] == 1.2345e-30f && fr == 7) *(float*)u.C = 0.f; } };
}
struct Args { const float* in[32]; float* out; unsigned char* ws; };

struct Frame {
    LAS unsigned char* lds;
    int wave, G, bid;
    int gw, ngw;
    int ngt;
};
#define PHASE_TID(F, tid, lane, gt) int lane = lane_id(); asm volatile("" : "+v"(lane)); const int tid = (F).wave * 64 + lane; const int gt = (F).bid * NTHR + tid; (void)tid; (void)gt


struct MatDesc { const float* W; const float* gk; bf16_t* WT; int K, N, rs, roff, nsplit; float nsc; int transpose, rmode; };
__device__ __forceinline__ int even_row(int ng) { const int part = ng >> 10, ch = ng & 1023, pn = ch >> 6, r = ch & 63; return 256 * pn + 128 * (part >> 1) + 32 * (r >> 4) + 8 * ((r >> 2) & 3) + 4 * (part & 1) + (r & 3); }
__device__ __forceinline__ void tr_load(const MatDesc& d, int item, int lane, f32x4 (&v)[16], float (&gs)[16]) {
    const int nblk = d.N / 64, kb = item / nblk, nb = item % nblk, k0 = 64 * kb, n0 = 64 * nb;
    const unsigned voff = (unsigned)((lane >> 4) * d.N + (lane & 15) * 4) * 4u;
    const char* sbase = (const char*)(d.W + (size_t)k0 * d.N + n0);
#pragma unroll
    for (int i = 0; i < 16; ++i) v[i] = __builtin_nontemporal_load((const f32x4*)(sbase + (size_t)(4 * i) * d.N * 4 + voff));
    if (d.gk) {
#pragma unroll
        for (int i = 0; i < 16; ++i) gs[i] = d.gk[k0 + 4 * i + (lane >> 4)];
    } else {
#pragma unroll
        for (int i = 0; i < 16; ++i) gs[i] = 1.0f;
    }
}
__device__ __forceinline__ void tr_store(const MatDesc& d, LAS float* scr, int item, int lane, const f32x4 (&v)[16], const float (&gs)[16]) {
    const int nblk = d.N / 64, kb = item / nblk, nb = item % nblk, k0 = 64 * kb, n0 = 64 * nb;
    LAS float* wp = scr + (lane >> 4) * 65 + (lane & 15) * 4;
#pragma unroll
    for (int i = 0; i < 16; ++i) { const f32x4 x = v[i] * gs[i];
        wp[(4 * i) * 65 + 0] = x[0]; wp[(4 * i) * 65 + 1] = x[1]; wp[(4 * i) * 65 + 2] = x[2]; wp[(4 * i) * 65 + 3] = x[3]; }
    LDS_WAIT(); asm volatile("" ::: "memory");
    const int c = lane & 7;
#pragma unroll
    for (int j = 0; j < 8; ++j) { const int n = (lane >> 3) + 8 * j, ng = n0 + n; const LAS float* s = scr + (8 * c) * 65 + n;
        const float sc = (ng < d.nsplit) ? d.nsc : 1.0f;
        u32x4 o; o.x = cvt_pk_bf16(s[0 * 65] * sc, s[1 * 65] * sc); o.y = cvt_pk_bf16(s[2 * 65] * sc, s[3 * 65] * sc); o.z = cvt_pk_bf16(s[4 * 65] * sc, s[5 * 65] * sc); o.w = cvt_pk_bf16(s[6 * 65] * sc, s[7 * 65] * sc);
        const int drow = d.rmode ? even_row(ng) : (ng / 128) * d.rs + d.roff + (ng % 128);
#ifndef TR_NT_STORE
#define TR_NT_STORE 0
#endif
        if (TR_NT_STORE) __builtin_nontemporal_store(o, (u32x4*)(d.WT + (size_t)drow * d.K + k0 + 8 * c)); else *(u32x4*)(d.WT + (size_t)drow * d.K + k0 + 8 * c) = o; }
    LDS_WAIT(); asm volatile("" ::: "memory");
}
__device__ __forceinline__ void get_mat(const Args& a, int id, MatDesc& d) {
    unsigned char* ws = a.ws;
    d.gk = nullptr; d.rs = 128; d.roff = 0; d.nsplit = 0; d.nsc = 1.f; d.transpose = 1; d.rmode = 0; d.K = D; d.N = D;
    if (id < 2)       { const int i = id;      d.W = a.in[8] + (size_t)i * D * EVEN_IN; d.N = EVEN_IN; d.rmode = 1; d.gk = a.in[2] + (2 * i) * D; d.WT = (bf16_t*)(ws + WS_WIN_T) + (size_t)i * EVEN_IN * D; }
    else if (id < 4)  { const int i = id - 2;  d.W = a.in[19] + (size_t)i * D * D; d.WT = (bf16_t*)(ws + WS_EWOUT_T) + (size_t)i * D * D; }
    else if (id < 6)  { const int i = id - 4;  d.W = a.in[20] + (size_t)i * D * ODD_IN; d.N = ODD_IN; d.gk = a.in[2] + (2 * i + 1) * D; d.nsplit = NQH * HD; d.nsc = 0.125f; d.WT = (bf16_t*)(ws + WS_WQKV_T) + (size_t)i * ODD_IN * D; }
    else if (id < 8)  { const int i = id - 6;  d.W = a.in[23] + (size_t)i * D * D; d.WT = (bf16_t*)(ws + WS_OWOUT_T) + (size_t)i * D * D; }
    else if (id < 12) { const int l = id - 8;  d.W = a.in[25] + (size_t)l * D * 2 * D; d.N = 2 * D; d.WT = (bf16_t*)(ws + WS_WKV_T) + (size_t)l * 2 * D * D; }
    else if (id < 16) { const int l = id - 12; d.W = a.in[26] + (size_t)l * D * D; d.WT = (bf16_t*)(ws + WS_WO_T) + (size_t)l * D * D; }
    else if (id < 20) { const int l = id - 16; d.W = a.in[27] + (size_t)l * D * DFF; d.N = DFF; d.gk = a.in[4] + l * D; d.rs = 256; d.WT = (bf16_t*)(ws + WS_WGU_T) + (size_t)l * NGU * D; }
    else if (id < 24) { const int l = id - 20; d.W = a.in[28] + (size_t)l * D * DFF; d.N = DFF; d.gk = a.in[4] + l * D; d.rs = 256; d.roff = 128; d.WT = (bf16_t*)(ws + WS_WGU_T) + (size_t)l * NGU * D; }
    else if (id < 28) { const int l = id - 24; d.W = a.in[31] + (size_t)l * DFF * D; d.K = DFF; d.WT = (bf16_t*)(ws + WS_WDOWN_T) + (size_t)l * D * DFF; }
    else              { const int l = id - 28; d.W = a.in[24] + (size_t)l * D * D; d.transpose = 0; d.WT = (bf16_t*)(ws + WS_WQ_BF) + (size_t)l * D * D; }
}

__device__ __forceinline__ void p0_prologue(const Args& a, Frame& F) {
    unsigned char* ws = a.ws;
    PHASE_TID(F, tid, lane, gt);
    LAS float* scr = (LAS float*)(F.lds + F.wave * 16640);
    if (F.wave == 7) { float* sp = (float*)(ws + WS_S5P);
      for (int i = F.bid + F.G * lane; i < 2 * 64 * 64; i += F.G * 64) {
          const int g = (i >> 6) & 63, li_ = i >> 12;
          const double lr = a.in[10][i], li = a.in[11][i], dt = exp((double)a.in[12][li_ * 64 + g]);
          const double er = exp(lr * dt), abr = er * cos(li * dt), abi = er * sin(li * dt);
          const double xr_ = abr - 1.0, xi_ = abi, den = lr * lr + li * li;
          const double fr = (xr_ * lr + xi_ * li) / den, fi = (xi_ * lr - xr_ * li) / den;
          float* o = sp + (size_t)i * 34; o[0] = (float)abr; o[1] = (float)abi;
          for (int h = 0; h < 16; ++h) { const double br = a.in[13][(size_t)i * 16 + h], bi = a.in[14][(size_t)i * 16 + h]; o[2 + h] = (float)(fr * br - fi * bi); o[18 + h] = (float)(fr * bi + fi * br); } } }
    { int id = 0, base = 0; MatDesc d; get_mat(a, 0, d); int nit = (d.K / 64) * (d.N / 64);
      constexpr int TOTAL = 2 * (32 * 64 + 32 * 32 + 32 * 40 + 32 * 32) + 4 * (32 * 64 + 32 * 32 + 3 * 32 * 88);
      MatDesc dn = d; int idn = 0, basen = 0, nitn = nit;
      f32x4 vc[16], vn[16]; float gc[16], gn[16];
      int gi = F.gw;
      if (gi < TOTAL) {
          while (gi >= basen + nitn) { basen += nitn; ++idn; get_mat(a, idn, dn); nitn = (dn.K / 64) * (dn.N / 64); }
          d = dn; base = basen;
          tr_load(d, gi - base, lane, vc, gc);
          for (;;) {
              const int gnx = gi + F.ngw; const bool has_next = gnx < TOTAL;
              if (has_next) { while (gnx >= basen + nitn) { basen += nitn; ++idn; get_mat(a, idn, dn); nitn = (dn.K / 64) * (dn.N / 64); }
                              tr_load(dn, gnx - basen, lane, vn, gn); }
              tr_store(d, scr, gi - base, lane, vc, gc);
              if (!has_next) break;
#pragma unroll
              for (int i = 0; i < 16; ++i) { vc[i] = vn[i]; gc[i] = gn[i]; }
              d = dn; base = basen; gi = gnx;
          }
      } }
#if defined(PROBE_TR) && PROBE_TR
    { int id = 0, base = 0; MatDesc d; get_mat(a, 0, d); int nit = (d.K / 64) * (d.N / 64);
      constexpr int TOTAL = 2 * (32 * 64 + 32 * 32 + 32 * 40 + 32 * 32) + 4 * (32 * 64 + 32 * 32 + 3 * 32 * 88);
      f32x4 accp = (f32x4){0.f, 0.f, 0.f, 0.f};
      for (int gi = F.gw; gi < TOTAL; gi += F.ngw) {
          while (gi >= base + nit) { base += nit; ++id; get_mat(a, id, d); nit = (d.K / 64) * (d.N / 64); }
          f32x4 va[16]; float gs[16]; tr_load(d, gi - base, lane, va, gs);
          if (PROBE_TR == 1) {
#pragma unroll
              for (int i = 0; i < 16; ++i) accp += va[i] * gs[i];
          } else {
              const int item = gi - base, nblk = d.N / 64, kb = item / nblk, nb = item % nblk, k0 = 64 * kb, n0 = 64 * nb, c = lane & 7;
#pragma unroll
              for (int j = 0; j < 8; ++j) { const int n = (lane >> 3) + 8 * j, ng = n0 + n; const int drow = (ng / 128) * d.rs + d.roff + (ng % 128);
                  u32x4 o; o.x = (unsigned)gi; o.y = o.z = o.w = 0u;
                  *(u32x4*)((bf16_t*)(ws + WS_END) + ((size_t)(d.WT - (bf16_t*)(ws + WS_WIN_T)) % (32u << 20)) + (size_t)drow * d.K + k0 + 8 * c) = o; }
          } }
      if (accp[0] + accp[1] + accp[2] + accp[3] == 1.2345e-30f) *(float*)(ws + WS_END) = 0.f; }
#endif
    for (int id = 28; id < 32; ++id) {
        MatDesc d; get_mat(a, id, d);
        const size_t n8 = (size_t)d.K * d.N / 8;
        for (size_t i = gt; i < n8; i += F.ngt) { const f32x4 x0 = *(const f32x4*)(d.W + i * 8), x1 = *(const f32x4*)(d.W + i * 8 + 4);
            u32x4 o; o.x = cvt_pk_bf16(x0[0], x0[1]); o.y = cvt_pk_bf16(x0[2], x0[3]); o.z = cvt_pk_bf16(x1[0], x1[1]); o.w = cvt_pk_bf16(x1[2], x1[3]); *(u32x4*)(d.WT + i * 8) = o; }
    }
    { u32x4* z = (u32x4*)(ws + WS_SS + (size_t)M * 8); for (int i = gt; i < 13 * M * 8 / 16; i += F.ngt) z[i] = (u32x4){0u, 0u, 0u, 0u}; }
    { const float* x = a.in[0]; bf16_t* HB = (bf16_t*)(ws + WS_HB); i64* ss0 = (i64*)(ws + WS_SS);
      for (int row = F.gw; row < M; row += F.ngw) {
          const f32x4* xr = (const f32x4*)(x + (size_t)row * D); float s = 0.f;
#pragma unroll
          for (int j = 0; j < 4; ++j) { const f32x4 v0 = xr[(j * 64 + lane) * 2], v1 = xr[(j * 64 + lane) * 2 + 1];
              s += (v0[0] * v0[0] + v0[1] * v0[1]) + (v0[2] * v0[2] + v0[3] * v0[3]) + (v1[0] * v1[0] + v1[1] * v1[1]) + (v1[2] * v1[2] + v1[3] * v1[3]);
              u32x4 o; o.x = cvt_pk_bf16(v0[0], v0[1]); o.y = cvt_pk_bf16(v0[2], v0[3]); o.z = cvt_pk_bf16(v1[0], v1[1]); o.w = cvt_pk_bf16(v1[2], v1[3]);
              *(u32x4*)(HB + (size_t)row * D + (j * 64 + lane) * 8) = o; }
          s = wave_sum(s, lane); if (lane == 0) ss0[row] = (i64)(s * SS_SCALE); } }
    { const float* mem = a.in[1]; const float* gm = a.in[6]; bf16_t* MN = (bf16_t*)(ws + WS_MEMN);
      for (int row = F.gw; row < MROWS; row += F.ngw) {
          const f32x4* xr = (const f32x4*)(mem + (size_t)row * D); f32x4 v[8]; float s = 0.f;
#pragma unroll
          for (int j = 0; j < 4; ++j) { v[2 * j] = xr[(j * 64 + lane) * 2]; v[2 * j + 1] = xr[(j * 64 + lane) * 2 + 1];
              const f32x4 v0 = v[2 * j], v1 = v[2 * j + 1]; s += (v0[0] * v0[0] + v0[1] * v0[1]) + (v0[2] * v0[2] + v0[3] * v0[3]) + (v1[0] * v1[0] + v1[1] * v1[1]) + (v1[2] * v1[2] + v1[3] * v1[3]); }
          s = wave_sum(s, lane); const float r = 1.0f / sqrtf(s * (1.0f / D) + EPS);
#pragma unroll
          for (int j = 0; j < 4; ++j) { const f32x4 g0 = *(const f32x4*)(gm + (j * 64 + lane) * 8), g1 = *(const f32x4*)(gm + (j * 64 + lane) * 8 + 4);
              const f32x4 v0 = v[2 * j] * r * g0, v1 = v[2 * j + 1] * r * g1;
              u32x4 o; o.x = cvt_pk_bf16(v0[0], v0[1]); o.y = cvt_pk_bf16(v0[2], v0[3]); o.z = cvt_pk_bf16(v1[0], v1[1]); o.w = cvt_pk_bf16(v1[2], v1[3]);
              *(u32x4*)(MN + (size_t)row * D + (j * 64 + lane) * 8) = o; } } }
    { float* qb = (float*)(ws + WS_QKVB); const float* b = a.in[21];
      for (int i = gt; i < 2 * ODD_IN; i += F.ngt) qb[i] = b[i] * (((i % ODD_IN) < NQH * HD) ? 0.125f : 1.0f); }
    { float* gxs = (float*)(ws + WS_GXS); const float* gx = a.in[3];
      for (int i = gt; i < 4 * D; i += F.ngt) gxs[i] = gx[i] * 0.044194173824159216f; }
}

__device__ __forceinline__ void unpack8(const u32x4 w, float (&f)[8]) { f[0] = bf_lo(w.x); f[1] = bf_hi(w.x); f[2] = bf_lo(w.y); f[3] = bf_hi(w.y); f[4] = bf_lo(w.z); f[5] = bf_hi(w.z); f[6] = bf_lo(w.w); f[7] = bf_hi(w.w); }
__device__ __forceinline__ void phase_convgate(const bf16_t* Z, const float* cw, bf16_t* YY, Frame& F) {
    PHASE_TID(F, tid, lane, gt);
    for (int idx = gt; idx < M * (AW / 8); idx += F.ngt) {
        const int row = idx >> 7, c8 = (idx & 127) * 8, t = row & (L - 1);
        const bf16_t* zr = Z + (size_t)row * EVEN_IN + c8;
        float gb[8], a0[8], b0[8], a1[8], b1[8], a2[8], b2[8];
        unpack8(*(const u32x4*)zr, gb); unpack8(*(const u32x4*)(zr + AW), a0); unpack8(*(const u32x4*)(zr + 2 * AW), b0);
        const u32x4 zero = (u32x4){0u, 0u, 0u, 0u};
        unpack8(t >= 1 ? *(const u32x4*)(zr - EVEN_IN + AW) : zero, a1); unpack8(t >= 1 ? *(const u32x4*)(zr - EVEN_IN + 2 * AW) : zero, b1);
        unpack8(t >= 2 ? *(const u32x4*)(zr - 2 * EVEN_IN + AW) : zero, a2); unpack8(t >= 2 ? *(const u32x4*)(zr - 2 * EVEN_IN + 2 * AW) : zero, b2);
        float o[8];
#pragma unroll
        for (int j = 0; j < 8; ++j) o[j] = gb[j] * (cw[2 * AW + c8 + j] * (a0[j] * b0[j]) + cw[AW + c8 + j] * (a1[j] * b1[j]) + cw[c8 + j] * (a2[j] * b2[j]));
        u32x4 w; w.x = cvt_pk_bf16(o[0], o[1]); w.y = cvt_pk_bf16(o[2], o[3]); w.z = cvt_pk_bf16(o[4], o[5]); w.w = cvt_pk_bf16(o[6], o[7]);
        *(u32x4*)(YY + (size_t)row * D + c8) = w;
    }
}

__device__ __forceinline__ void phase_mlp_fixup(const float* HG, const float* HU, const float* cw, const float* cb, bf16_t* ACT, Frame& F) {
    PHASE_TID(F, tid, lane, gt);
    for (int idx = gt; idx < 512 * (DFF / 4); idx += F.ngt) {
        const int ri = idx / (DFF / 4), c = (idx % (DFF / 4)) * 4, blk = ri >> 1, e = ri & 1, r = blk * 64 + e, t = r & (L - 1);
        const f32x4 zero = (f32x4){0.f, 0.f, 0.f, 0.f};
        f32x4 gm2, gm1, g0;
        if (e == 0) { gm2 = (t >= 2) ? *(const f32x4*)(HG + ((size_t)(blk - 1) * 4 + 0) * DFF + c) : zero; gm1 = (t >= 1) ? *(const f32x4*)(HG + ((size_t)(blk - 1) * 4 + 1) * DFF + c) : zero; g0 = *(const f32x4*)(HG + ((size_t)blk * 4 + 2) * DFF + c); }
        else        { gm2 = (t >= 2) ? *(const f32x4*)(HG + ((size_t)(blk - 1) * 4 + 1) * DFF + c) : zero; gm1 = *(const f32x4*)(HG + ((size_t)blk * 4 + 2) * DFF + c); g0 = *(const f32x4*)(HG + ((size_t)blk * 4 + 3) * DFF + c); }
        const f32x4 up = *(const f32x4*)(HU + ((size_t)blk * 2 + e) * DFF + c);
        const f32x4 w0 = *(const f32x4*)(cw + c), w1 = *(const f32x4*)(cw + DFF + c), w2 = *(const f32x4*)(cw + 2 * DFF + c), bb = *(const f32x4*)(cb + c);
        f32x4 pre = w2 * g0 + w1 * gm1 + w0 * gm2 + bb, a;
#pragma unroll
        for (int j = 0; j < 4; ++j) a[j] = pre[j] * fast_sigmoid(pre[j]) * up[j];
        u32x2 w; w.x = cvt_pk_bf16(a[0], a[1]); w.y = cvt_pk_bf16(a[2], a[3]);
        *(u32x2*)(ACT + (size_t)r * DFF + c) = w;
    }
}

__device__ __forceinline__ void phase_ya_fixup(const float* HV, const float* HGB, const float* cw, bf16_t* YY, Frame& F) {
    PHASE_TID(F, tid, lane, gt);
    for (int idx = gt; idx < 512 * (AW / 4); idx += F.ngt) {
        const int ri = idx >> 8, c = (idx & 255) * 4, blk = ri >> 1, e = ri & 1, r = blk * 64 + e, t = r & (L - 1);
        const f32x4 zero = (f32x4){0.f, 0.f, 0.f, 0.f};
        f32x4 vm2, vm1, v0;
        if (e == 0) { vm2 = (t >= 2) ? *(const f32x4*)(HV + ((size_t)(blk - 1) * 4 + 0) * AW + c) : zero; vm1 = (t >= 1) ? *(const f32x4*)(HV + ((size_t)(blk - 1) * 4 + 1) * AW + c) : zero; v0 = *(const f32x4*)(HV + ((size_t)blk * 4 + 2) * AW + c); }
        else        { vm2 = (t >= 2) ? *(const f32x4*)(HV + ((size_t)(blk - 1) * 4 + 1) * AW + c) : zero; vm1 = *(const f32x4*)(HV + ((size_t)blk * 4 + 2) * AW + c); v0 = *(const f32x4*)(HV + ((size_t)blk * 4 + 3) * AW + c); }
        const f32x4 gb = *(const f32x4*)(HGB + ((size_t)blk * 2 + e) * AW + c);
        const f32x4 w0 = *(const f32x4*)(cw + c), w1 = *(const f32x4*)(cw + AW + c), w2 = *(const f32x4*)(cw + 2 * AW + c);
        const f32x4 a = gb * (w2 * v0 + w1 * vm1 + w0 * vm2);
        u32x2 w; w.x = cvt_pk_bf16(a[0], a[1]); w.y = cvt_pk_bf16(a[2], a[3]);
        *(u32x2*)(YY + (size_t)r * D + c) = w;
    }
}

__device__ __forceinline__ void phase_final(const bf16_t* HB, const i64* ss, const float* g, float* out, Frame& F) {
    PHASE_TID(F, tid, lane, gt);
    for (size_t i = gt; i < (size_t)M * D / 8; i += F.ngt) {
        const int row = (int)(i >> 8), c = (int)(i & 255) * 8;
        const float rs = 1.0f / sqrtf((float)ss[row] * SS_INV + EPS);
        float h[8]; unpack8(*(const u32x4*)(HB + i * 8), h);
        const f32x4 g0 = *(const f32x4*)(g + c), g1 = *(const f32x4*)(g + c + 4);
        *(f32x4*)(out + i * 8) = (f32x4){h[0], h[1], h[2], h[3]} * rs * g0; *(f32x4*)(out + i * 8 + 4) = (f32x4){h[4], h[5], h[6], h[7]} * rs * g1;
    }
}

typedef float f32x16 __attribute__((ext_vector_type(16)));
constexpr int SWA_KSTR = 144, SWA_VSTR = 520, SWA_K_OFF = 0, SWA_V_OFF = 256 * SWA_KSTR, SWA_T_OFF = SWA_V_OFF + 64 * SWA_VSTR, SWA_TLEN = 192;
__device__ __forceinline__ void phase_swa(const bf16_t* QKV, const float* rel_bias, const float* sinks, bf16_t* O, Frame& F) {
    PHASE_TID(F, tid, lane, gt);
    const float LOG2E = 1.4426950408889634f;
    LAS unsigned char* lds = F.lds;
    const int q31 = lane & 31, hf = lane >> 5;
    for (int unit = F.bid; unit < NB * 32 * NKVH; unit += F.G) {
        const int b = unit >> 7, n = (unit >> 2) & 31, kvh = unit & 3, row0 = b * L + n * 128;
#pragma unroll
        for (int i = 0; i < 4; ++i) { const int it = tid + i * NTHR, key = it >> 3, ch = it & 7;
            u32x4 v = (u32x4){0u, 0u, 0u, 0u};
            if (n > 0 || key >= 128) v = *(const u32x4*)(QKV + (size_t)(row0 - 128 + key) * ODD_IN + NQH * HD + kvh * HD + ch * 8);
            *(LAS u32x4*)(lds + SWA_K_OFF + key * SWA_KSTR + ch * 16) = v; }
#pragma unroll
        for (int i = 0; i < 2; ++i) { const int it = tid + i * NTHR, dc = it & 7, kp = it >> 3;
            u32x4 v0 = (u32x4){0u, 0u, 0u, 0u}, v1 = v0;
            if (n > 0 || kp >= 64) { const bf16_t* vp = QKV + (size_t)(row0 - 128 + 2 * kp) * ODD_IN + (NQH + NKVH) * HD + kvh * HD + dc * 8; v0 = *(const u32x4*)vp; v1 = *(const u32x4*)(vp + ODD_IN); }
            LAS unsigned char* dst = lds + SWA_V_OFF + (dc * 8) * SWA_VSTR + kp * 4;
            *(LAS unsigned*)(dst + 0 * SWA_VSTR) = (v0.x & 0xffffu) | (v1.x << 16); *(LAS unsigned*)(dst + 1 * SWA_VSTR) = (v0.x >> 16) | (v1.x & 0xffff0000u);
            *(LAS unsigned*)(dst + 2 * SWA_VSTR) = (v0.y & 0xffffu) | (v1.y << 16); *(LAS unsigned*)(dst + 3 * SWA_VSTR) = (v0.y >> 16) | (v1.y & 0xffff0000u);
            *(LAS unsigned*)(dst + 4 * SWA_VSTR) = (v0.z & 0xffffu) | (v1.z << 16); *(LAS unsigned*)(dst + 5 * SWA_VSTR) = (v0.z >> 16) | (v1.z & 0xffff0000u);
            *(LAS unsigned*)(dst + 6 * SWA_VSTR) = (v0.w & 0xffffu) | (v1.w << 16); *(LAS unsigned*)(dst + 7 * SWA_VSTR) = (v0.w >> 16) | (v1.w & 0xffff0000u); }
        for (int idx = tid; idx < 8 * SWA_TLEN; idx += NTHR) { const int g = idx / SWA_TLEN, e = idx % SWA_TLEN, rel = e - 31;
            const float v = (rel >= 0 && rel < 128) ? rel_bias[kBucket[rel] * NQH + kvh * 8 + g] * LOG2E : -1e30f;
            *(LAS float*)(lds + SWA_T_OFF + idx * 4) = v; }
        __syncthreads();
        const int hq = kvh * 8 + F.wave; const float sink2 = sinks[hq] * LOG2E;
        bf16x8 qn[4];
        { const bf16_t* qp = QKV + (size_t)(row0 + q31) * ODD_IN + hq * HD + 8 * hf;
#pragma unroll
          for (int s = 0; s < 4; ++s) qn[s] = *(const bf16x8*)(qp + 16 * s); }
#pragma unroll 1
        for (int qt = 0; qt < 4; ++qt) {
            bf16x8 qf[4];
#pragma unroll
            for (int s = 0; s < 4; ++s) qf[s] = qn[s];
            if (qt < 3) { const bf16_t* qp = QKV + (size_t)(row0 + 32 * (qt + 1) + q31) * ODD_IN + hq * HD + 8 * hf;
#pragma unroll
                for (int s = 0; s < 4; ++s) qn[s] = *(const bf16x8*)(qp + 16 * s); }
            f32x16 S[5];
#pragma unroll
            for (int dt = 0; dt < 5; ++dt) {
                const int kt = qt + dt;
                if (n == 0 && kt < 4) {
#pragma unroll
                    for (int i = 0; i < 16; ++i) S[dt][i] = -1e30f;
                } else {
                    f32x16 acc;
#pragma unroll
                    for (int i = 0; i < 16; ++i) acc[i] = 0.f;
#pragma unroll
                    for (int s = 0; s < 4; ++s) { const bf16x8 kf = *(const LAS bf16x8*)(lds + SWA_K_OFF + (32 * kt + q31) * SWA_KSTR + (16 * s + 8 * hf) * 2);
                        acc = __builtin_amdgcn_mfma_f32_32x32x16_bf16(kf, qf[s], acc, 0, 0, 0); }
                    const LAS unsigned char* tb = lds + SWA_T_OFF + (F.wave * SWA_TLEN + 159 - 32 * dt + q31 - 4 * hf - 27) * 4;
#pragma unroll
                    for (int i = 0; i < 16; ++i) S[dt][i] = acc[i] * LOG2E + *(const LAS float*)(tb + (27 - (8 * (i >> 2) + (i & 3))) * 4);
                }
            }
            float mx = sink2;
#pragma unroll
            for (int dt = 0; dt < 5; ++dt)
#pragma unroll
                for (int i = 0; i < 16; ++i) mx = fmaxf(mx, S[dt][i]);
            mx = fmaxf(mx, shx(mx, 32, lane));
            float l = 0.f;
#pragma unroll
            for (int dt = 0; dt < 5; ++dt)
#pragma unroll
                for (int i = 0; i < 16; ++i) { const float p = __builtin_amdgcn_exp2f(S[dt][i] - mx); S[dt][i] = p; l += p; }
            l += shx(l, 32, lane);
            const float inv = __builtin_amdgcn_rcpf(l + __builtin_amdgcn_exp2f(sink2 - mx));
            f32x16 oa[2];
#pragma unroll
            for (int dd = 0; dd < 2; ++dd)
#pragma unroll
                for (int i = 0; i < 16; ++i) oa[dd][i] = 0.f;
#pragma unroll
            for (int dt = 0; dt < 5; ++dt) {
                const int kt = qt + dt;
                if (!(n == 0 && kt < 4)) {
#pragma unroll
                    for (int s = 0; s < 2; ++s) {
                        u32x4 pw; pw.x = cvt_pk_bf16(S[dt][8 * s + 0], S[dt][8 * s + 1]); pw.y = cvt_pk_bf16(S[dt][8 * s + 2], S[dt][8 * s + 3]); pw.z = cvt_pk_bf16(S[dt][8 * s + 4], S[dt][8 * s + 5]); pw.w = cvt_pk_bf16(S[dt][8 * s + 6], S[dt][8 * s + 7]);
                        const bf16x8 pb = __builtin_bit_cast(bf16x8, pw);
#pragma unroll
                        for (int dd = 0; dd < 2; ++dd) {
                            const LAS unsigned char* vp = lds + SWA_V_OFF + (32 * dd + q31) * SWA_VSTR + (32 * kt + 16 * s + 4 * hf) * 2;
                            const u32x2 a0 = *(const LAS u32x2*)vp, a1 = *(const LAS u32x2*)(vp + 16);
                            const bf16x8 va = __builtin_bit_cast(bf16x8, (u32x4){a0.x, a0.y, a1.x, a1.y});
                            oa[dd] = __builtin_amdgcn_mfma_f32_32x32x16_bf16(va, pb, oa[dd], 0, 0, 0);
                        }
                    }
                }
            }
            bf16_t* op = O + (size_t)(row0 + 32 * qt + q31) * D + hq * HD + 4 * hf;
#pragma unroll
            for (int dd = 0; dd < 2; ++dd)
#pragma unroll
                for (int g4 = 0; g4 < 4; ++g4) { u32x2 w; w.x = cvt_pk_bf16(oa[dd][4 * g4 + 0] * inv, oa[dd][4 * g4 + 1] * inv); w.y = cvt_pk_bf16(oa[dd][4 * g4 + 2] * inv, oa[dd][4 * g4 + 3] * inv);
                    *(u32x2*)(op + 32 * dd + 8 * g4) = w; }
        }
        __syncthreads();
    }
}

constexpr int S5_PW_OFF = 0, S5_KC_OFF = 4608, S5_SL_OFF = 9216, S5_XB_OFF = 41984, S5_XSTR = 272;
__device__ __forceinline__ float bfe(const bf16x8& v, int j) { return __uint_as_float(((unsigned)(unsigned short)v[j]) << 16); }
template <int RT>
__device__ __forceinline__ void s5_unit(const bf16_t* Z, const float* s5p, const float* c_re, const float* c_im, const float* dvec, const float* glu, bf16_t* YY, LAS unsigned char* lds,
                                        const int b, const int g, const int wave, const int tid, const int lane) {
    const int q31 = lane & 31, hf = lane >> 5, mtl = wave >> 2;
    LAS f32x2* PW = (LAS f32x2*)(lds + S5_PW_OFF);
    { const int p = tid & 63, j = tid >> 6; const float ar = s5p[(size_t)(g * 64 + p) * 34], ai = s5p[(size_t)(g * 64 + p) * 34 + 1];
      float pr = 1.f, pi = 0.f;
      for (int k = 0; k < j; ++k) { const float nr = pr * ar - pi * ai, ni = pr * ai + pi * ar; pr = nr; pi = ni; }
      PW[j * 64 + p] = (f32x2){pr, pi};
      if (j == 7) PW[8 * 64 + p] = (f32x2){pr * ar - pi * ai, pr * ai + pi * ar}; }
    __syncthreads();
    { LAS bf16_t* KC = (LAS bf16_t*)(lds + S5_KC_OFF);
#pragma unroll 1
      for (int q = 0; q < 4; ++q) { const int e = tid + NTHR * q, jj = e >> 8, h = (e >> 4) & 15, hp = e & 15;
          const float* cr = c_re + (size_t)(g * 16 + h) * 64; const float* ci = c_im + (size_t)(g * 16 + h) * 64; const float* bb = s5p + (size_t)(g * 64) * 34 + 2 + hp;
          float sum = 0.f;
#pragma unroll 4
          for (int p = 0; p < 64; ++p) { const f32x2 pw = PW[jj * 64 + p]; const float tr = cr[p] * pw.x - ci[p] * pw.y, ti = cr[p] * pw.y + ci[p] * pw.x; sum += tr * bb[p * 34] - ti * bb[p * 34 + 16]; }
          const int pos = 8 * ((hp >> 2) & 1) + 4 * (hp >> 3) + (hp & 3);
          KC[(jj * 16 + h) * 16 + pos] = (bf16_t)(cvt_pk_bf16(sum, 0.f) & 0xffffu); }
      if (tid < 128) ((LAS unsigned*)(KC + 8 * 256))[tid] = 0u; }
    __syncthreads();
    bf16x8 pf[8], qf[8], kf[2 * RT + 2], ga[2]; float d8[8];
    {
      const int comp = 32 * RT + q31, p = comp & 63; const bool im = comp >= 64; const float* bbp = s5p + (size_t)(g * 64 + p) * 34 + 2;
      float br[8], bi[8];
#pragma unroll
      for (int j = 0; j < 8; ++j) { const int hp = 8 * (j >> 2) + 4 * hf + (j & 3); br[j] = bbp[hp]; bi[j] = bbp[16 + hp]; }
#pragma unroll
      for (int s = 0; s < 8; ++s) { const f32x2 pw = PW[(7 - s) * 64 + p]; float v[8];
#pragma unroll
          for (int j = 0; j < 8; ++j) v[j] = im ? (pw.x * bi[j] + pw.y * br[j]) : (pw.x * br[j] - pw.y * bi[j]);
          u32x4 w; w.x = cvt_pk_bf16(v[0], v[1]); w.y = cvt_pk_bf16(v[2], v[3]); w.z = cvt_pk_bf16(v[4], v[5]); w.w = cvt_pk_bf16(v[6], v[7]); pf[s] = __builtin_bit_cast(bf16x8, w); } }
    {
      const int t2 = 2 * RT + (q31 >> 4), h = q31 & 15; const float* cr = c_re + (size_t)(g * 16 + h) * 64; const float* ci = c_im + (size_t)(g * 16 + h) * 64;
#pragma unroll
      for (int ks = 0; ks < 4; ++ks) { float vr[8], vi[8];
#pragma unroll
          for (int j = 0; j < 8; ++j) { const int p = 16 * ks + 8 * hf + j; const f32x2 pw = PW[(t2 + 1) * 64 + p]; const float a = cr[p], c = ci[p]; vr[j] = a * pw.x - c * pw.y; vi[j] = -(a * pw.y + c * pw.x); }
          u32x4 w; w.x = cvt_pk_bf16(vr[0], vr[1]); w.y = cvt_pk_bf16(vr[2], vr[3]); w.z = cvt_pk_bf16(vr[4], vr[5]); w.w = cvt_pk_bf16(vr[6], vr[7]); qf[ks] = __builtin_bit_cast(bf16x8, w);
          w.x = cvt_pk_bf16(vi[0], vi[1]); w.y = cvt_pk_bf16(vi[2], vi[3]); w.z = cvt_pk_bf16(vi[4], vi[5]); w.w = cvt_pk_bf16(vi[6], vi[7]); qf[ks + 4] = __builtin_bit_cast(bf16x8, w); }
#pragma unroll
      for (int s = 0; s < 2 * RT + 2; ++s) { int jj = t2 - s; jj = jj < 0 ? 8 : jj; kf[s] = *(const LAS bf16x8*)(lds + S5_KC_OFF + ((jj * 16 + h) * 16 + 8 * hf) * 2); }
      const int o = q31 & 15, t2p = q31 >> 4;
#pragma unroll
      for (int ks = 0; ks < 2; ++ks) { float v[8];
#pragma unroll
          for (int j = 0; j < 8; ++j) { const int hh = 8 * (j >> 2) + 4 * hf + (j & 3); v[j] = (t2p == ks) ? glu[g * 256 + hh * 16 + o] : 0.f; }
          u32x4 w; w.x = cvt_pk_bf16(v[0], v[1]); w.y = cvt_pk_bf16(v[2], v[3]); w.z = cvt_pk_bf16(v[4], v[5]); w.w = cvt_pk_bf16(v[6], v[7]); ga[ks] = __builtin_bit_cast(bf16x8, w); }
#pragma unroll
      for (int j = 0; j < 8; ++j) d8[j] = dvec[g * 16 + 8 * (j >> 2) + 4 * hf + (j & 3)]; }
    const f32x2 a8 = PW[8 * 64 + lane];
    float Sre = 0.f, Sim = 0.f;
    LAS float* SL = (LAS float*)(lds + S5_SL_OFF);
#pragma unroll 1
    for (int seg = 0; seg < 8; ++seg) {
        const int mloc = mtl * 32 + q31; const size_t tok0 = (size_t)b * L + 8 * (seg * 64 + mloc);
        const bf16_t* up = Z + ((size_t)g * M + tok0) * 16 + 4 * hf;
        bf16x8 uf[8];
#pragma unroll
        for (int s = 0; s < 8; ++s) { const u32x2 lo = *(const u32x2*)(up + s * 16), hi = *(const u32x2*)(up + s * 16 + 8); uf[s] = __builtin_bit_cast(bf16x8, (u32x4){lo.x, lo.y, hi.x, hi.y}); }
        { f32x16 acc;
#pragma unroll
          for (int i = 0; i < 16; ++i) acc[i] = 0.f;
#pragma unroll
          for (int s = 0; s < 8; ++s) acc = __builtin_amdgcn_mfma_f32_32x32x16_bf16(uf[s], pf[s], acc, 0, 0, 0);
#pragma unroll
          for (int i = 0; i < 16; ++i) SL[(mtl * 32 + 8 * (i >> 2) + 4 * hf + (i & 3)) * 128 + 32 * RT + q31] = acc[i]; }
        __syncthreads();
        if (wave == 0) {
#pragma unroll 1
            for (int blk = 0; blk < 8; ++blk) { float lr[8], li[8];
#pragma unroll
                for (int k = 0; k < 8; ++k) { lr[k] = SL[(blk * 8 + k) * 128 + lane]; li[k] = SL[(blk * 8 + k) * 128 + 64 + lane]; }
#pragma unroll
                for (int k = 0; k < 8; ++k) { LAS bf16_t* xr = (LAS bf16_t*)(lds + S5_XB_OFF + (blk * 8 + k) * S5_XSTR);
                    const unsigned w = cvt_pk_bf16(Sre, Sim); xr[lane] = (bf16_t)(w & 0xffffu); xr[64 + lane] = (bf16_t)(w >> 16);
                    const float nr = a8.x * Sre - a8.y * Sim + lr[k], ni = a8.x * Sim + a8.y * Sre + li[k]; Sre = nr; Sim = ni; } } }
        __syncthreads();
        { f32x16 acc;
#pragma unroll
          for (int i = 0; i < 16; ++i) acc[i] = 0.f;
#pragma unroll
          for (int s = 0; s < 2 * RT + 2; ++s) acc = __builtin_amdgcn_mfma_f32_32x32x16_bf16(kf[s], uf[s], acc, 0, 0, 0);
#pragma unroll
          for (int ks = 0; ks < 8; ++ks) { const bf16x8 xf = *(const LAS bf16x8*)(lds + S5_XB_OFF + mloc * S5_XSTR + (16 * ks + 8 * hf) * 2); acc = __builtin_amdgcn_mfma_f32_32x32x16_bf16(qf[ks], xf, acc, 0, 0, 0); }
          float yg[16];
#pragma unroll
          for (int i = 0; i < 16; ++i) yg[i] = gelu_tanh_f(acc[i] + d8[i & 7] * bfe(uf[2 * RT + (i >> 3)], i & 7));
          f32x16 gt;
#pragma unroll
          for (int i = 0; i < 16; ++i) gt[i] = 0.f;
#pragma unroll
          for (int ks = 0; ks < 2; ++ks) { u32x4 w; w.x = cvt_pk_bf16(yg[8 * ks + 0], yg[8 * ks + 1]); w.y = cvt_pk_bf16(yg[8 * ks + 2], yg[8 * ks + 3]); w.z = cvt_pk_bf16(yg[8 * ks + 4], yg[8 * ks + 5]); w.w = cvt_pk_bf16(yg[8 * ks + 6], yg[8 * ks + 7]);
              gt = __builtin_amdgcn_mfma_f32_32x32x16_bf16(ga[ks], __builtin_bit_cast(bf16x8, w), gt, 0, 0, 0); }
          bf16_t* op = YY + (tok0 + 2 * RT) * D + AW + g * 16 + 4 * hf;
#pragma unroll
          for (int t2l = 0; t2l < 2; ++t2l)
#pragma unroll
              for (int grp = 0; grp < 2; ++grp) { const int i0 = 8 * t2l + 4 * grp; float o[4];
#pragma unroll
                  for (int r = 0; r < 4; ++r) o[r] = yg[i0 + r] * fast_sigmoid(gt[i0 + r]);
                  u32x2 w; w.x = cvt_pk_bf16(o[0], o[1]); w.y = cvt_pk_bf16(o[2], o[3]);
                  *(u32x2*)(op + (size_t)t2l * D + 8 * grp) = w; } }
    }
    __syncthreads();
}
__device__ __forceinline__ void phase_s5(const bf16_t* Z, const float* s5p, const float* c_re, const float* c_im, const float* dvec, const float* glu, bf16_t* YY, Frame& F) {
    PHASE_TID(F, tid, lane, gt);
    for (int unit = F.bid; unit < NB * S5G; unit += F.G) {
        const int b = unit / S5G, g = unit % S5G;
        switch (F.wave & 3) {
            case 0: s5_unit<0>(Z, s5p, c_re, c_im, dvec, glu, YY, F.lds, b, g, F.wave, tid, lane); break;
            case 1: s5_unit<1>(Z, s5p, c_re, c_im, dvec, glu, YY, F.lds, b, g, F.wave, tid, lane); break;
            case 2: s5_unit<2>(Z, s5p, c_re, c_im, dvec, glu, YY, F.lds, b, g, F.wave, tid, lane); break;
            default: s5_unit<3>(Z, s5p, c_re, c_im, dvec, glu, YY, F.lds, b, g, F.wave, tid, lane); break;
        }
    }
}
namespace pg8 {
struct SchedKV {
    unsigned char* ws; int G, c;
    __device__ __forceinline__ bool next(int i, Unit& u) const {
        const long Lx = (long)i * G + c; if (Lx >= 256) return false;
        const int l = (int)Lx >> 6, rem = (int)Lx & 63, pm = rem >> 4, pn = rem & 15;
        u.A = (const char*)(ws + WS_MEMN) + (size_t)pm * 256 * D * 2;
        u.B = (const char*)(ws + WS_WKV_T) + ((size_t)l * 2 * D + pn * 256) * D * 2;
        u.C = (char*)(ws + WS_KVM) + (pn >= 8 ? 16 * MiB : 0) + (((size_t)l * MROWS + pm * 256) * D + (pn & 7) * 256) * 2;
        u.vec = nullptr; u.row0 = pm * 256; u.col0 = pn * 256; u.aux = D; return true;
    }
};
struct SchedWSVW {
    unsigned char* ws; const float* gx; int G, c;
    __device__ __forceinline__ bool next(int i, Unit& u) const {
        const long Lx = (long)i * G + c; if (Lx >= 1024) return false;
        const int j = (int)Lx & 511, z = j >> 3, pt = j & 7, l = z >> 4, b = (z >> 2) & 3, head = z & 3;
        if (Lx < 512) {
            u.A = (const char*)(ws + WS_KVM) + (((size_t)l * MROWS + b * 256) * D + head * XHD) * 2;
            u.B = (const char*)(ws + WS_WQ_BF) + (((size_t)l * D + pt * 256) * D + head * XHD) * 2;
            u.C = (char*)(ws + WS_WS) + ((((size_t)(l * 4 + b) * 1024 + head * 256) * D) + pt * 256) * 2;
            u.vec = gx + l * D; u.row0 = 0; u.col0 = pt * 256; u.aux = D;
        } else {
            u.A = (const char*)(ws + WS_WO_T) + (((size_t)l * D + pt * 256) * D + head * XHD) * 2;
            u.B = (const char*)(ws + WS_KVM) + 16 * MiB + (((size_t)l * MROWS + b * 256) * D + head * XHD) * 2;
            u.C = (char*)(ws + WS_VW) + ((((size_t)(l * 4 + b) * D + pt * 256) * 1024) + head * 256) * 2;
            u.vec = nullptr; u.row0 = 0; u.col0 = 0; u.aux = 1024;
        }
        return true;
    }
};
}

#ifndef NO_PKF32
#define NO_PKF32 1
#endif
#if NO_PKF32 && defined(__HIP_DEVICE_COMPILE__)
#define MEGA_TGT __attribute__((target("no-packed-fp32-ops")))
#else
#define MEGA_TGT
#endif
__global__ void __launch_bounds__(NTHR, 2) MEGA_TGT mega_fwd(Args a) {
    extern __shared__ __attribute__((aligned(16))) unsigned char lds_raw[];
    Frame F;
    F.lds = (LAS unsigned char*)lds_raw;
    const int tid0 = threadIdx.x; F.wave = __builtin_amdgcn_readfirstlane(tid0 >> 6);
    F.G = gridDim.x; F.bid = blockIdx.x;
    F.gw = F.bid * NWAVES + F.wave; F.ngw = F.G * NWAVES; F.ngt = F.G * NTHR;
    unsigned char* ws = a.ws;
    volatile LAS unsigned* MISC = (volatile LAS unsigned*)(F.lds + MISC_OFF);
    for (int u = tid0; u < (LDS_BYTES - MISC_OFF) / 4; u += NTHR) ((LAS unsigned*)(F.lds + MISC_OFF))[u] = 0u;
    __syncthreads();
    unsigned* ctl = (unsigned*)(ws + WS_CTL);
    const XcdBarrier bar = xcd_barrier_post(ctl + CW_BAR, MISC + 8, F.wave);
    static_assert(8 * 16640 <= MISC_OFF, "prologue scratch below the control words");
    static_assert((CW_BAR + XCD_BAR_WORDS) * 4 <= (int)CTL_ZERO_BYTES, "barrier words inside the memset region");
#define GRID_BAR() do { xcd_barrier(bar); if (PROBE_BAR) xcd_barrier(bar); } while (0)

    i64* SS = (i64*)(ws + WS_SS);
    bf16_t* HB = (bf16_t*)(ws + WS_HB); bf16_t* YY = (bf16_t*)(ws + WS_YY);
    bf16_t* BIG = (bf16_t*)(ws + WS_BIG);
    float* HG = (float*)(ws + WS_HALO_G); float* HU = (float*)(ws + WS_HALO_U);
    float* DUMF = (float*)(ws + WS_END); bf16_t* DUMB = (bf16_t*)(ws + WS_END); (void)DUMF; (void)DUMB;
    const int cid = (int)blockIdx.x;

#ifndef PHMASK
#define PHMASK 0xFFFF
#endif
#ifndef PROBE_DUP
#define PROBE_DUP 0
#endif
#ifndef PROBE_KONLY
#define PROBE_KONLY 0
#endif
#ifndef F1_ALIGN
#define F1_ALIGN true
#endif
#ifndef F2_WGM
#define F2_WGM 4
#endif
#ifndef PROBE_BAR
#define PROBE_BAR 0
#endif
#define REP(bit) for (int rep_ = 0; rep_ < (((PROBE_DUP) & (bit)) ? 2 : 1); ++rep_)
    REP(1) if (PHMASK & 1) p0_prologue(a, F);
    GRID_BAR();
    for (int l = 0; l < 4; ++l) {
        const int i = l >> 1;
        if ((l & 1) == 0) {
            if (l == 0 && (PHMASK & 2)) { pg8::SchedKV S{ws, F.G, cid}; pg8::EpiPlain E;
              pg8::gemm_phase<pg8::EpiPlain, pg8::SchedKV, true>(F.lds, F.wave, D, D, D, S, E); }
            REP(8) if (PHMASK & 8) { pg8::SchedMain S{(const char*)HB, (const char*)(ws + WS_WIN_T) + (size_t)i * EVEN_IN * D * 2, nullptr, (size_t)256 * D * 2, (size_t)256 * D * 2, 0, 0, 0, 64, 16, 64, 64, F.G, cid};
              pg8::EpiEven E{SS + (size_t)(3 * l) * M, a.in[9] + (size_t)i * 3 * AW, YY, BIG, HG, HG + 2 * MiB};
              pg8::gemm_phase<pg8::EpiEven, pg8::SchedMain, true>(F.lds, F.wave, D, D, D, S, E); }
            GRID_BAR();
            if (l == 0 && (PHMASK & 4)) { pg8::SchedWSVW S{ws, (const float*)(ws + WS_GXS), F.G, cid}; pg8::EpiPlain E;
              pg8::gemm_phase<pg8::EpiPlain, pg8::SchedWSVW, true>(F.lds, F.wave, D, D, XHD, S, E); }
            REP(16) if (PHMASK & 16) phase_ya_fixup(HG, HG + 2 * MiB, a.in[9] + (size_t)i * 3 * AW, YY, F);
            REP(32) if (PHMASK & 32) phase_s5(BIG, (const float*)(ws + WS_S5P) + (size_t)i * 4096 * 34, a.in[15] + (size_t)i * 65536, a.in[16] + (size_t)i * 65536, a.in[17] + i * 1024, a.in[18] + (size_t)i * 16384, YY, F);
            GRID_BAR();
        } else {
            REP(64) if (PHMASK & 64) { pg8::SchedMain S{(const char*)HB, (const char*)(ws + WS_WQKV_T) + (size_t)i * ODD_IN * D * 2, (char*)BIG, (size_t)256 * D * 2, (size_t)256 * D * 2, 0, (size_t)256 * ODD_IN * 2, 256 * 2, 64, 10, 64, 256, F.G, cid};
              pg8::EpiRowScale E{SS + (size_t)(3 * l) * M, (const float*)(ws + WS_QKVB) + i * ODD_IN, ODD_IN};
              pg8::gemm_phase<pg8::EpiRowScale, pg8::SchedMain, true>(F.lds, F.wave, D, D, D, S, E); }
            GRID_BAR();
            REP(128) if (PHMASK & 128) phase_swa(BIG, a.in[7], a.in[22] + i * NQH, YY, F);
            GRID_BAR();
        }
        REP(256) if (PHMASK & 256) { const char* Bw = (l & 1) ? (const char*)(ws + WS_OWOUT_T) + (size_t)i * D * D * 2 : (const char*)(ws + WS_EWOUT_T) + (size_t)i * D * D * 2;
          pg8::SchedMain S{(const char*)YY, Bw, nullptr, (size_t)256 * D * 2, (size_t)256 * D * 2, 0, 0, 0, 64, 8, 64, 256, F.G, cid};
          pg8::EpiRes E{HB, rep_ ? DUMB : HB, SS + (size_t)(rep_ ? 13 : 3 * l + 1) * M, F.lds + RING_BYTES};
          pg8::gemm_phase<pg8::EpiRes, pg8::SchedMain, true>(F.lds, F.wave, D, D, D, S, E); }
        GRID_BAR();
        REP(512) if (PHMASK & 512) { pg8::SchedMain S{(const char*)HB, (const char*)(ws + WS_WS) + (size_t)l * 4 * 1024 * D * 2, (char*)BIG, (size_t)256 * D * 2, (size_t)256 * D * 2, (size_t)1024 * D * 2, (size_t)256 * 1024 * 2, 256 * 2, 64, 4, 16, 256, F.G, cid};
          pg8::EpiSoftmax E{SS + (size_t)(3 * l + 1) * M, 1024};
          pg8::gemm_phase<pg8::EpiSoftmax, pg8::SchedMain, false>(F.lds, F.wave, D, D, D, S, E); }
        GRID_BAR();
        REP(1024) if (PHMASK & 1024) { pg8::SchedMain S{(const char*)BIG, (const char*)(ws + WS_VW) + (size_t)l * 4 * D * 1024 * 2, nullptr, (size_t)256 * 1024 * 2, (size_t)256 * 1024 * 2, (size_t)D * 1024 * 2, 0, 0, 64, 8, 16, 256, F.G, cid};
          pg8::EpiRes E{HB, rep_ ? DUMB : HB, SS + (size_t)(rep_ ? 13 : 3 * l + 2) * M, F.lds + RING_BYTES};
          pg8::gemm_phase<pg8::EpiRes, pg8::SchedMain, true>(F.lds, F.wave, 1024, 1024, 1024, S, E); }
        GRID_BAR();
        REP(2048) if (PHMASK & 2048) { pg8::SchedMain S{(const char*)HB, (const char*)(ws + WS_WGU_T) + (size_t)l * NGU * D * 2, (char*)BIG, (size_t)256 * D * 2, (size_t)256 * D * 2, 0, (size_t)256 * DFF * 2, 128 * 2, 64, 44, 64, 128, F.G, cid};
          {
            PHASE_TID(F, tid, lane, gt); pg8::Unit fu; int nslots = 0, lastpm = -1;
            const float* cwp = a.in[29] + (size_t)l * 3 * DFF; const float* cbp = a.in[30] + (size_t)l * DFF; const i64* ssp = SS + (size_t)(3 * l + 2) * M;
            for (int ui = 0; ui < 12 && S.next(ui, fu); ++ui) {
                const int pm = fu.row0 >> 8;
                if (pm != lastpm && nslots < 3) { if (tid < 256) ((LAS float*)(F.lds + F1_RST_OFF))[nslots * 256 + tid] = rstd_of(ssp[pm * 256 + tid]); ++nslots; lastpm = pm; }
                if (tid == 0) ((LAS int*)(F.lds + F1_SLOT_OFF))[ui] = nslots - 1;
                const int vec = tid >> 7, ch = tid & 127;
                ((LAS float*)(F.lds + F1_CWT_OFF))[ui * 512 + tid] = (vec < 3 ? cwp[vec * DFF + fu.col0 + ch] : cbp[fu.col0 + ch]) * 1.4426950408889634f;
            }
            LDS_WAIT(); __syncthreads(); }
          pg8::EpiMLP E{F.lds, HG, HU};
          pg8::gemm_phase<pg8::EpiMLP, pg8::SchedMain, F1_ALIGN>(F.lds, F.wave, D, D, D, S, E);
          if (PROBE_KONLY & 2048) { pg8::EpiNull E0; pg8::gemm_phase<pg8::EpiNull, pg8::SchedMain, true>(F.lds, F.wave, D, D, D, S, E0); } }
        GRID_BAR();
        if (PHMASK & 4096) phase_mlp_fixup(HG, HU, a.in[29] + (size_t)l * 3 * DFF, a.in[30] + (size_t)l * DFF, BIG, F);
        GRID_BAR();
        REP(8192) if (PHMASK & 8192) { pg8::SchedMain S{(const char*)BIG, (const char*)(ws + WS_WDOWN_T) + (size_t)l * D * DFF * 2, nullptr, (size_t)256 * DFF * 2, (size_t)256 * DFF * 2, 0, 0, 0, 64, 8, 64, 256, F.G, cid, F2_WGM};
          pg8::EpiRes E{HB, rep_ ? DUMB : HB, SS + (size_t)(rep_ ? 13 : 3 * l + 3) * M, F.lds + RING_BYTES};
          pg8::gemm_phase<pg8::EpiRes, pg8::SchedMain, true>(F.lds, F.wave, DFF, DFF, DFF, S, E); }
        GRID_BAR();
    }
    if (PHMASK & 16384) phase_final(HB, SS + (size_t)12 * M, a.in[5], a.out, F);
#undef GRID_BAR
}

extern "C" void kernel_launch(void* const* d_in, const int* in_sizes, int n_in, void* d_out, int out_size, void* d_ws, size_t ws_size, hipStream_t stream) {
    static int grid = 0;
    if (grid == 0) {
        if (n_in != 32 || out_size != M * D || ws_size < WS_END) { fprintf(stderr, "kernel_launch: unexpected shapes (n_in %d out %d ws %zu)\n", n_in, out_size, ws_size); grid = -1; return; }
        int dev = 0, cus = 0, per_cu = 0;
        if (hipGetDevice(&dev) != hipSuccess || hipDeviceGetAttribute(&cus, hipDeviceAttributeMultiprocessorCount, dev) != hipSuccess) { grid = -1; return; }
        if (hipFuncSetAttribute((const void*)mega_fwd, hipFuncAttributeMaxDynamicSharedMemorySize, LDS_BYTES) != hipSuccess) { fprintf(stderr, "kernel_launch: hipFuncSetAttribute failed\n"); grid = -1; return; }
        if (hipOccupancyMaxActiveBlocksPerMultiprocessor(&per_cu, (const void*)mega_fwd, NTHR, LDS_BYTES) != hipSuccess || per_cu < 1) { fprintf(stderr, "kernel_launch: occupancy query says %d\n", per_cu); }
        (void)hipGetLastError();
        grid = cus;
    }
    if (grid < 0) return;
    if (hipMemsetAsync((char*)d_ws + WS_CTL, 0, CTL_ZERO_BYTES, stream) != hipSuccess) return;
    Args a{};
    for (int i = 0; i < 32; ++i) a.in[i] = (const float*)d_in[i];
    a.out = (float*)d_out; a.ws = (unsigned char*)d_ws;
    hipLaunchKernelGGL(mega_fwd, dim3(grid), dim3(NTHR), LDS_BYTES, stream, a);
}
```

```cpp
#include <hip/hip_runtime.h>
#include <stdint.h>
#include <stdio.h>

#define LAS __attribute__((address_space(3)))
#define GAS __attribute__((address_space(1)))
typedef unsigned short bf16_t;
typedef short bf16x8 __attribute__((ext_vector_type(8)));
typedef float f32x4 __attribute__((ext_vector_type(4)));
typedef float f32x2 __attribute__((ext_vector_type(2)));
typedef unsigned u32x4 __attribute__((ext_vector_type(4)));
typedef unsigned u32x2 __attribute__((ext_vector_type(2)));
typedef GAS unsigned gu32;

constexpr int D = 2048, NB = 4, L = 4096, M = NB * L, NMEM = 256, MROWS = NB * NMEM;
constexpr int AW = 1024, S5G = 64, EVEN_IN = 4096;
constexpr int HD = 64, NQH = 32, NKVH = 4, ODD_IN = 2560;
constexpr int XH = 4, XHD = 512, DFF = 5632, NGU = 2 * DFF;
constexpr float EPS = 1e-5f;
constexpr int NWAVES = 8, NTHR = 512;

constexpr size_t MiB = 1u << 20;
constexpr size_t WS_CTL = 0, CTL_ZERO_BYTES = 32768;
constexpr size_t WS_QKVB = 1 * MiB;
constexpr size_t WS_GXS = 1 * MiB + 64 * 1024;
constexpr size_t WS_WIN_T = 2 * MiB;
constexpr size_t WS_EWOUT_T = 34 * MiB;
constexpr size_t WS_WQKV_T = 50 * MiB;
constexpr size_t WS_OWOUT_T = 70 * MiB;
constexpr size_t WS_WS = 86 * MiB;
constexpr size_t WS_VW = 150 * MiB;
constexpr size_t WS_WGU_T = 214 * MiB;
constexpr size_t WS_WDOWN_T = 390 * MiB;
constexpr size_t WS_H = 478 * MiB;
constexpr size_t WS_HB = 606 * MiB;
constexpr size_t WS_YY = 670 * MiB;
constexpr size_t WS_BIG = 734 * MiB;
constexpr size_t WS_WQ_BF = WS_H;
constexpr size_t WS_WKV_T = WS_H + 32 * MiB;
constexpr size_t WS_WO_T = WS_H + 96 * MiB;
constexpr size_t WS_KVM = 952 * MiB;
constexpr size_t WS_MEMN = 984 * MiB;
constexpr size_t WS_HALO_G = 910 * MiB;
constexpr size_t WS_HALO_U = 934 * MiB;
constexpr size_t WS_S5P = 946 * MiB;
constexpr size_t WS_SS = 948 * MiB;
constexpr size_t WS_END = 990 * MiB;

constexpr int CW_BAR = 4096;

constexpr int RING_BYTES = 131072;
constexpr int LDS_BYTES = 163840;
constexpr int MISC_OFF = LDS_BYTES - 256;
constexpr int F1_CWT_OFF = RING_BYTES, F1_RST_OFF = RING_BYTES + 12 * 2048, F1_SLOT_OFF = F1_RST_OFF + 3 * 1024;

#define RLX_AGENT __ATOMIC_RELAXED, __HIP_MEMORY_SCOPE_AGENT
#define LDS_WAIT() asm volatile("s_waitcnt lgkmcnt(0)" ::: "memory")
#define VM_WAIT() asm volatile("s_waitcnt vmcnt(0)" ::: "memory")
__device__ __forceinline__ unsigned cvt_pk_bf16(float lo, float hi) { unsigned r; asm volatile("v_cvt_pk_bf16_f32 %0, %1, %2" : "=v"(r) : "v"(lo), "v"(hi)); return r; }
__device__ __forceinline__ float bf_lo(unsigned w) { return __uint_as_float(w << 16); }
__device__ __forceinline__ float bf_hi(unsigned w) { return __uint_as_float(w & 0xffff0000u); }
__device__ __forceinline__ float bf1(bf16_t b) { return __uint_as_float(((unsigned)b) << 16); }
__device__ __forceinline__ float shx(float v, int mask, int lane) { return __builtin_bit_cast(float, __builtin_amdgcn_ds_bpermute((lane ^ mask) << 2, __builtin_bit_cast(int, v))); }
__device__ __forceinline__ float shl_(float v, int src, int lane) { (void)lane; return __builtin_bit_cast(float, __builtin_amdgcn_ds_bpermute(src << 2, __builtin_bit_cast(int, v))); }
__device__ __forceinline__ float wave_sum(float v, int lane) {
#pragma unroll
    for (int o = 1; o < 64; o <<= 1) v += shx(v, o, lane);
    return v;
}
__device__ __forceinline__ float wave_max(float v, int lane) {
#pragma unroll
    for (int o = 1; o < 64; o <<= 1) v = fmaxf(v, shx(v, o, lane));
    return v;
}
__device__ __forceinline__ float fast_exp(float x) { return __builtin_amdgcn_exp2f(x * 1.4426950408889634f); }
__device__ __forceinline__ float fast_sigmoid(float x) { return __builtin_amdgcn_rcpf(1.0f + fast_exp(-x)); }
__device__ __forceinline__ float gelu_tanh_f(float y) { const float u = 0.7978845608028654f * (y + 0.044715f * y * y * y); return y * fast_sigmoid(2.0f * u); }

__device__ const unsigned char kBucket[128] = {
 0,1,2,3,4,5,6,7,8,9,10,11,12,13,14,15,
 16,16,16,17,17,18,18,18,19,19,19,20,20,20,20,21,21,21,21,22,22,22,22,22,
 23,23,23,23,23,23,24,24,24,24,24,24,25,25,25,25,25,25,25,26,26,26,26,26,
 26,26,26,27,27,27,27,27,27,27,27,27,27,28,28,28,28,28,28,28,28,28,28,29,
 29,29,29,29,29,29,29,29,29,29,29,30,30,30,30,30,30,30,30,30,30,30,30,30,
 30,31,31,31,31,31,31,31,31,31,31,31,31,31,31,31};

typedef long long i64;
constexpr float SS_SCALE = 16777216.0f, SS_INV = 1.0f / (16777216.0f * 2048.0f);
__device__ __forceinline__ float rstd_of(const i64 v) { return __builtin_amdgcn_rsqf((float)v * SS_INV + EPS); }
__device__ __forceinline__ int lane_id() { return (int)__builtin_amdgcn_mbcnt_hi(~0u, __builtin_amdgcn_mbcnt_lo(~0u, 0u)); }
#define XB_TMO      128
#define XB_XCNT(j)  (256  + 64 * (j))
#define XB_XSUB(j)  (1280 + 64 * (j))
#define XB_XGEN(j)  (2304 + 64 * (j))
#define XB_TOP      3328
#define XB_TOPGEN   3392
#define XCD_BAR_WORDS 3456
#define XB_SPIN_CAP (1u << 22)

__device__ __forceinline__ unsigned xb_ld(unsigned* p)              { return __hip_atomic_load(p, __ATOMIC_RELAXED, __HIP_MEMORY_SCOPE_AGENT); }
__device__ __forceinline__ unsigned xb_add(unsigned* p, unsigned v) { return __hip_atomic_fetch_add(p, v, __ATOMIC_RELAXED, __HIP_MEMORY_SCOPE_AGENT); }
__device__ __forceinline__ unsigned xb_xcc_id() { return (unsigned)__builtin_amdgcn_s_getreg((3 << 11) | 20) & 0xFu; }
#define XB_SPIN(cond, bar) do { unsigned _sp = 0; while (cond) { __builtin_amdgcn_s_sleep(1); \
    if ((++_sp & 255u) == 0u) { if (xb_ld(&(bar)[XB_TMO])) break; if (_sp > XB_SPIN_CAP) { atomicAdd(&(bar)[XB_TMO], 1u); break; } } } } while (0)

struct XcdBarrier { unsigned* bar; unsigned x; volatile LAS unsigned* st; int wave; };

__device__ __forceinline__ XcdBarrier xcd_barrier_post(unsigned* bar, volatile LAS unsigned* st, int wave) {
    XcdBarrier b; b.bar = bar; b.x = xb_xcc_id(); b.st = st; b.wave = wave;
    if (wave == 0 && lane_id() == 0) (void)xb_add(&bar[XB_XCNT(b.x)], 1u);
    return b;
}
__device__ __forceinline__ void xcd_barrier_complete(unsigned* bar, unsigned x, unsigned& nloc, unsigned& nx) {
    const unsigned G = gridDim.x * gridDim.y * gridDim.z;
    unsigned sum, cnt, mine, sp = 0u;
    for (;;) {
        sum = 0u; cnt = 0u; mine = 0u;
#pragma unroll
        for (unsigned j = 0; j < 16; ++j) { const unsigned c = xb_ld(&bar[XB_XCNT(j)]); sum += c; cnt += (c > 0u) ? 1u : 0u; mine = (j == x) ? c : mine; }
        if (sum == G) break;
        __builtin_amdgcn_s_sleep(1);
        if ((++sp & 255u) == 0u) { if (xb_ld(&bar[XB_TMO])) break; if (sp > XB_SPIN_CAP) { atomicAdd(&bar[XB_TMO], 1u); break; } }
    }
    nloc = mine > 0u ? mine : 1u; nx = cnt > 0u ? cnt : 1u;
}
__device__ __forceinline__ void xcd_barrier(const XcdBarrier& b) {
    asm volatile("s_waitcnt vmcnt(0)" ::: "memory");
    __syncthreads();
    int wv = b.wave; asm volatile("" : "+s"(wv));
    if (wv == 0 && lane_id() == 0) {
        unsigned* bar = b.bar; asm volatile("" : "+s"(bar));
        const unsigned bx = xb_xcc_id();
        __builtin_amdgcn_s_waitcnt(0);
        unsigned nloc = b.st[0], nx = b.st[1];
        if (nloc == 0u) { xcd_barrier_complete(bar, bx, nloc, nx); b.st[0] = nloc; b.st[1] = nx; }
        const unsigned old = xb_add(&bar[XB_XSUB(bx)], 1u);
        const unsigned gen = old / nloc;
        if (old + 1u == (gen + 1u) * nloc) {
            __builtin_amdgcn_fence(__ATOMIC_RELEASE, "agent");
            asm volatile("s_waitcnt vmcnt(0)" ::: "memory");
            const unsigned og = xb_add(&bar[XB_TOP], 1u);
            const unsigned tg = og / nx;
            if (og + 1u == (tg + 1u) * nx) xb_add(&bar[XB_TOPGEN], 1u);
            else XB_SPIN(xb_ld(&bar[XB_TOPGEN]) == tg, bar);
            __builtin_amdgcn_fence(__ATOMIC_ACQUIRE, "agent");
            xb_add(&bar[XB_XGEN(bx)], 1u);
            asm volatile("s_waitcnt vmcnt(0)" ::: "memory");
        } else {
            XB_SPIN(xb_ld(&bar[XB_XGEN(bx)]) == gen, bar);
            __builtin_amdgcn_fence(__ATOMIC_ACQUIRE, "agent");
            asm volatile("s_waitcnt vmcnt(0)" ::: "memory");
        }
    }
    __syncthreads();
}

namespace pg8 {
constexpr int BM = 256, BK = 64, HALF = 128, HTB = HALF * BK * 2, STAGE_BYTES = 8 * HTB, NXCD = 8, WGM = 8;
__host__ __device__ __forceinline__ int lds_byte(int r, int c) { const int st = (r >> 4) * 2 + (c >> 5), rr = r & 15, cc = c & 31, ob = rr * 64 + cc * 2; return st * 1024 + (ob ^ (((ob >> 9) & 1) << 5)); }
__host__ __device__ __forceinline__ void stage_rc(int b, int& R, int& C) { const int st = b / 1024, sb = b % 1024, swz = sb ^ (((sb >> 9) & 1) << 5); R = (st >> 1) * 16 + swz / 64; C = (st & 1) * 32 + (swz % 64) / 2; }
__host__ __device__ __forceinline__ int perm32(int rho) { const int n = rho >> 4, i = rho & 15; return 8 * (i >> 2) + 4 * n + (i & 3); }

struct Unit { const char* A; const char* B; char* C; const float* vec; int row0, col0, aux; };

__device__ __forceinline__ void tile_of(int wgid, int nM, int nN, int& pm, int& pn, const int WGM = 8) {
    const int nwg = nM * nN;
    { const int q = nwg / NXCD, r = nwg % NXCD, xcd = wgid % NXCD, off = wgid / NXCD; wgid = (xcd < r ? xcd * (q + 1) : r * (q + 1) + (xcd - r) * q) + off; }
    const int nig = WGM * nN, gid = wgid / nig, fm = gid * WGM, gsz = (nM - fm) < WGM ? (nM - fm) : WGM;
    pm = fm + ((wgid % nig) % gsz); pn = (wgid % nig) / gsz;
}

template <class Epi, class Sched, bool ALIGN_EPI>
__device__ __forceinline__ void gemm_phase(LAS unsigned char* lds, const int wave_, const int lda, const int ldb, const int K, const Sched& S, const Epi& E) {
    int lane_ = lane_id(); asm volatile("" : "+v"(lane_));
    int wv_ = wave_; asm volatile("" : "+s"(wv_));
    const int wid = wv_, lane = lane_, tid = wid * 64 + lane, wr = wid >> 2, wc = wid & 3, fr = lane & 15, fq = lane >> 4;
    const int nt = K / BK;
    unsigned voffA[2], voffB[2];
#pragma unroll
    for (int i = 0; i < 2; ++i) { int R, C; stage_rc(tid * 16 + i * 8192, R, C); const int Rb = (R & ~31) + perm32(R & 31);
        const int Ra = Epi::APERM ? ((R & ~63) + 4 * (R & 15) + ((R >> 4) & 3)) : R;
        voffA[i] = (unsigned)(Ra * lda + C) * 2u; voffB[i] = (unsigned)(Rb * ldb + C) * 2u; }
    const size_t kstep = (size_t)(BK * 2);
    const size_t hsA = (size_t)HALF * lda * 2, hsB = (size_t)HALF * ldb * 2;
    const unsigned ldsw = (unsigned)wid * 1024u;
    const int aoff = lds_byte(wr * 64 + fr, fq * 8), boff = lds_byte(wc * 32 + fr, fq * 8);
#define PG8_SA(b, h) (((b) * 2 + (h)) * HTB)
#define PG8_SB(b, h) ((4 + (b) * 2 + (h)) * HTB)
#define PG8_STAGE(bufoff, gbase, voff) do { _Pragma("unroll") for (int _i = 0; _i < 2; ++_i) \
        __builtin_amdgcn_global_load_lds((const unsigned*)((const char*)(gbase) + (voff)[_i]), (LAS unsigned*)(lds + (bufoff) + ldsw + _i * 8192), 16, 0, 0); } while (0)
#define PG8_LDA(dst, b, h) do { _Pragma("unroll") for (int m = 0; m < 4; ++m) _Pragma("unroll") for (int k = 0; k < 2; ++k) dst[m][k] = *(const LAS bf16x8*)(lds + PG8_SA(b, h) + aoff + m * 2048 + k * 1024); } while (0)
#define PG8_LDB(dst, b, h) do { _Pragma("unroll") for (int n = 0; n < 2; ++n) _Pragma("unroll") for (int k = 0; k < 2; ++k) dst[n][k] = *(const LAS bf16x8*)(lds + PG8_SB(b, h) + boff + n * 2048 + k * 1024); } while (0)
#define PG8_MMA(ai, bj, At, Bt) do { __builtin_amdgcn_s_setprio(1); _Pragma("unroll") for (int m = 0; m < 4; ++m) _Pragma("unroll") for (int n = 0; n < 2; ++n) _Pragma("unroll") for (int k = 0; k < 2; ++k) \
        acc[ai][bj][m][n] = __builtin_amdgcn_mfma_f32_16x16x32_bf16(Bt[n][k], At[m][k], acc[ai][bj][m][n], 0, 0, 0); __builtin_amdgcn_s_setprio(0); } while (0)
#define PG8_WAIT_V(n) asm volatile("s_waitcnt vmcnt(" #n ")" ::: "memory")
#define PG8_WAIT_L(n) asm volatile("s_waitcnt lgkmcnt(" #n ")" ::: "memory")
#define PG8_BAR __builtin_amdgcn_s_barrier()
#define PG8_SCHED __builtin_amdgcn_sched_barrier(0)
    Unit cur, nxt; int ui = 0;
    if (!S.next(0, cur)) return;
    f32x4 acc[2][2][4][2];
    if constexpr (Epi::PRELOAD) E.preload(acc, cur, wr, wc);
    else {
#pragma unroll
    for (int a = 0; a < 2; ++a)
#pragma unroll
        for (int b = 0; b < 2; ++b)
#pragma unroll
            for (int m = 0; m < 4; ++m)
#pragma unroll
                for (int n = 0; n < 2; ++n) acc[a][b][m][n] = (f32x4){0.f, 0.f, 0.f, 0.f};
    }
    bf16x8 At[4][2], B0[2][2], B1[2][2];
    const char* cA = cur.A; const char* cB = cur.B;
#ifndef GEMM_SP2
#define GEMM_SP2 1
#endif
    constexpr bool SP2 = GEMM_SP2;
    if constexpr (SP2) {
    PG8_STAGE(PG8_SB(0, 0), cB, voffB); PG8_STAGE(PG8_SB(0, 1), cB + hsB, voffB); PG8_STAGE(PG8_SA(0, 0), cA, voffA); PG8_STAGE(PG8_SA(0, 1), cA + hsA, voffA);
    if (wr == 1) PG8_BAR;
    PG8_WAIT_V(2); PG8_BAR;
    PG8_STAGE(PG8_SB(1, 0), cB + kstep, voffB); PG8_STAGE(PG8_SA(1, 0), cA + kstep, voffA); PG8_STAGE(PG8_SB(1, 1), cB + hsB + kstep, voffB);
    PG8_WAIT_V(6); PG8_BAR;
    } else {
    PG8_STAGE(PG8_SB(0, 0), cB, voffB); PG8_STAGE(PG8_SA(0, 0), cA, voffA); PG8_STAGE(PG8_SB(0, 1), cB + hsB, voffB); PG8_STAGE(PG8_SA(0, 1), cA + hsA, voffA);
    if (wr == 1) PG8_BAR;
    PG8_WAIT_V(4); PG8_BAR;
    PG8_STAGE(PG8_SB(1, 0), cB + kstep, voffB); PG8_STAGE(PG8_SA(1, 0), cA + kstep, voffA); PG8_STAGE(PG8_SB(1, 1), cB + hsB + kstep, voffB);
    PG8_WAIT_V(6); PG8_BAR;
    }
    for (;;) {
        const bool has_next = S.next(ui + 1, nxt);
        const char* nA = has_next ? nxt.A : cA; const char* nB = has_next ? nxt.B : cB;
#ifndef KLOOP_ALIGN
#define KLOOP_ALIGN 8
#endif
#define PG8_STR2(x) #x
#define PG8_STR(x) PG8_STR2(x)
        asm volatile(".p2align " PG8_STR(KLOOP_ALIGN));
        for (int t = 0; t < nt; t += 2) {
            const bool last = (t == nt - 2);
            const char* a1 = cA + (size_t)(t + 1) * kstep;
            const char* a2 = last ? nA : cA + (size_t)(t + 2) * kstep; const char* b2 = last ? nB : cB + (size_t)(t + 2) * kstep;
            const char* a3 = a2 + kstep; const char* b3 = b2 + kstep;
            if constexpr (SP2) {
            PG8_LDB(B0, 0, 0); PG8_LDB(B1, 0, 1); PG8_SCHED; PG8_LDA(At, 0, 0); PG8_STAGE(PG8_SA(1, 1), a1 + hsA, voffA);
            PG8_WAIT_V(8); PG8_WAIT_L(0); PG8_BAR; PG8_MMA(0, 0, At, B0); PG8_MMA(0, 1, At, B1); PG8_BAR; PG8_SCHED;
            PG8_LDA(At, 0, 1); PG8_STAGE(PG8_SB(0, 0), b2, voffB); PG8_STAGE(PG8_SB(0, 1), b2 + hsB, voffB); PG8_STAGE(PG8_SA(0, 0), a2, voffA);
            PG8_WAIT_V(8); PG8_WAIT_L(0); PG8_BAR; PG8_MMA(1, 0, At, B0); PG8_MMA(1, 1, At, B1); PG8_BAR; PG8_SCHED;
            PG8_LDB(B0, 1, 0); PG8_LDB(B1, 1, 1); PG8_SCHED; PG8_LDA(At, 1, 0); PG8_STAGE(PG8_SA(0, 1), a2 + hsA, voffA);
            PG8_WAIT_V(8); PG8_WAIT_L(0); PG8_BAR; PG8_MMA(0, 0, At, B0); PG8_MMA(0, 1, At, B1); PG8_BAR; PG8_SCHED;
            PG8_LDA(At, 1, 1); PG8_STAGE(PG8_SB(1, 0), b3, voffB); PG8_STAGE(PG8_SB(1, 1), b3 + hsB, voffB); PG8_STAGE(PG8_SA(1, 0), a3, voffA);
            PG8_WAIT_V(8); PG8_WAIT_L(0); PG8_BAR; PG8_MMA(1, 0, At, B0); PG8_MMA(1, 1, At, B1); PG8_BAR; PG8_SCHED;
            } else {
            PG8_LDB(B0, 0, 0); PG8_SCHED; PG8_LDA(At, 0, 0); PG8_STAGE(PG8_SA(1, 1), a1 + hsA, voffA);
            PG8_WAIT_L(8); PG8_BAR; PG8_WAIT_L(0); PG8_MMA(0, 0, At, B0); PG8_BAR; PG8_SCHED;
            PG8_LDB(B1, 0, 1); PG8_STAGE(PG8_SB(0, 0), b2, voffB);
            PG8_BAR; PG8_WAIT_L(0); PG8_MMA(0, 1, At, B1); PG8_BAR;
            PG8_LDA(At, 0, 1); PG8_STAGE(PG8_SA(0, 0), a2, voffA);
            PG8_BAR; PG8_WAIT_L(0); PG8_MMA(1, 0, At, B0); PG8_BAR; PG8_SCHED;
            PG8_STAGE(PG8_SB(0, 1), b2 + hsB, voffB);
            PG8_WAIT_V(6); PG8_BAR; PG8_MMA(1, 1, At, B1); PG8_BAR;
            PG8_LDB(B0, 1, 0); PG8_SCHED; PG8_LDA(At, 1, 0); PG8_STAGE(PG8_SA(0, 1), a2 + hsA, voffA);
            PG8_WAIT_L(8); PG8_BAR; PG8_WAIT_L(0); PG8_MMA(0, 0, At, B0); PG8_BAR; PG8_SCHED;
            PG8_LDB(B1, 1, 1); PG8_STAGE(PG8_SB(1, 0), b3, voffB);
            PG8_BAR; PG8_WAIT_L(0); PG8_MMA(0, 1, At, B1); PG8_BAR;
            PG8_LDA(At, 1, 1); PG8_STAGE(PG8_SA(1, 0), a3, voffA);
            PG8_BAR; PG8_WAIT_L(0); PG8_MMA(1, 0, At, B0); PG8_BAR; PG8_SCHED;
            PG8_STAGE(PG8_SB(1, 1), b3 + hsB, voffB);
            PG8_WAIT_V(6); PG8_BAR; PG8_MMA(1, 1, At, B1); PG8_BAR;
            }
        }
        if constexpr (ALIGN_EPI) { if (wr == 0) PG8_BAR; }
        if constexpr (Epi::FUSEDPRE) { Unit pu = cur; if (has_next) pu = nxt; E.epi_pre(acc, cur, pu, has_next, wr, wc); if (!has_next) break; }
        else {
        if constexpr (!Epi::AFTER_DRAIN) { E(acc, cur, wr, wc, fr, fq); }
        if (!has_next) break;
        }
        if constexpr (Epi::FUSEDPRE) {}
        else if constexpr (Epi::PRELOAD) E.preload(acc, nxt, wr, wc);
        else {
#pragma unroll
        for (int a = 0; a < 2; ++a)
#pragma unroll
            for (int b = 0; b < 2; ++b)
#pragma unroll
                for (int m = 0; m < 4; ++m)
#pragma unroll
                    for (int n = 0; n < 2; ++n) acc[a][b][m][n] = (f32x4){0.f, 0.f, 0.f, 0.f};
        }
        cur = nxt; cA = nA; cB = nB; ++ui;
        if constexpr (ALIGN_EPI) { if (wr == 1) PG8_BAR; }
    }
    PG8_WAIT_V(0);
    if constexpr (!ALIGN_EPI) { if (wr == 0) PG8_BAR; }
    PG8_BAR;
    if constexpr (Epi::AFTER_DRAIN) { E.fused(acc, cur, wr, wc, fr, fq, lds, wid, lane); }
#undef PG8_SA
#undef PG8_SB
#undef PG8_STAGE
#undef PG8_LDA
#undef PG8_LDB
#undef PG8_MMA
#undef PG8_WAIT_V
#undef PG8_WAIT_L
#undef PG8_BAR
#undef PG8_SCHED
}
}
#ifndef DEF_WGM
#define DEF_WGM 4
#endif
namespace pg8 {
struct SchedMain {
    const char* A; const char* B; char* C; size_t tA, tB, bB, tC, cC; int nM, nN, bdiv, ccols, G, c, wgm = DEF_WGM;
    __device__ __forceinline__ bool next(int i, Unit& u) const {
        const long Lx = (long)i * G + c; if (Lx >= (long)nM * nN) return false;
        int pm, pn; tile_of((int)Lx, nM, nN, pm, pn, wgm);
        u.A = A + (size_t)pm * tA; u.B = B + (size_t)pn * tB + (size_t)(pm / bdiv) * bB; u.C = C + (size_t)pm * tC + (size_t)pn * cC;
        u.row0 = pm * BM; u.col0 = pn * ccols; u.aux = i; u.vec = nullptr; return true;
    }
};

struct EpiRowScale {
    static constexpr bool AFTER_DRAIN = false, PRELOAD = false, APERM = false, FUSEDPRE = false;
    const i64* ss; const float* bias; int ldc;
    __device__ __forceinline__ void operator()(f32x4 (&acc)[2][2][4][2], const Unit& u, int wr, int wc, int fr_, int fq_) const {
        int lane_ = lane_id(); asm volatile("" : "+v"(lane_)); const int fr = lane_ & 15, fq = lane_ >> 4; (void)fr_; (void)fq_;
        const int colw = wc * 32 + 8 * fq; const unsigned loff = (unsigned)((wr * 64 + fr) * ldc + colw) * 2u; const unsigned soff = (unsigned)(wr * 64 + fr) * 8u;
        i64 sv[2][4];
#pragma unroll
        for (int ai = 0; ai < 2; ++ai)
#pragma unroll
            for (int m = 0; m < 4; ++m) sv[ai][m] = *(const i64*)((const char*)(ss + u.row0 + ai * HALF + m * 16) + soff);
        f32x4 bv[2][2];
#pragma unroll
        for (int bj = 0; bj < 2; ++bj)
#pragma unroll
            for (int n = 0; n < 2; ++n) bv[bj][n] = bias ? *(const f32x4*)(bias + u.col0 + colw + bj * HALF + 4 * n) : (f32x4){0.f, 0.f, 0.f, 0.f};
#pragma unroll
        for (int ai = 0; ai < 2; ++ai)
#pragma unroll
            for (int m = 0; m < 4; ++m) {
                const int rb = ai * HALF + m * 16;
                const float rs = rstd_of(sv[ai][m]);
                char* rowp = u.C + (size_t)rb * ldc * 2 + loff;
#pragma unroll
                for (int bj = 0; bj < 2; ++bj) {
                    const f32x4 v0 = acc[ai][bj][m][0] * rs + bv[bj][0], v1 = acc[ai][bj][m][1] * rs + bv[bj][1];
                    u32x4 w; w.x = cvt_pk_bf16(v0[0], v0[1]); w.y = cvt_pk_bf16(v0[2], v0[3]); w.z = cvt_pk_bf16(v1[0], v1[1]); w.w = cvt_pk_bf16(v1[2], v1[3]);
                    *(u32x4*)(rowp + bj * HALF * 2) = w;
                }
            }
    }
};

struct EpiPlain {
    static constexpr bool AFTER_DRAIN = false, PRELOAD = false, APERM = false, FUSEDPRE = false;
    __device__ __forceinline__ void operator()(f32x4 (&acc)[2][2][4][2], const Unit& u, int wr, int wc, int fr_, int fq_) const {
        int lane_ = lane_id(); asm volatile("" : "+v"(lane_)); const int fr = lane_ & 15, fq = lane_ >> 4; (void)fr_; (void)fq_;
        const int colw = wc * 32 + 8 * fq, ldc = u.aux; const float* cs = (const float*)u.vec; const unsigned loff = (unsigned)((wr * 64 + fr) * ldc + colw) * 2u;
        f32x4 sv[2][2];
#pragma unroll
        for (int bj = 0; bj < 2; ++bj)
#pragma unroll
            for (int n = 0; n < 2; ++n) sv[bj][n] = cs ? *(const f32x4*)(cs + u.col0 + colw + bj * HALF + 4 * n) : (f32x4){1.f, 1.f, 1.f, 1.f};
#pragma unroll
        for (int ai = 0; ai < 2; ++ai)
#pragma unroll
            for (int m = 0; m < 4; ++m) {
                char* rowp = u.C + (size_t)(ai * HALF + m * 16) * ldc * 2 + loff;
#pragma unroll
                for (int bj = 0; bj < 2; ++bj) {
                    const f32x4 v0 = acc[ai][bj][m][0] * sv[bj][0], v1 = acc[ai][bj][m][1] * sv[bj][1];
                    u32x4 w; w.x = cvt_pk_bf16(v0[0], v0[1]); w.y = cvt_pk_bf16(v0[2], v0[3]); w.z = cvt_pk_bf16(v1[0], v1[1]); w.w = cvt_pk_bf16(v1[2], v1[3]);
                    *(u32x4*)(rowp + bj * HALF * 2) = w;
                }
            }
    }
};

struct EpiRes {
    static constexpr bool AFTER_DRAIN = false, PRELOAD = true, APERM = false, FUSEDPRE = true;
    bf16_t* hb; bf16_t* hbo; i64* ssout; LAS unsigned char* lds_spare;
    __device__ __forceinline__ void preload(f32x4 (&acc)[2][2][4][2], const Unit& u, int wr, int wc) const {
        int lane_ = lane_id(); asm volatile("" : "+v"(lane_)); const int fr = lane_ & 15, fq = lane_ >> 4;
        const unsigned l2 = (unsigned)((wr * 64 + fr) * D + wc * 32 + 8 * fq) * 2u;
#pragma unroll
        for (int ai = 0; ai < 2; ++ai)
#pragma unroll
            for (int m = 0; m < 4; ++m) { const char* pin = (const char*)(hb + (size_t)(u.row0 + ai * HALF + m * 16) * D + u.col0) + l2;
#pragma unroll
                for (int bj = 0; bj < 2; ++bj) { const u32x4 w = *(const u32x4*)(pin + bj * HALF * 2);
                    acc[ai][bj][m][0] = (f32x4){bf_lo(w.x), bf_hi(w.x), bf_lo(w.y), bf_hi(w.y)}; acc[ai][bj][m][1] = (f32x4){bf_lo(w.z), bf_hi(w.z), bf_lo(w.w), bf_hi(w.w)}; } }
    }
    __device__ __forceinline__ void operator()(f32x4 (&)[2][2][4][2], const Unit&, int, int, int, int) const {}
    __device__ __forceinline__ void epi_pre(f32x4 (&acc)[2][2][4][2], const Unit& u, const Unit& nu, const bool has_next, int wr, int wc) const {
        int lane_ = lane_id(); asm volatile("" : "+v"(lane_)); const int fr = lane_ & 15, fq = lane_ >> 4;
        const unsigned l2 = (unsigned)((wr * 64 + fr) * D + wc * 32 + 8 * fq) * 2u;
        LAS float* T = (LAS float*)(lds_spare);
        u32x4 raw[2][4][2];
        if (has_next) {
#pragma unroll
        for (int ai = 0; ai < 2; ++ai)
#pragma unroll
            for (int m = 0; m < 4; ++m) { const char* pin = (const char*)(hb + (size_t)(nu.row0 + ai * HALF + m * 16) * D + nu.col0) + l2;
                asm volatile("global_load_dwordx4 %0, %2, off\n\tglobal_load_dwordx4 %1, %2, off offset:256" : "=&v"(raw[ai][m][0]), "=&v"(raw[ai][m][1]) : "v"(pin) : "memory"); }
        }
#pragma unroll
        for (int ai = 0; ai < 2; ++ai)
#pragma unroll
            for (int m = 0; m < 4; ++m) {
                char* pb = (char*)(hbo + (size_t)(u.row0 + ai * HALF + m * 16) * D + u.col0) + l2;
                float s = 0.f;
#pragma unroll
                for (int bj = 0; bj < 2; ++bj) {
                    const f32x4 o0 = acc[ai][bj][m][0], o1 = acc[ai][bj][m][1];
                    u32x4 w; w.x = cvt_pk_bf16(o0[0], o0[1]); w.y = cvt_pk_bf16(o0[2], o0[3]); w.z = cvt_pk_bf16(o1[0], o1[1]); w.w = cvt_pk_bf16(o1[2], o1[3]);
                    *(u32x4*)(pb + bj * HALF * 2) = w;
                    s += (o0[0] * o0[0] + o0[1] * o0[1]) + (o0[2] * o0[2] + o0[3] * o0[3]) + (o1[0] * o1[0] + o1[1] * o1[1]) + (o1[2] * o1[2] + o1[3] * o1[3]);
                }
                s += shx(s, 16, lane_); s += shx(s, 32, lane_);
                if (fq == 0) T[(ai * HALF + wr * 64 + m * 16 + fr) * 4 + wc] = s;
            }
        asm volatile("s_waitcnt lgkmcnt(0)" ::: "memory"); __builtin_amdgcn_s_barrier(); asm volatile("" ::: "memory");
        if (lane_ < 32) { const int row = (wr * 4 + wc) * 32 + lane_; const f32x4 p = *(const LAS f32x4*)(T + row * 4);
            __hip_atomic_fetch_add(ssout + u.row0 + row, (i64)(((p[0] + p[1]) + (p[2] + p[3])) * SS_SCALE), __ATOMIC_RELAXED, __HIP_MEMORY_SCOPE_AGENT); }
        if (!has_next) return;
        asm volatile("s_waitcnt vmcnt(16)" : "+v"(raw[0][0][0]), "+v"(raw[0][0][1]), "+v"(raw[0][1][0]), "+v"(raw[0][1][1]), "+v"(raw[0][2][0]), "+v"(raw[0][2][1]), "+v"(raw[0][3][0]), "+v"(raw[0][3][1]),
                                           "+v"(raw[1][0][0]), "+v"(raw[1][0][1]), "+v"(raw[1][1][0]), "+v"(raw[1][1][1]), "+v"(raw[1][2][0]), "+v"(raw[1][2][1]), "+v"(raw[1][3][0]), "+v"(raw[1][3][1]) :: "memory");
#pragma unroll
        for (int ai = 0; ai < 2; ++ai)
#pragma unroll
            for (int m = 0; m < 4; ++m)
#pragma unroll
                for (int bj = 0; bj < 2; ++bj) { const u32x4 w = raw[ai][m][bj];
                    acc[ai][bj][m][0] = (f32x4){bf_lo(w.x), bf_hi(w.x), bf_lo(w.y), bf_hi(w.y)}; acc[ai][bj][m][1] = (f32x4){bf_lo(w.z), bf_hi(w.z), bf_lo(w.w), bf_hi(w.w)}; }
    }
};

struct EpiSoftmax {
    static constexpr bool AFTER_DRAIN = true, PRELOAD = false, APERM = false, FUSEDPRE = false;
    const i64* ss; int ldc;
    __device__ __forceinline__ void operator()(f32x4 (&)[2][2][4][2], const Unit&, int, int, int, int) const {}
    __device__ __forceinline__ void fused(f32x4 (&acc)[2][2][4][2], const Unit& u, int wr, int wc, int fr_, int fq_, LAS unsigned char* lds, int wid, int lane) const {
        int lane_ = lane_id(); asm volatile("" : "+v"(lane_)); const int fr = lane_ & 15, fq = lane_ >> 4; (void)fr_; (void)fq_;
        LAS f32x2* T = (LAS f32x2*)lds;
        const unsigned loff = (unsigned)((wr * 64 + fr) * ldc + wc * 32 + 8 * fq) * 2u, soff = (unsigned)(wr * 64 + fr) * 8u;
        float mown[2][4]; i64 sv[2][4];
#pragma unroll
        for (int ai = 0; ai < 2; ++ai)
#pragma unroll
            for (int m = 0; m < 4; ++m) sv[ai][m] = *(const i64*)((const char*)(ss + u.row0 + ai * HALF + m * 16) + soff);
#pragma unroll
        for (int ai = 0; ai < 2; ++ai)
#pragma unroll
            for (int m = 0; m < 4; ++m) {
                const int r = ai * HALF + wr * 64 + m * 16 + fr;
                const float rs = rstd_of(sv[ai][m]);
                float mx = -3.0e38f;
#pragma unroll
                for (int bj = 0; bj < 2; ++bj)
#pragma unroll
                    for (int n = 0; n < 2; ++n) { f32x4 v = acc[ai][bj][m][n] * rs; acc[ai][bj][m][n] = v; mx = fmaxf(fmaxf(mx, fmaxf(v[0], v[1])), fmaxf(v[2], v[3])); }
                mx = fmaxf(mx, shx(mx, 16, lane_)); mx = fmaxf(mx, shx(mx, 32, lane_));
                float l = 0.f;
#pragma unroll
                for (int bj = 0; bj < 2; ++bj)
#pragma unroll
                    for (int n = 0; n < 2; ++n) { f32x4 v = acc[ai][bj][m][n]; v[0] = fast_exp(v[0] - mx); v[1] = fast_exp(v[1] - mx); v[2] = fast_exp(v[2] - mx); v[3] = fast_exp(v[3] - mx); acc[ai][bj][m][n] = v; l += (v[0] + v[1]) + (v[2] + v[3]); }
                l += shx(l, 16, lane_); l += shx(l, 32, lane_);
                mown[ai][m] = mx;
                if (fq == 0) T[r * 4 + wc] = (f32x2){mx, l};
            }
        asm volatile("s_waitcnt lgkmcnt(0)" ::: "memory"); __builtin_amdgcn_s_barrier(); asm volatile("" ::: "memory");
#pragma unroll
        for (int ai = 0; ai < 2; ++ai)
#pragma unroll
            for (int m = 0; m < 4; ++m) {
                const int r = ai * HALF + wr * 64 + m * 16 + fr;
                const f32x2 a = T[r * 4 + 0], b = T[r * 4 + 1], c = T[r * 4 + 2], d = T[r * 4 + 3];
                const float Mx = fmaxf(fmaxf(a.x, b.x), fmaxf(c.x, d.x));
                const float Ls = a.y * fast_exp(a.x - Mx) + b.y * fast_exp(b.x - Mx) + c.y * fast_exp(c.x - Mx) + d.y * fast_exp(d.x - Mx);
                const float f = fast_exp(mown[ai][m] - Mx) * __builtin_amdgcn_rcpf(Ls);
                char* rowp = u.C + (size_t)(ai * HALF + m * 16) * ldc * 2 + loff;
#pragma unroll
                for (int bj = 0; bj < 2; ++bj) {
                    const f32x4 v0 = acc[ai][bj][m][0] * f, v1 = acc[ai][bj][m][1] * f;
                    u32x4 w; w.x = cvt_pk_bf16(v0[0], v0[1]); w.y = cvt_pk_bf16(v0[2], v0[3]); w.z = cvt_pk_bf16(v1[0], v1[1]); w.w = cvt_pk_bf16(v1[2], v1[3]);
                    *(u32x4*)(rowp + bj * HALF * 2) = w;
                }
            }
    }
};

__device__ __forceinline__ float dpp_shr1z(float x) { return __builtin_bit_cast(float, __builtin_amdgcn_update_dpp(0, __builtin_bit_cast(int, x), 0x111  , 0xf, 0xf, true)); }
struct EpiMLP {
    static constexpr bool AFTER_DRAIN = false, PRELOAD = false, APERM = true, FUSEDPRE = false;
    LAS unsigned char* lds; float* halo_g; float* halo_u;
    __device__ __forceinline__ void operator()(f32x4 (&acc)[2][2][4][2], const Unit& u, int wr, int wc, int fr_, int fq_) const {
        int lane_ = lane_id(); asm volatile("" : "+v"(lane_)); const int fr = lane_ & 15, fq = lane_ >> 4; (void)fr_; (void)fq_;
        const int colw = wc * 32 + 8 * fq, ch0 = u.col0 + colw;
        const unsigned loff = (unsigned)((wr * 64 + 4 * fr) * DFF + colw) * 2u;
        const float LN2 = 0.6931471805599453f;
        const LAS float* cwt = (const LAS float*)(lds + F1_CWT_OFF) + u.aux * 512 + colw;
        const int slot = *(const LAS int*)(lds + F1_SLOT_OFF + u.aux * 4);
        const LAS float* rst = (const LAS float*)(lds + F1_RST_OFF) + slot * 256 + wr * 64 + 4 * fr;
        f32x4 w0[2], w1[2], w2[2], bb[2];
#pragma unroll
        for (int n = 0; n < 2; ++n) { w0[n] = *(const LAS f32x4*)(cwt + 4 * n); w1[n] = *(const LAS f32x4*)(cwt + 128 + 4 * n); w2[n] = *(const LAS f32x4*)(cwt + 256 + 4 * n); bb[n] = *(const LAS f32x4*)(cwt + 384 + 4 * n); }
#pragma unroll
        for (int ai = 0; ai < 2; ++ai) {
            const int rb = u.row0 + ai * HALF + wr * 64, blk = rb >> 6;
            const f32x4 rsv = *(const LAS f32x4*)(rst + ai * HALF);
            float rs[4], irsu[4];
#pragma unroll
            for (int m = 0; m < 4; ++m) { rs[m] = rsv[m]; irsu[m] = __builtin_amdgcn_rcpf(rs[m] * LN2); }
#pragma unroll
            for (int n = 0; n < 2; ++n) {
                f32x4 g[4];
#pragma unroll
                for (int m = 0; m < 4; ++m) g[m] = acc[ai][0][m][n] * rs[m];
                if (fr == 15) { *(f32x4*)(halo_g + ((size_t)blk * 4 + 0) * DFF + ch0 + 4 * n) = g[2]; *(f32x4*)(halo_g + ((size_t)blk * 4 + 1) * DFF + ch0 + 4 * n) = g[3]; }
                if (fr == 0) { *(f32x4*)(halo_g + ((size_t)blk * 4 + 2) * DFF + ch0 + 4 * n) = g[0]; *(f32x4*)(halo_g + ((size_t)blk * 4 + 3) * DFF + ch0 + 4 * n) = g[1];
                               *(f32x4*)(halo_u + ((size_t)blk * 2 + 0) * DFF + ch0 + 4 * n) = acc[ai][1][0][n] * rs[0]; *(f32x4*)(halo_u + ((size_t)blk * 2 + 1) * DFF + ch0 + 4 * n) = acc[ai][1][1][n] * rs[1]; }
                f32x4 pre[4];
#pragma unroll
                for (int j = 0; j < 4; ++j) {
                    const float s3 = dpp_shr1z(g[3][j]), s2 = dpp_shr1z(g[2][j]);
                    pre[0][j] = __builtin_fmaf(w2[n][j], g[0][j], __builtin_fmaf(w1[n][j], s3, __builtin_fmaf(w0[n][j], s2, bb[n][j])));
                    pre[1][j] = __builtin_fmaf(w2[n][j], g[1][j], __builtin_fmaf(w1[n][j], g[0][j], __builtin_fmaf(w0[n][j], s3, bb[n][j])));
                    pre[2][j] = __builtin_fmaf(w2[n][j], g[2][j], __builtin_fmaf(w1[n][j], g[1][j], __builtin_fmaf(w0[n][j], g[0][j], bb[n][j])));
                    pre[3][j] = __builtin_fmaf(w2[n][j], g[3][j], __builtin_fmaf(w1[n][j], g[2][j], __builtin_fmaf(w0[n][j], g[1][j], bb[n][j])));
                }
#pragma unroll
                for (int m = 0; m < 4; ++m) {
                    f32x4 a;
#pragma unroll
                    for (int j = 0; j < 4; ++j) { const float p = pre[m][j]; a[j] = (p * acc[ai][1][m][n][j]) * __builtin_amdgcn_rcpf(__builtin_fmaf(__builtin_amdgcn_exp2f(-p), irsu[m], irsu[m])); }
                    acc[ai][0][m][n] = a;
                }
            }
#pragma unroll
            for (int m = 0; m < 4; ++m) {
                const f32x4 v0 = acc[ai][0][m][0], v1 = acc[ai][0][m][1];
                u32x4 w; w.x = cvt_pk_bf16(v0[0], v0[1]); w.y = cvt_pk_bf16(v0[2], v0[3]); w.z = cvt_pk_bf16(v1[0], v1[1]); w.w = cvt_pk_bf16(v1[2], v1[3]);
                *(u32x4*)(u.C + (size_t)(ai * HALF + m) * DFF * 2 + loff) = w;
            }
        }
    }
};
struct EpiEven {
    static constexpr bool AFTER_DRAIN = false, PRELOAD = false, APERM = true, FUSEDPRE = false;
    const i64* ss; const float* cw; bf16_t* YY; bf16_t* UB; float* HV; float* HGB;
    __device__ __forceinline__ void operator()(f32x4 (&acc)[2][2][4][2], const Unit& u, int wr, int wc, int fr_, int fq_) const {
        int lane_ = lane_id(); asm volatile("" : "+v"(lane_)); const int fr = lane_ & 15, fq = lane_ >> 4; (void)fr_; (void)fq_;
        const int ch = u.col0 + 16 * wc + 4 * fq, g = (u.col0 >> 4) + wc;
        const unsigned soff = (unsigned)(wr * 64 + 4 * fr) * 8u;
        i64 sv[2][4];
#pragma unroll
        for (int ai = 0; ai < 2; ++ai)
#pragma unroll
            for (int m = 0; m < 4; ++m) sv[ai][m] = *(const i64*)((const char*)(ss + u.row0 + ai * HALF + m) + soff);
        const f32x4 w0 = *(const f32x4*)(cw + ch), w1 = *(const f32x4*)(cw + AW + ch), w2 = *(const f32x4*)(cw + 2 * AW + ch);
#pragma unroll
        for (int ai = 0; ai < 2; ++ai) {
            const int rb = u.row0 + ai * HALF + wr * 64, blk = rb >> 6;
            f32x4 gb[4], v[4], y[4];
#pragma unroll
            for (int m = 0; m < 4; ++m) { const float rs = rstd_of(sv[ai][m]); gb[m] = acc[ai][0][m][0] * rs; v[m] = (acc[ai][0][m][1] * rs) * (acc[ai][1][m][0] * rs); acc[ai][1][m][1] = acc[ai][1][m][1] * rs; }
            if (fr == 15) { *(f32x4*)(HV + ((size_t)blk * 4 + 0) * AW + ch) = v[2]; *(f32x4*)(HV + ((size_t)blk * 4 + 1) * AW + ch) = v[3]; }
            if (fr == 0) { *(f32x4*)(HV + ((size_t)blk * 4 + 2) * AW + ch) = v[0]; *(f32x4*)(HV + ((size_t)blk * 4 + 3) * AW + ch) = v[1];
                           *(f32x4*)(HGB + ((size_t)blk * 2 + 0) * AW + ch) = gb[0]; *(f32x4*)(HGB + ((size_t)blk * 2 + 1) * AW + ch) = gb[1]; }
#pragma unroll
            for (int j = 0; j < 4; ++j) {
                const float s3 = dpp_shr1z(v[3][j]), s2 = dpp_shr1z(v[2][j]);
                y[0][j] = w2[j] * v[0][j] + w1[j] * s3 + w0[j] * s2;
                y[1][j] = w2[j] * v[1][j] + w1[j] * v[0][j] + w0[j] * s3;
                y[2][j] = w2[j] * v[2][j] + w1[j] * v[1][j] + w0[j] * v[0][j];
                y[3][j] = w2[j] * v[3][j] + w1[j] * v[2][j] + w0[j] * v[1][j];
            }
#pragma unroll
            for (int m = 0; m < 4; ++m) {
                const size_t row = (size_t)(rb + 4 * fr + m);
                const f32x4 a = gb[m] * y[m], uu = acc[ai][1][m][1];
                u32x2 wa; wa.x = cvt_pk_bf16(a[0], a[1]); wa.y = cvt_pk_bf16(a[2], a[3]);
                u32x2 wu; wu.x = cvt_pk_bf16(uu[0], uu[1]); wu.y = cvt_pk_bf16(uu[2], uu[3]);
                *(u32x2*)(YY + row * D + ch) = wa;
                *(u32x2*)(UB + ((size_t)g * M + row) * 16 + 4 * fq) = wu;
            }
        }
    }
};
struct EpiNull { static constexpr bool AFTER_DRAIN = false, PRELOAD = false, APERM = false, FUSEDPRE = false;
    __device__ __forceinline__ void operator()(f32x4 (&acc)[2][2][4][2], const Unit& u, int, int, int fr, int) const {
        f32x4 s = (f32x4){0.f, 0.f, 0.f, 0.f};
#pragma unroll
        for (int a = 0; a < 2; ++a)
#pragma unroll
            for (int b = 0; b < 2; ++b)
#pragma unroll
                for (int m = 0; m < 4; ++m)
#pragma unroll
                    for (int n = 0; n < 2; ++n) s += acc[a][b][m][n];
        if (s[0] + s[1] + s[2] + s[3] == 1.2345e-30f && fr == 7) *(float*)u.C = 0.f; } };
}
struct Args { const float* in[32]; float* out; unsigned char* ws; };

struct Frame {
    LAS unsigned char* lds;
    int wave, G, bid;
    int gw, ngw;
    int ngt;
};
#define PHASE_TID(F, tid, lane, gt) int lane = lane_id(); asm volatile("" : "+v"(lane)); const int tid = (F).wave * 64 + lane; const int gt = (F).bid * NTHR + tid; (void)tid; (void)gt


struct MatDesc { const float* W; const float* gk; bf16_t* WT; int K, N, rs, roff, nsplit; float nsc; int transpose, rmode; };
__device__ __forceinline__ int even_row(int ng) { const int part = ng >> 10, ch = ng & 1023, pn = ch >> 6, r = ch & 63; return 256 * pn + 128 * (part >> 1) + 32 * (r >> 4) + 8 * ((r >> 2) & 3) + 4 * (part & 1) + (r & 3); }
__device__ __forceinline__ void tr_load(const MatDesc& d, int item, int lane, f32x4 (&v)[16], float (&gs)[16]) {
    const int nblk = d.N / 64, kb = item / nblk, nb = item % nblk, k0 = 64 * kb, n0 = 64 * nb;
    const unsigned voff = (unsigned)((lane >> 4) * d.N + (lane & 15) * 4) * 4u;
    const char* sbase = (const char*)(d.W + (size_t)k0 * d.N + n0);
#pragma unroll
    for (int i = 0; i < 16; ++i) v[i] = __builtin_nontemporal_load((const f32x4*)(sbase + (size_t)(4 * i) * d.N * 4 + voff));
    if (d.gk) {
#pragma unroll
        for (int i = 0; i < 16; ++i) gs[i] = d.gk[k0 + 4 * i + (lane >> 4)];
    } else {
#pragma unroll
        for (int i = 0; i < 16; ++i) gs[i] = 1.0f;
    }
}
__device__ __forceinline__ void tr_store(const MatDesc& d, LAS float* scr, int item, int lane, const f32x4 (&v)[16], const float (&gs)[16]) {
    const int nblk = d.N / 64, kb = item / nblk, nb = item % nblk, k0 = 64 * kb, n0 = 64 * nb;
    LAS float* wp = scr + (lane >> 4) * 65 + (lane & 15) * 4;
#pragma unroll
    for (int i = 0; i < 16; ++i) { const f32x4 x = v[i] * gs[i];
        wp[(4 * i) * 65 + 0] = x[0]; wp[(4 * i) * 65 + 1] = x[1]; wp[(4 * i) * 65 + 2] = x[2]; wp[(4 * i) * 65 + 3] = x[3]; }
    LDS_WAIT(); asm volatile("" ::: "memory");
    const int c = lane & 7;
#pragma unroll
    for (int j = 0; j < 8; ++j) { const int n = (lane >> 3) + 8 * j, ng = n0 + n; const LAS float* s = scr + (8 * c) * 65 + n;
        const float sc = (ng < d.nsplit) ? d.nsc : 1.0f;
        u32x4 o; o.x = cvt_pk_bf16(s[0 * 65] * sc, s[1 * 65] * sc); o.y = cvt_pk_bf16(s[2 * 65] * sc, s[3 * 65] * sc); o.z = cvt_pk_bf16(s[4 * 65] * sc, s[5 * 65] * sc); o.w = cvt_pk_bf16(s[6 * 65] * sc, s[7 * 65] * sc);
        const int drow = d.rmode ? even_row(ng) : (ng / 128) * d.rs + d.roff + (ng % 128);
        __builtin_nontemporal_store(o, (u32x4*)(d.WT + (size_t)drow * d.K + k0 + 8 * c)); }
    LDS_WAIT(); asm volatile("" ::: "memory");
}
__device__ __forceinline__ void get_mat(const Args& a, int id, MatDesc& d) {
    unsigned char* ws = a.ws;
    d.gk = nullptr; d.rs = 128; d.roff = 0; d.nsplit = 0; d.nsc = 1.f; d.transpose = 1; d.rmode = 0; d.K = D; d.N = D;
    if (id < 2)       { const int i = id;      d.W = a.in[8] + (size_t)i * D * EVEN_IN; d.N = EVEN_IN; d.rmode = 1; d.gk = a.in[2] + (2 * i) * D; d.WT = (bf16_t*)(ws + WS_WIN_T) + (size_t)i * EVEN_IN * D; }
    else if (id < 4)  { const int i = id - 2;  d.W = a.in[19] + (size_t)i * D * D; d.WT = (bf16_t*)(ws + WS_EWOUT_T) + (size_t)i * D * D; }
    else if (id < 6)  { const int i = id - 4;  d.W = a.in[20] + (size_t)i * D * ODD_IN; d.N = ODD_IN; d.gk = a.in[2] + (2 * i + 1) * D; d.nsplit = NQH * HD; d.nsc = 0.125f; d.WT = (bf16_t*)(ws + WS_WQKV_T) + (size_t)i * ODD_IN * D; }
    else if (id < 8)  { const int i = id - 6;  d.W = a.in[23] + (size_t)i * D * D; d.WT = (bf16_t*)(ws + WS_OWOUT_T) + (size_t)i * D * D; }
    else if (id < 12) { const int l = id - 8;  d.W = a.in[25] + (size_t)l * D * 2 * D; d.N = 2 * D; d.WT = (bf16_t*)(ws + WS_WKV_T) + (size_t)l * 2 * D * D; }
    else if (id < 16) { const int l = id - 12; d.W = a.in[26] + (size_t)l * D * D; d.WT = (bf16_t*)(ws + WS_WO_T) + (size_t)l * D * D; }
    else if (id < 20) { const int l = id - 16; d.W = a.in[27] + (size_t)l * D * DFF; d.N = DFF; d.gk = a.in[4] + l * D; d.rs = 256; d.WT = (bf16_t*)(ws + WS_WGU_T) + (size_t)l * NGU * D; }
    else if (id < 24) { const int l = id - 20; d.W = a.in[28] + (size_t)l * D * DFF; d.N = DFF; d.gk = a.in[4] + l * D; d.rs = 256; d.roff = 128; d.WT = (bf16_t*)(ws + WS_WGU_T) + (size_t)l * NGU * D; }
    else if (id < 28) { const int l = id - 24; d.W = a.in[31] + (size_t)l * DFF * D; d.K = DFF; d.WT = (bf16_t*)(ws + WS_WDOWN_T) + (size_t)l * D * DFF; }
    else              { const int l = id - 28; d.W = a.in[24] + (size_t)l * D * D; d.transpose = 0; d.WT = (bf16_t*)(ws + WS_WQ_BF) + (size_t)l * D * D; }
}

__device__ __forceinline__ void p0_prologue(const Args& a, Frame& F) {
    unsigned char* ws = a.ws;
    PHASE_TID(F, tid, lane, gt);
    LAS float* scr = (LAS float*)(F.lds + F.wave * 16640);
    if (F.wave == 7) { float* sp = (float*)(ws + WS_S5P);
      for (int i = F.bid + F.G * lane; i < 2 * 64 * 64; i += F.G * 64) {
          const int g = (i >> 6) & 63, li_ = i >> 12;
          const double lr = a.in[10][i], li = a.in[11][i], dt = exp((double)a.in[12][li_ * 64 + g]);
          const double er = exp(lr * dt), abr = er * cos(li * dt), abi = er * sin(li * dt);
          const double xr_ = abr - 1.0, xi_ = abi, den = lr * lr + li * li;
          const double fr = (xr_ * lr + xi_ * li) / den, fi = (xi_ * lr - xr_ * li) / den;
          float* o = sp + (size_t)i * 34; o[0] = (float)abr; o[1] = (float)abi;
          for (int h = 0; h < 16; ++h) { const double br = a.in[13][(size_t)i * 16 + h], bi = a.in[14][(size_t)i * 16 + h]; o[2 + h] = (float)(fr * br - fi * bi); o[18 + h] = (float)(fr * bi + fi * br); } } }
    { int id = 0, base = 0; MatDesc d; get_mat(a, 0, d); int nit = (d.K / 64) * (d.N / 64);
      constexpr int TOTAL = 2 * (32 * 64 + 32 * 32 + 32 * 40 + 32 * 32) + 4 * (32 * 64 + 32 * 32 + 3 * 32 * 88);
      MatDesc dn = d; int idn = 0, basen = 0, nitn = nit;
      f32x4 vc[16], vn[16]; float gc[16], gn[16];
      int gi = F.gw;
      if (gi < TOTAL) {
          while (gi >= basen + nitn) { basen += nitn; ++idn; get_mat(a, idn, dn); nitn = (dn.K / 64) * (dn.N / 64); }
          d = dn; base = basen;
          tr_load(d, gi - base, lane, vc, gc);
          for (;;) {
              const int gnx = gi + F.ngw; const bool has_next = gnx < TOTAL;
              if (has_next) { while (gnx >= basen + nitn) { basen += nitn; ++idn; get_mat(a, idn, dn); nitn = (dn.K / 64) * (dn.N / 64); }
                              tr_load(dn, gnx - basen, lane, vn, gn); }
              tr_store(d, scr, gi - base, lane, vc, gc);
              if (!has_next) break;
#pragma unroll
              for (int i = 0; i < 16; ++i) { vc[i] = vn[i]; gc[i] = gn[i]; }
              d = dn; base = basen; gi = gnx;
          }
      } }
#if defined(PROBE_TR) && PROBE_TR
    { int id = 0, base = 0; MatDesc d; get_mat(a, 0, d); int nit = (d.K / 64) * (d.N / 64);
      constexpr int TOTAL = 2 * (32 * 64 + 32 * 32 + 32 * 40 + 32 * 32) + 4 * (32 * 64 + 32 * 32 + 3 * 32 * 88);
      f32x4 accp = (f32x4){0.f, 0.f, 0.f, 0.f};
      for (int gi = F.gw; gi < TOTAL; gi += F.ngw) {
          while (gi >= base + nit) { base += nit; ++id; get_mat(a, id, d); nit = (d.K / 64) * (d.N / 64); }
          f32x4 va[16]; float gs[16]; tr_load(d, gi - base, lane, va, gs);
          if (PROBE_TR == 1) {
#pragma unroll
              for (int i = 0; i < 16; ++i) accp += va[i] * gs[i];
          } else {
              const int item = gi - base, nblk = d.N / 64, kb = item / nblk, nb = item % nblk, k0 = 64 * kb, n0 = 64 * nb, c = lane & 7;
#pragma unroll
              for (int j = 0; j < 8; ++j) { const int n = (lane >> 3) + 8 * j, ng = n0 + n; const int drow = (ng / 128) * d.rs + d.roff + (ng % 128);
                  u32x4 o; o.x = (unsigned)gi; o.y = o.z = o.w = 0u;
                  *(u32x4*)((bf16_t*)(ws + WS_END) + ((size_t)(d.WT - (bf16_t*)(ws + WS_WIN_T)) % (32u << 20)) + (size_t)drow * d.K + k0 + 8 * c) = o; }
          } }
      if (accp[0] + accp[1] + accp[2] + accp[3] == 1.2345e-30f) *(float*)(ws + WS_END) = 0.f; }
#endif
    for (int id = 28; id < 32; ++id) {
        MatDesc d; get_mat(a, id, d);
        const size_t n8 = (size_t)d.K * d.N / 8;
        for (size_t i = gt; i < n8; i += F.ngt) { const f32x4 x0 = *(const f32x4*)(d.W + i * 8), x1 = *(const f32x4*)(d.W + i * 8 + 4);
            u32x4 o; o.x = cvt_pk_bf16(x0[0], x0[1]); o.y = cvt_pk_bf16(x0[2], x0[3]); o.z = cvt_pk_bf16(x1[0], x1[1]); o.w = cvt_pk_bf16(x1[2], x1[3]); *(u32x4*)(d.WT + i * 8) = o; }
    }
    { u32x4* z = (u32x4*)(ws + WS_SS + (size_t)M * 8); for (int i = gt; i < 13 * M * 8 / 16; i += F.ngt) z[i] = (u32x4){0u, 0u, 0u, 0u}; }
    { const float* x = a.in[0]; bf16_t* HB = (bf16_t*)(ws + WS_HB); i64* ss0 = (i64*)(ws + WS_SS);
      for (int row = F.gw; row < M; row += F.ngw) {
          const f32x4* xr = (const f32x4*)(x + (size_t)row * D); float s = 0.f;
#pragma unroll
          for (int j = 0; j < 4; ++j) { const f32x4 v0 = xr[(j * 64 + lane) * 2], v1 = xr[(j * 64 + lane) * 2 + 1];
              s += (v0[0] * v0[0] + v0[1] * v0[1]) + (v0[2] * v0[2] + v0[3] * v0[3]) + (v1[0] * v1[0] + v1[1] * v1[1]) + (v1[2] * v1[2] + v1[3] * v1[3]);
              u32x4 o; o.x = cvt_pk_bf16(v0[0], v0[1]); o.y = cvt_pk_bf16(v0[2], v0[3]); o.z = cvt_pk_bf16(v1[0], v1[1]); o.w = cvt_pk_bf16(v1[2], v1[3]);
              *(u32x4*)(HB + (size_t)row * D + (j * 64 + lane) * 8) = o; }
          s = wave_sum(s, lane); if (lane == 0) ss0[row] = (i64)(s * SS_SCALE); } }
    { const float* mem = a.in[1]; const float* gm = a.in[6]; bf16_t* MN = (bf16_t*)(ws + WS_MEMN);
      for (int row = F.gw; row < MROWS; row += F.ngw) {
          const f32x4* xr = (const f32x4*)(mem + (size_t)row * D); f32x4 v[8]; float s = 0.f;
#pragma unroll
          for (int j = 0; j < 4; ++j) { v[2 * j] = xr[(j * 64 + lane) * 2]; v[2 * j + 1] = xr[(j * 64 + lane) * 2 + 1];
              const f32x4 v0 = v[2 * j], v1 = v[2 * j + 1]; s += (v0[0] * v0[0] + v0[1] * v0[1]) + (v0[2] * v0[2] + v0[3] * v0[3]) + (v1[0] * v1[0] + v1[1] * v1[1]) + (v1[2] * v1[2] + v1[3] * v1[3]); }
          s = wave_sum(s, lane); const float r = 1.0f / sqrtf(s * (1.0f / D) + EPS);
#pragma unroll
          for (int j = 0; j < 4; ++j) { const f32x4 g0 = *(const f32x4*)(gm + (j * 64 + lane) * 8), g1 = *(const f32x4*)(gm + (j * 64 + lane) * 8 + 4);
              const f32x4 v0 = v[2 * j] * r * g0, v1 = v[2 * j + 1] * r * g1;
              u32x4 o; o.x = cvt_pk_bf16(v0[0], v0[1]); o.y = cvt_pk_bf16(v0[2], v0[3]); o.z = cvt_pk_bf16(v1[0], v1[1]); o.w = cvt_pk_bf16(v1[2], v1[3]);
              *(u32x4*)(MN + (size_t)row * D + (j * 64 + lane) * 8) = o; } } }
    { float* qb = (float*)(ws + WS_QKVB); const float* b = a.in[21];
      for (int i = gt; i < 2 * ODD_IN; i += F.ngt) qb[i] = b[i] * (((i % ODD_IN) < NQH * HD) ? 0.125f : 1.0f); }
    { float* gxs = (float*)(ws + WS_GXS); const float* gx = a.in[3];
      for (int i = gt; i < 4 * D; i += F.ngt) gxs[i] = gx[i] * 0.044194173824159216f; }
}

__device__ __forceinline__ void unpack8(const u32x4 w, float (&f)[8]) { f[0] = bf_lo(w.x); f[1] = bf_hi(w.x); f[2] = bf_lo(w.y); f[3] = bf_hi(w.y); f[4] = bf_lo(w.z); f[5] = bf_hi(w.z); f[6] = bf_lo(w.w); f[7] = bf_hi(w.w); }
__device__ __forceinline__ void phase_convgate(const bf16_t* Z, const float* cw, bf16_t* YY, Frame& F) {
    PHASE_TID(F, tid, lane, gt);
    for (int idx = gt; idx < M * (AW / 8); idx += F.ngt) {
        const int row = idx >> 7, c8 = (idx & 127) * 8, t = row & (L - 1);
        const bf16_t* zr = Z + (size_t)row * EVEN_IN + c8;
        float gb[8], a0[8], b0[8], a1[8], b1[8], a2[8], b2[8];
        unpack8(*(const u32x4*)zr, gb); unpack8(*(const u32x4*)(zr + AW), a0); unpack8(*(const u32x4*)(zr + 2 * AW), b0);
        const u32x4 zero = (u32x4){0u, 0u, 0u, 0u};
        unpack8(t >= 1 ? *(const u32x4*)(zr - EVEN_IN + AW) : zero, a1); unpack8(t >= 1 ? *(const u32x4*)(zr - EVEN_IN + 2 * AW) : zero, b1);
        unpack8(t >= 2 ? *(const u32x4*)(zr - 2 * EVEN_IN + AW) : zero, a2); unpack8(t >= 2 ? *(const u32x4*)(zr - 2 * EVEN_IN + 2 * AW) : zero, b2);
        float o[8];
#pragma unroll
        for (int j = 0; j < 8; ++j) o[j] = gb[j] * (cw[2 * AW + c8 + j] * (a0[j] * b0[j]) + cw[AW + c8 + j] * (a1[j] * b1[j]) + cw[c8 + j] * (a2[j] * b2[j]));
        u32x4 w; w.x = cvt_pk_bf16(o[0], o[1]); w.y = cvt_pk_bf16(o[2], o[3]); w.z = cvt_pk_bf16(o[4], o[5]); w.w = cvt_pk_bf16(o[6], o[7]);
        *(u32x4*)(YY + (size_t)row * D + c8) = w;
    }
}

__device__ __forceinline__ void phase_mlp_fixup(const float* HG, const float* HU, const float* cw, const float* cb, bf16_t* ACT, Frame& F) {
    PHASE_TID(F, tid, lane, gt);
    for (int idx = gt; idx < 512 * (DFF / 4); idx += F.ngt) {
        const int ri = idx / (DFF / 4), c = (idx % (DFF / 4)) * 4, blk = ri >> 1, e = ri & 1, r = blk * 64 + e, t = r & (L - 1);
        const f32x4 zero = (f32x4){0.f, 0.f, 0.f, 0.f};
        f32x4 gm2, gm1, g0;
        if (e == 0) { gm2 = (t >= 2) ? *(const f32x4*)(HG + ((size_t)(blk - 1) * 4 + 0) * DFF + c) : zero; gm1 = (t >= 1) ? *(const f32x4*)(HG + ((size_t)(blk - 1) * 4 + 1) * DFF + c) : zero; g0 = *(const f32x4*)(HG + ((size_t)blk * 4 + 2) * DFF + c); }
        else        { gm2 = (t >= 2) ? *(const f32x4*)(HG + ((size_t)(blk - 1) * 4 + 1) * DFF + c) : zero; gm1 = *(const f32x4*)(HG + ((size_t)blk * 4 + 2) * DFF + c); g0 = *(const f32x4*)(HG + ((size_t)blk * 4 + 3) * DFF + c); }
        const f32x4 up = *(const f32x4*)(HU + ((size_t)blk * 2 + e) * DFF + c);
        const f32x4 w0 = *(const f32x4*)(cw + c), w1 = *(const f32x4*)(cw + DFF + c), w2 = *(const f32x4*)(cw + 2 * DFF + c), bb = *(const f32x4*)(cb + c);
        f32x4 pre = w2 * g0 + w1 * gm1 + w0 * gm2 + bb, a;
#pragma unroll
        for (int j = 0; j < 4; ++j) a[j] = pre[j] * fast_sigmoid(pre[j]) * up[j];
        u32x2 w; w.x = cvt_pk_bf16(a[0], a[1]); w.y = cvt_pk_bf16(a[2], a[3]);
        *(u32x2*)(ACT + (size_t)r * DFF + c) = w;
    }
}

__device__ __forceinline__ void phase_ya_fixup(const float* HV, const float* HGB, const float* cw, bf16_t* YY, Frame& F) {
    PHASE_TID(F, tid, lane, gt);
    for (int idx = gt; idx < 512 * (AW / 4); idx += F.ngt) {
        const int ri = idx >> 8, c = (idx & 255) * 4, blk = ri >> 1, e = ri & 1, r = blk * 64 + e, t = r & (L - 1);
        const f32x4 zero = (f32x4){0.f, 0.f, 0.f, 0.f};
        f32x4 vm2, vm1, v0;
        if (e == 0) { vm2 = (t >= 2) ? *(const f32x4*)(HV + ((size_t)(blk - 1) * 4 + 0) * AW + c) : zero; vm1 = (t >= 1) ? *(const f32x4*)(HV + ((size_t)(blk - 1) * 4 + 1) * AW + c) : zero; v0 = *(const f32x4*)(HV + ((size_t)blk * 4 + 2) * AW + c); }
        else        { vm2 = (t >= 2) ? *(const f32x4*)(HV + ((size_t)(blk - 1) * 4 + 1) * AW + c) : zero; vm1 = *(const f32x4*)(HV + ((size_t)blk * 4 + 2) * AW + c); v0 = *(const f32x4*)(HV + ((size_t)blk * 4 + 3) * AW + c); }
        const f32x4 gb = *(const f32x4*)(HGB + ((size_t)blk * 2 + e) * AW + c);
        const f32x4 w0 = *(const f32x4*)(cw + c), w1 = *(const f32x4*)(cw + AW + c), w2 = *(const f32x4*)(cw + 2 * AW + c);
        const f32x4 a = gb * (w2 * v0 + w1 * vm1 + w0 * vm2);
        u32x2 w; w.x = cvt_pk_bf16(a[0], a[1]); w.y = cvt_pk_bf16(a[2], a[3]);
        *(u32x2*)(YY + (size_t)r * D + c) = w;
    }
}

__device__ __forceinline__ void phase_final(const bf16_t* HB, const i64* ss, const float* g, float* out, Frame& F) {
    PHASE_TID(F, tid, lane, gt);
    for (size_t i = gt; i < (size_t)M * D / 8; i += F.ngt) {
        const int row = (int)(i >> 8), c = (int)(i & 255) * 8;
        const float rs = 1.0f / sqrtf((float)ss[row] * SS_INV + EPS);
        float h[8]; unpack8(*(const u32x4*)(HB + i * 8), h);
        const f32x4 g0 = *(const f32x4*)(g + c), g1 = *(const f32x4*)(g + c + 4);
        *(f32x4*)(out + i * 8) = (f32x4){h[0], h[1], h[2], h[3]} * rs * g0; *(f32x4*)(out + i * 8 + 4) = (f32x4){h[4], h[5], h[6], h[7]} * rs * g1;
    }
}

typedef float f32x16 __attribute__((ext_vector_type(16)));
constexpr int SWA_KSTR = 144, SWA_VSTR = 520, SWA_K_OFF = 0, SWA_V_OFF = 256 * SWA_KSTR, SWA_T_OFF = SWA_V_OFF + 64 * SWA_VSTR, SWA_TLEN = 192;
__device__ __forceinline__ void phase_swa(const bf16_t* QKV, const float* rel_bias, const float* sinks, bf16_t* O, Frame& F) {
    PHASE_TID(F, tid, lane, gt);
    const float LOG2E = 1.4426950408889634f;
    LAS unsigned char* lds = F.lds;
    const int q31 = lane & 31, hf = lane >> 5;
    for (int unit = F.bid; unit < NB * 32 * NKVH; unit += F.G) {
        const int b = unit >> 7, n = (unit >> 2) & 31, kvh = unit & 3, row0 = b * L + n * 128;
#pragma unroll
        for (int i = 0; i < 4; ++i) { const int it = tid + i * NTHR, key = it >> 3, ch = it & 7;
            u32x4 v = (u32x4){0u, 0u, 0u, 0u};
            if (n > 0 || key >= 128) v = *(const u32x4*)(QKV + (size_t)(row0 - 128 + key) * ODD_IN + NQH * HD + kvh * HD + ch * 8);
            *(LAS u32x4*)(lds + SWA_K_OFF + key * SWA_KSTR + ch * 16) = v; }
#pragma unroll
        for (int i = 0; i < 2; ++i) { const int it = tid + i * NTHR, dc = it & 7, kp = it >> 3;
            u32x4 v0 = (u32x4){0u, 0u, 0u, 0u}, v1 = v0;
            if (n > 0 || kp >= 64) { const bf16_t* vp = QKV + (size_t)(row0 - 128 + 2 * kp) * ODD_IN + (NQH + NKVH) * HD + kvh * HD + dc * 8; v0 = *(const u32x4*)vp; v1 = *(const u32x4*)(vp + ODD_IN); }
            LAS unsigned char* dst = lds + SWA_V_OFF + (dc * 8) * SWA_VSTR + kp * 4;
            *(LAS unsigned*)(dst + 0 * SWA_VSTR) = (v0.x & 0xffffu) | (v1.x << 16); *(LAS unsigned*)(dst + 1 * SWA_VSTR) = (v0.x >> 16) | (v1.x & 0xffff0000u);
            *(LAS unsigned*)(dst + 2 * SWA_VSTR) = (v0.y & 0xffffu) | (v1.y << 16); *(LAS unsigned*)(dst + 3 * SWA_VSTR) = (v0.y >> 16) | (v1.y & 0xffff0000u);
            *(LAS unsigned*)(dst + 4 * SWA_VSTR) = (v0.z & 0xffffu) | (v1.z << 16); *(LAS unsigned*)(dst + 5 * SWA_VSTR) = (v0.z >> 16) | (v1.z & 0xffff0000u);
            *(LAS unsigned*)(dst + 6 * SWA_VSTR) = (v0.w & 0xffffu) | (v1.w << 16); *(LAS unsigned*)(dst + 7 * SWA_VSTR) = (v0.w >> 16) | (v1.w & 0xffff0000u); }
        for (int idx = tid; idx < 8 * SWA_TLEN; idx += NTHR) { const int g = idx / SWA_TLEN, e = idx % SWA_TLEN, rel = e - 31;
            const float v = (rel >= 0 && rel < 128) ? rel_bias[kBucket[rel] * NQH + kvh * 8 + g] * LOG2E : -1e30f;
            *(LAS float*)(lds + SWA_T_OFF + idx * 4) = v; }
        __syncthreads();
        const int hq = kvh * 8 + F.wave; const float sink2 = sinks[hq] * LOG2E;
        bf16x8 qn[4];
        { const bf16_t* qp = QKV + (size_t)(row0 + q31) * ODD_IN + hq * HD + 8 * hf;
#pragma unroll
          for (int s = 0; s < 4; ++s) qn[s] = *(const bf16x8*)(qp + 16 * s); }
#pragma unroll 1
        for (int qt = 0; qt < 4; ++qt) {
            bf16x8 qf[4];
#pragma unroll
            for (int s = 0; s < 4; ++s) qf[s] = qn[s];
            if (qt < 3) { const bf16_t* qp = QKV + (size_t)(row0 + 32 * (qt + 1) + q31) * ODD_IN + hq * HD + 8 * hf;
#pragma unroll
                for (int s = 0; s < 4; ++s) qn[s] = *(const bf16x8*)(qp + 16 * s); }
            f32x16 S[5];
#pragma unroll
            for (int dt = 0; dt < 5; ++dt) {
                const int kt = qt + dt;
                if (n == 0 && kt < 4) {
#pragma unroll
                    for (int i = 0; i < 16; ++i) S[dt][i] = -1e30f;
                } else {
                    f32x16 acc;
#pragma unroll
                    for (int i = 0; i < 16; ++i) acc[i] = 0.f;
#pragma unroll
                    for (int s = 0; s < 4; ++s) { const bf16x8 kf = *(const LAS bf16x8*)(lds + SWA_K_OFF + (32 * kt + q31) * SWA_KSTR + (16 * s + 8 * hf) * 2);
                        acc = __builtin_amdgcn_mfma_f32_32x32x16_bf16(kf, qf[s], acc, 0, 0, 0); }
                    const LAS unsigned char* tb = lds + SWA_T_OFF + (F.wave * SWA_TLEN + 159 - 32 * dt + q31 - 4 * hf - 27) * 4;
#pragma unroll
                    for (int i = 0; i < 16; ++i) S[dt][i] = acc[i] * LOG2E + *(const LAS float*)(tb + (27 - (8 * (i >> 2) + (i & 3))) * 4);
                }
            }
            float mx = sink2;
#pragma unroll
            for (int dt = 0; dt < 5; ++dt)
#pragma unroll
                for (int i = 0; i < 16; ++i) mx = fmaxf(mx, S[dt][i]);
            mx = fmaxf(mx, shx(mx, 32, lane));
            float l = 0.f;
#pragma unroll
            for (int dt = 0; dt < 5; ++dt)
#pragma unroll
                for (int i = 0; i < 16; ++i) { const float p = __builtin_amdgcn_exp2f(S[dt][i] - mx); S[dt][i] = p; l += p; }
            l += shx(l, 32, lane);
            const float inv = __builtin_amdgcn_rcpf(l + __builtin_amdgcn_exp2f(sink2 - mx));
            f32x16 oa[2];
#pragma unroll
            for (int dd = 0; dd < 2; ++dd)
#pragma unroll
                for (int i = 0; i < 16; ++i) oa[dd][i] = 0.f;
#pragma unroll
            for (int dt = 0; dt < 5; ++dt) {
                const int kt = qt + dt;
                if (!(n == 0 && kt < 4)) {
#pragma unroll
                    for (int s = 0; s < 2; ++s) {
                        u32x4 pw; pw.x = cvt_pk_bf16(S[dt][8 * s + 0], S[dt][8 * s + 1]); pw.y = cvt_pk_bf16(S[dt][8 * s + 2], S[dt][8 * s + 3]); pw.z = cvt_pk_bf16(S[dt][8 * s + 4], S[dt][8 * s + 5]); pw.w = cvt_pk_bf16(S[dt][8 * s + 6], S[dt][8 * s + 7]);
                        const bf16x8 pb = __builtin_bit_cast(bf16x8, pw);
#pragma unroll
                        for (int dd = 0; dd < 2; ++dd) {
                            const LAS unsigned char* vp = lds + SWA_V_OFF + (32 * dd + q31) * SWA_VSTR + (32 * kt + 16 * s + 4 * hf) * 2;
                            const u32x2 a0 = *(const LAS u32x2*)vp, a1 = *(const LAS u32x2*)(vp + 16);
                            const bf16x8 va = __builtin_bit_cast(bf16x8, (u32x4){a0.x, a0.y, a1.x, a1.y});
                            oa[dd] = __builtin_amdgcn_mfma_f32_32x32x16_bf16(va, pb, oa[dd], 0, 0, 0);
                        }
                    }
                }
            }
            bf16_t* op = O + (size_t)(row0 + 32 * qt + q31) * D + hq * HD + 4 * hf;
#pragma unroll
            for (int dd = 0; dd < 2; ++dd)
#pragma unroll
                for (int g4 = 0; g4 < 4; ++g4) { u32x2 w; w.x = cvt_pk_bf16(oa[dd][4 * g4 + 0] * inv, oa[dd][4 * g4 + 1] * inv); w.y = cvt_pk_bf16(oa[dd][4 * g4 + 2] * inv, oa[dd][4 * g4 + 3] * inv);
                    *(u32x2*)(op + 32 * dd + 8 * g4) = w; }
        }
        __syncthreads();
    }
}

constexpr int S5_PW_OFF = 0, S5_KC_OFF = 4608, S5_SL_OFF = 9216, S5_XB_OFF = 41984, S5_XSTR = 272, S5_PT_OFF = 59392, S5_UL_OFF = 94208, S5_USTR = 264, S5_UBUF = 64 * 264;
__device__ __forceinline__ float bfe(const bf16x8& v, int j) { return __uint_as_float(((unsigned)(unsigned short)v[j]) << 16); }
template <int RT>
__device__ __forceinline__ void s5_unit(const bf16_t* Z, const float* s5p, const float* c_re, const float* c_im, const float* dvec, const float* glu, bf16_t* YY, LAS unsigned char* lds,
                                        const int b, const int g, const int wave, const int tid, const int lane) {
    const int q31 = lane & 31, hf = lane >> 5, mtl = wave >> 2;
    LAS f32x2* PW = (LAS f32x2*)(lds + S5_PW_OFF);
    { const int p = tid & 63, j = tid >> 6; const float ar = s5p[(size_t)(g * 64 + p) * 34], ai = s5p[(size_t)(g * 64 + p) * 34 + 1];
      float pr = 1.f, pi = 0.f;
      for (int k = 0; k < j; ++k) { const float nr = pr * ar - pi * ai, ni = pr * ai + pi * ar; pr = nr; pi = ni; }
      PW[j * 64 + p] = (f32x2){pr, pi};
      if (j == 7) PW[8 * 64 + p] = (f32x2){pr * ar - pi * ai, pr * ai + pi * ar}; }
    __syncthreads();
    { LAS bf16_t* KC = (LAS bf16_t*)(lds + S5_KC_OFF);
#pragma unroll 1
      for (int q = 0; q < 4; ++q) { const int e = tid + NTHR * q, jj = e >> 8, h = (e >> 4) & 15, hp = e & 15;
          const float* cr = c_re + (size_t)(g * 16 + h) * 64; const float* ci = c_im + (size_t)(g * 16 + h) * 64; const float* bb = s5p + (size_t)(g * 64) * 34 + 2 + hp;
          float sum = 0.f;
#pragma unroll 4
          for (int p = 0; p < 64; ++p) { const f32x2 pw = PW[jj * 64 + p]; const float tr = cr[p] * pw.x - ci[p] * pw.y, ti = cr[p] * pw.y + ci[p] * pw.x; sum += tr * bb[p * 34] - ti * bb[p * 34 + 16]; }
          const int pos = 8 * ((hp >> 2) & 1) + 4 * (hp >> 3) + (hp & 3);
          KC[(jj * 16 + h) * 16 + pos] = (bf16_t)(cvt_pk_bf16(sum, 0.f) & 0xffffu); }
      if (tid < 128) ((LAS unsigned*)(KC + 8 * 256))[tid] = 0u; }
    __syncthreads();
    bf16x8 qf[8], ga[2]; float d8[8];
    {
      const int comp = 32 * RT + q31, p = comp & 63; const bool im = comp >= 64; const float* bbp = s5p + (size_t)(g * 64 + p) * 34 + 2;
      float br[8], bi[8];
#pragma unroll
      for (int j = 0; j < 8; ++j) { const int hp = 8 * (j >> 2) + 4 * hf + (j & 3); br[j] = bbp[hp]; bi[j] = bbp[16 + hp]; }
#pragma unroll
      for (int s = 0; s < 8; ++s) { const f32x2 pw = PW[(7 - s) * 64 + p]; float v[8];
#pragma unroll
          for (int j = 0; j < 8; ++j) v[j] = im ? (pw.x * bi[j] + pw.y * br[j]) : (pw.x * br[j] - pw.y * bi[j]);
          u32x4 w; w.x = cvt_pk_bf16(v[0], v[1]); w.y = cvt_pk_bf16(v[2], v[3]); w.z = cvt_pk_bf16(v[4], v[5]); w.w = cvt_pk_bf16(v[6], v[7]);
          if (mtl == 0) *(LAS u32x4*)(lds + S5_PT_OFF + comp * S5_XSTR + s * 32 + hf * 16) = w; } }
    {
      const int t2 = 2 * RT + (q31 >> 4), h = q31 & 15; const float* cr = c_re + (size_t)(g * 16 + h) * 64; const float* ci = c_im + (size_t)(g * 16 + h) * 64;
#pragma unroll
      for (int ks = 0; ks < 4; ++ks) { float vr[8], vi[8];
#pragma unroll
          for (int j = 0; j < 8; ++j) { const int p = 16 * ks + 8 * hf + j; const f32x2 pw = PW[(t2 + 1) * 64 + p]; const float a = cr[p], c = ci[p]; vr[j] = a * pw.x - c * pw.y; vi[j] = -(a * pw.y + c * pw.x); }
          u32x4 w; w.x = cvt_pk_bf16(vr[0], vr[1]); w.y = cvt_pk_bf16(vr[2], vr[3]); w.z = cvt_pk_bf16(vr[4], vr[5]); w.w = cvt_pk_bf16(vr[6], vr[7]); qf[ks] = __builtin_bit_cast(bf16x8, w);
          w.x = cvt_pk_bf16(vi[0], vi[1]); w.y = cvt_pk_bf16(vi[2], vi[3]); w.z = cvt_pk_bf16(vi[4], vi[5]); w.w = cvt_pk_bf16(vi[6], vi[7]); qf[ks + 4] = __builtin_bit_cast(bf16x8, w); }
      const int o = q31 & 15, t2p = q31 >> 4;
#pragma unroll
      for (int ks = 0; ks < 2; ++ks) { float v[8];
#pragma unroll
          for (int j = 0; j < 8; ++j) { const int hh = 8 * (j >> 2) + 4 * hf + (j & 3); v[j] = (t2p == ks) ? glu[g * 256 + hh * 16 + o] : 0.f; }
          u32x4 w; w.x = cvt_pk_bf16(v[0], v[1]); w.y = cvt_pk_bf16(v[2], v[3]); w.z = cvt_pk_bf16(v[4], v[5]); w.w = cvt_pk_bf16(v[6], v[7]); ga[ks] = __builtin_bit_cast(bf16x8, w); }
#pragma unroll
      for (int j = 0; j < 8; ++j) d8[j] = dvec[g * 16 + 8 * (j >> 2) + 4 * hf + (j & 3)]; }
    const f32x2 a8 = PW[8 * 64 + lane];
    float Sre = 0.f, Sim = 0.f;
    LAS float* SL = (LAS float*)(lds + S5_SL_OFF);
    bf16x8 uf[8];
    u32x4 gU0, gU1;
    const bf16_t* ubase = Z + ((size_t)g * M + (size_t)b * L) * 16 + (size_t)tid * 16;
#define S5_GLOADU(SEG) do { const u32x4* gp_ = (const u32x4*)(ubase + (size_t)(SEG) * 8192); gU0 = gp_[0]; gU1 = gp_[1]; } while (0)
#define S5_STOREU(SEG) do { LAS unsigned char* up_ = lds + S5_UL_OFF + ((SEG) & 1) * S5_UBUF + (tid >> 3) * S5_USTR + (tid & 7) * 32; \
        *(LAS u32x2*)(up_) = (u32x2){gU0.x, gU0.y}; *(LAS u32x2*)(up_ + 8) = (u32x2){gU0.z, gU0.w}; *(LAS u32x2*)(up_ + 16) = (u32x2){gU1.x, gU1.y}; *(LAS u32x2*)(up_ + 24) = (u32x2){gU1.z, gU1.w}; } while (0)
#define S5_READU(SEG) do { const LAS unsigned char* up_ = lds + S5_UL_OFF + ((SEG) & 1) * S5_UBUF + (mtl * 32 + q31) * S5_USTR + hf * 8; \
        _Pragma("unroll") for (int s = 0; s < 8; ++s) { const u32x2 lo = *(const LAS u32x2*)(up_ + s * 32), hi = *(const LAS u32x2*)(up_ + s * 32 + 16); uf[s] = __builtin_bit_cast(bf16x8, (u32x4){lo.x, lo.y, hi.x, hi.y}); } } while (0)
#define S5_SEG(SEG) do { \
        const int seg = (SEG); const int mloc = mtl * 32 + q31; const size_t tok0 = (size_t)b * L + 8 * (seg * 64 + mloc); \
        { f32x16 acc; \
          _Pragma("unroll") for (int i = 0; i < 16; ++i) acc[i] = 0.f; \
          S5_READU(seg); \
          _Pragma("unroll") for (int s = 0; s < 8; ++s) acc = __builtin_amdgcn_mfma_f32_32x32x16_bf16(uf[s], *(const LAS bf16x8*)(lds + S5_PT_OFF + (32 * RT + q31) * S5_XSTR + s * 32 + hf * 16), acc, 0, 0, 0); \
          if (seg < 7) S5_STOREU(seg + 1); \
          if (seg < 6) S5_GLOADU(seg + 2); \
          _Pragma("unroll") for (int i = 0; i < 16; ++i) SL[(mtl * 32 + 8 * (i >> 2) + 4 * hf + (i & 3)) * 128 + 32 * RT + q31] = acc[i]; } \
        __syncthreads(); \
        if (wave == 0) { \
            _Pragma("unroll 1") for (int blk = 0; blk < 8; ++blk) { float lr[8], li[8]; \
                _Pragma("unroll") for (int k = 0; k < 8; ++k) { lr[k] = SL[(blk * 8 + k) * 128 + lane]; li[k] = SL[(blk * 8 + k) * 128 + 64 + lane]; } \
                _Pragma("unroll") for (int k = 0; k < 8; ++k) { LAS bf16_t* xr = (LAS bf16_t*)(lds + S5_XB_OFF + (blk * 8 + k) * S5_XSTR); \
                    const unsigned w = cvt_pk_bf16(Sre, Sim); xr[lane] = (bf16_t)(w & 0xffffu); xr[64 + lane] = (bf16_t)(w >> 16); \
                    const float nr = a8.x * Sre - a8.y * Sim + lr[k], ni = a8.x * Sim + a8.y * Sre + li[k]; Sre = nr; Sim = ni; } } } \
        __syncthreads(); \
        { f32x16 acc; \
          _Pragma("unroll") for (int i = 0; i < 16; ++i) acc[i] = 0.f; \
          _Pragma("unroll") for (int s = 0; s < 2 * RT + 2; ++s) { int jj = t2r - s; jj = jj < 0 ? 8 : jj; \
              const bf16x8 kfs = *(const LAS bf16x8*)(lds + S5_KC_OFF + ((jj * 16 + hr) * 16 + 8 * hf) * 2); acc = __builtin_amdgcn_mfma_f32_32x32x16_bf16(kfs, uf[s], acc, 0, 0, 0); } \
          _Pragma("unroll") for (int ks = 0; ks < 8; ++ks) { const bf16x8 xf = *(const LAS bf16x8*)(lds + S5_XB_OFF + mloc * S5_XSTR + (16 * ks + 8 * hf) * 2); acc = __builtin_amdgcn_mfma_f32_32x32x16_bf16(qf[ks], xf, acc, 0, 0, 0); } \
          float yg[16]; \
          _Pragma("unroll") for (int i = 0; i < 16; ++i) yg[i] = gelu_tanh_f(acc[i] + d8[i & 7] * bfe(uf[2 * RT + (i >> 3)], i & 7)); \
          f32x16 gt; \
          _Pragma("unroll") for (int i = 0; i < 16; ++i) gt[i] = 0.f; \
          _Pragma("unroll") for (int ks = 0; ks < 2; ++ks) { u32x4 w; w.x = cvt_pk_bf16(yg[8 * ks + 0], yg[8 * ks + 1]); w.y = cvt_pk_bf16(yg[8 * ks + 2], yg[8 * ks + 3]); w.z = cvt_pk_bf16(yg[8 * ks + 4], yg[8 * ks + 5]); w.w = cvt_pk_bf16(yg[8 * ks + 6], yg[8 * ks + 7]); \
              gt = __builtin_amdgcn_mfma_f32_32x32x16_bf16(ga[ks], __builtin_bit_cast(bf16x8, w), gt, 0, 0, 0); } \
          bf16_t* op = YY + (tok0 + 2 * RT) * D + AW + g * 16 + 4 * hf; \
          _Pragma("unroll") for (int t2l = 0; t2l < 2; ++t2l) \
              _Pragma("unroll") for (int grp = 0; grp < 2; ++grp) { const int i0 = 8 * t2l + 4 * grp; float o[4]; \
                  _Pragma("unroll") for (int r = 0; r < 4; ++r) o[r] = yg[i0 + r] * fast_sigmoid(gt[i0 + r]); \
                  u32x2 w; w.x = cvt_pk_bf16(o[0], o[1]); w.y = cvt_pk_bf16(o[2], o[3]); \
                  *(u32x2*)(op + (size_t)t2l * D + 8 * grp) = w; } } \
    } while (0)
    const int t2r = 2 * RT + (q31 >> 4), hr = q31 & 15;
    S5_GLOADU(0); S5_STOREU(0); S5_GLOADU(1);
    __syncthreads();
#pragma unroll 1
    for (int sg = 0; sg < 8; ++sg) { S5_SEG(sg); }
#undef S5_SEG
#undef S5_GLOADU
#undef S5_STOREU
#undef S5_READU
    __syncthreads();
}
__device__ __forceinline__ void phase_s5(const bf16_t* Z, const float* s5p, const float* c_re, const float* c_im, const float* dvec, const float* glu, bf16_t* YY, Frame& F) {
    PHASE_TID(F, tid, lane, gt);
    for (int unit = F.bid; unit < NB * S5G; unit += F.G) {
        const int b = unit / S5G, g = unit % S5G;
        switch (F.wave & 3) {
            case 0: s5_unit<0>(Z, s5p, c_re, c_im, dvec, glu, YY, F.lds, b, g, F.wave, tid, lane); break;
            case 1: s5_unit<1>(Z, s5p, c_re, c_im, dvec, glu, YY, F.lds, b, g, F.wave, tid, lane); break;
            case 2: s5_unit<2>(Z, s5p, c_re, c_im, dvec, glu, YY, F.lds, b, g, F.wave, tid, lane); break;
            default: s5_unit<3>(Z, s5p, c_re, c_im, dvec, glu, YY, F.lds, b, g, F.wave, tid, lane); break;
        }
    }
}
namespace pg8 {
struct SchedKV {
    unsigned char* ws; int G, c;
    __device__ __forceinline__ bool next(int i, Unit& u) const {
        const long Lx = (long)i * G + c; if (Lx >= 256) return false;
        const int l = (int)Lx >> 6, rem = (int)Lx & 63, pm = rem >> 4, pn = rem & 15;
        u.A = (const char*)(ws + WS_MEMN) + (size_t)pm * 256 * D * 2;
        u.B = (const char*)(ws + WS_WKV_T) + ((size_t)l * 2 * D + pn * 256) * D * 2;
        u.C = (char*)(ws + WS_KVM) + (pn >= 8 ? 16 * MiB : 0) + (((size_t)l * MROWS + pm * 256) * D + (pn & 7) * 256) * 2;
        u.vec = nullptr; u.row0 = pm * 256; u.col0 = pn * 256; u.aux = D; return true;
    }
};
struct SchedWSVW {
    unsigned char* ws; const float* gx; int G, c;
    __device__ __forceinline__ bool next(int i, Unit& u) const {
        const long Lx = (long)i * G + c; if (Lx >= 1024) return false;
        const int j = (int)Lx & 511, z = j >> 3, pt = j & 7, l = z >> 4, b = (z >> 2) & 3, head = z & 3;
        if (Lx < 512) {
            u.A = (const char*)(ws + WS_KVM) + (((size_t)l * MROWS + b * 256) * D + head * XHD) * 2;
            u.B = (const char*)(ws + WS_WQ_BF) + (((size_t)l * D + pt * 256) * D + head * XHD) * 2;
            u.C = (char*)(ws + WS_WS) + ((((size_t)(l * 4 + b) * 1024 + head * 256) * D) + pt * 256) * 2;
            u.vec = gx + l * D; u.row0 = 0; u.col0 = pt * 256; u.aux = D;
        } else {
            u.A = (const char*)(ws + WS_WO_T) + (((size_t)l * D + pt * 256) * D + head * XHD) * 2;
            u.B = (const char*)(ws + WS_KVM) + 16 * MiB + (((size_t)l * MROWS + b * 256) * D + head * XHD) * 2;
            u.C = (char*)(ws + WS_VW) + ((((size_t)(l * 4 + b) * D + pt * 256) * 1024) + head * 256) * 2;
            u.vec = nullptr; u.row0 = 0; u.col0 = 0; u.aux = 1024;
        }
        return true;
    }
};
}

#ifndef NO_PKF32
#define NO_PKF32 1
#endif
#if NO_PKF32 && defined(__HIP_DEVICE_COMPILE__)
#define MEGA_TGT __attribute__((target("no-packed-fp32-ops")))
#else
#define MEGA_TGT
#endif
__global__ void __launch_bounds__(NTHR, 2) MEGA_TGT mega_fwd(Args a) {
    extern __shared__ __attribute__((aligned(16))) unsigned char lds_raw[];
    Frame F;
    F.lds = (LAS unsigned char*)lds_raw;
    const int tid0 = threadIdx.x; F.wave = __builtin_amdgcn_readfirstlane(tid0 >> 6);
    F.G = gridDim.x; F.bid = blockIdx.x;
    F.gw = F.bid * NWAVES + F.wave; F.ngw = F.G * NWAVES; F.ngt = F.G * NTHR;
    unsigned char* ws = a.ws;
    volatile LAS unsigned* MISC = (volatile LAS unsigned*)(F.lds + MISC_OFF);
    for (int u = tid0; u < (LDS_BYTES - MISC_OFF) / 4; u += NTHR) ((LAS unsigned*)(F.lds + MISC_OFF))[u] = 0u;
    __syncthreads();
    unsigned* ctl = (unsigned*)(ws + WS_CTL);
    const XcdBarrier bar = xcd_barrier_post(ctl + CW_BAR, MISC + 8, F.wave);
    static_assert(8 * 16640 <= MISC_OFF, "prologue scratch below the control words");
    static_assert((CW_BAR + XCD_BAR_WORDS) * 4 <= (int)CTL_ZERO_BYTES, "barrier words inside the memset region");
#define GRID_BAR() do { xcd_barrier(bar); if (PROBE_BAR) xcd_barrier(bar); } while (0)

    i64* SS = (i64*)(ws + WS_SS);
    bf16_t* HB = (bf16_t*)(ws + WS_HB); bf16_t* YY = (bf16_t*)(ws + WS_YY);
    bf16_t* BIG = (bf16_t*)(ws + WS_BIG);
    float* HG = (float*)(ws + WS_HALO_G); float* HU = (float*)(ws + WS_HALO_U);
    float* DUMF = (float*)(ws + WS_END); bf16_t* DUMB = (bf16_t*)(ws + WS_END); (void)DUMF; (void)DUMB;
    const int cid = (int)blockIdx.x;

#ifndef PHMASK
#define PHMASK 0xFFFF
#endif
#ifndef PROBE_DUP
#define PROBE_DUP 0
#endif
#ifndef PROBE_KONLY
#define PROBE_KONLY 0
#endif
#ifndef F1_ALIGN
#define F1_ALIGN true
#endif
#ifndef F2_WGM
#define F2_WGM 4
#endif
#ifndef PROBE_BAR
#define PROBE_BAR 0
#endif
#define REP(bit) for (int rep_ = 0; rep_ < (((PROBE_DUP) & (bit)) ? 2 : 1); ++rep_)
    REP(1) if (PHMASK & 1) p0_prologue(a, F);
    GRID_BAR();
    for (int l = 0; l < 4; ++l) {
        const int i = l >> 1;
        if ((l & 1) == 0) {
            if (l == 0 && (PHMASK & 2)) { pg8::SchedKV S{ws, F.G, cid}; pg8::EpiPlain E;
              pg8::gemm_phase<pg8::EpiPlain, pg8::SchedKV, true>(F.lds, F.wave, D, D, D, S, E); }
            REP(8) if (PHMASK & 8) { pg8::SchedMain S{(const char*)HB, (const char*)(ws + WS_WIN_T) + (size_t)i * EVEN_IN * D * 2, nullptr, (size_t)256 * D * 2, (size_t)256 * D * 2, 0, 0, 0, 64, 16, 64, 64, F.G, cid};
              pg8::EpiEven E{SS + (size_t)(3 * l) * M, a.in[9] + (size_t)i * 3 * AW, YY, BIG, HG, HG + 2 * MiB};
              pg8::gemm_phase<pg8::EpiEven, pg8::SchedMain, true>(F.lds, F.wave, D, D, D, S, E); }
            GRID_BAR();
            if (l == 0 && (PHMASK & 4)) { pg8::SchedWSVW S{ws, (const float*)(ws + WS_GXS), F.G, cid}; pg8::EpiPlain E;
              pg8::gemm_phase<pg8::EpiPlain, pg8::SchedWSVW, true>(F.lds, F.wave, D, D, XHD, S, E); }
            REP(16) if (PHMASK & 16) phase_ya_fixup(HG, HG + 2 * MiB, a.in[9] + (size_t)i * 3 * AW, YY, F);
            REP(32) if (PHMASK & 32) phase_s5(BIG, (const float*)(ws + WS_S5P) + (size_t)i * 4096 * 34, a.in[15] + (size_t)i * 65536, a.in[16] + (size_t)i * 65536, a.in[17] + i * 1024, a.in[18] + (size_t)i * 16384, YY, F);
            GRID_BAR();
        } else {
            REP(64) if (PHMASK & 64) { pg8::SchedMain S{(const char*)HB, (const char*)(ws + WS_WQKV_T) + (size_t)i * ODD_IN * D * 2, (char*)BIG, (size_t)256 * D * 2, (size_t)256 * D * 2, 0, (size_t)256 * ODD_IN * 2, 256 * 2, 64, 10, 64, 256, F.G, cid};
              pg8::EpiRowScale E{SS + (size_t)(3 * l) * M, (const float*)(ws + WS_QKVB) + i * ODD_IN, ODD_IN};
              pg8::gemm_phase<pg8::EpiRowScale, pg8::SchedMain, true>(F.lds, F.wave, D, D, D, S, E); }
            GRID_BAR();
            REP(128) if (PHMASK & 128) phase_swa(BIG, a.in[7], a.in[22] + i * NQH, YY, F);
            GRID_BAR();
        }
        REP(256) if (PHMASK & 256) { const char* Bw = (l & 1) ? (const char*)(ws + WS_OWOUT_T) + (size_t)i * D * D * 2 : (const char*)(ws + WS_EWOUT_T) + (size_t)i * D * D * 2;
          pg8::SchedMain S{(const char*)YY, Bw, nullptr, (size_t)256 * D * 2, (size_t)256 * D * 2, 0, 0, 0, 64, 8, 64, 256, F.G, cid};
          pg8::EpiRes E{HB, rep_ ? DUMB : HB, SS + (size_t)(rep_ ? 13 : 3 * l + 1) * M, F.lds + RING_BYTES};
          pg8::gemm_phase<pg8::EpiRes, pg8::SchedMain, true>(F.lds, F.wave, D, D, D, S, E); }
        GRID_BAR();
        REP(512) if (PHMASK & 512) { pg8::SchedMain S{(const char*)HB, (const char*)(ws + WS_WS) + (size_t)l * 4 * 1024 * D * 2, (char*)BIG, (size_t)256 * D * 2, (size_t)256 * D * 2, (size_t)1024 * D * 2, (size_t)256 * 1024 * 2, 256 * 2, 64, 4, 16, 256, F.G, cid};
          pg8::EpiSoftmax E{SS + (size_t)(3 * l + 1) * M, 1024};
          pg8::gemm_phase<pg8::EpiSoftmax, pg8::SchedMain, false>(F.lds, F.wave, D, D, D, S, E); }
        GRID_BAR();
        REP(1024) if (PHMASK & 1024) { pg8::SchedMain S{(const char*)BIG, (const char*)(ws + WS_VW) + (size_t)l * 4 * D * 1024 * 2, nullptr, (size_t)256 * 1024 * 2, (size_t)256 * 1024 * 2, (size_t)D * 1024 * 2, 0, 0, 64, 8, 16, 256, F.G, cid};
          pg8::EpiRes E{HB, rep_ ? DUMB : HB, SS + (size_t)(rep_ ? 13 : 3 * l + 2) * M, F.lds + RING_BYTES};
          pg8::gemm_phase<pg8::EpiRes, pg8::SchedMain, true>(F.lds, F.wave, 1024, 1024, 1024, S, E); }
        GRID_BAR();
        REP(2048) if (PHMASK & 2048) { pg8::SchedMain S{(const char*)HB, (const char*)(ws + WS_WGU_T) + (size_t)l * NGU * D * 2, (char*)BIG, (size_t)256 * D * 2, (size_t)256 * D * 2, 0, (size_t)256 * DFF * 2, 128 * 2, 64, 44, 64, 128, F.G, cid};
          {
            PHASE_TID(F, tid, lane, gt); pg8::Unit fu; int nslots = 0, lastpm = -1;
            const float* cwp = a.in[29] + (size_t)l * 3 * DFF; const float* cbp = a.in[30] + (size_t)l * DFF; const i64* ssp = SS + (size_t)(3 * l + 2) * M;
            for (int ui = 0; ui < 12 && S.next(ui, fu); ++ui) {
                const int pm = fu.row0 >> 8;
                if (pm != lastpm && nslots < 3) { if (tid < 256) ((LAS float*)(F.lds + F1_RST_OFF))[nslots * 256 + tid] = rstd_of(ssp[pm * 256 + tid]); ++nslots; lastpm = pm; }
                if (tid == 0) ((LAS int*)(F.lds + F1_SLOT_OFF))[ui] = nslots - 1;
                const int vec = tid >> 7, ch = tid & 127;
                ((LAS float*)(F.lds + F1_CWT_OFF))[ui * 512 + tid] = (vec < 3 ? cwp[vec * DFF + fu.col0 + ch] : cbp[fu.col0 + ch]) * 1.4426950408889634f;
            }
            LDS_WAIT(); __syncthreads(); }
          pg8::EpiMLP E{F.lds, HG, HU};
          pg8::gemm_phase<pg8::EpiMLP, pg8::SchedMain, F1_ALIGN>(F.lds, F.wave, D, D, D, S, E);
          if (PROBE_KONLY & 2048) { pg8::EpiNull E0; pg8::gemm_phase<pg8::EpiNull, pg8::SchedMain, true>(F.lds, F.wave, D, D, D, S, E0); } }
        GRID_BAR();
        if (PHMASK & 4096) phase_mlp_fixup(HG, HU, a.in[29] + (size_t)l * 3 * DFF, a.in[30] + (size_t)l * DFF, BIG, F);
        GRID_BAR();
        REP(8192) if (PHMASK & 8192) { pg8::SchedMain S{(const char*)BIG, (const char*)(ws + WS_WDOWN_T) + (size_t)l * D * DFF * 2, nullptr, (size_t)256 * DFF * 2, (size_t)256 * DFF * 2, 0, 0, 0, 64, 8, 64, 256, F.G, cid, F2_WGM};
          pg8::EpiRes E{HB, rep_ ? DUMB : HB, SS + (size_t)(rep_ ? 13 : 3 * l + 3) * M, F.lds + RING_BYTES};
          pg8::gemm_phase<pg8::EpiRes, pg8::SchedMain, true>(F.lds, F.wave, DFF, DFF, DFF, S, E); }
        GRID_BAR();
    }
    if (PHMASK & 16384) phase_final(HB, SS + (size_t)12 * M, a.in[5], a.out, F);
#undef GRID_BAR
}

extern "C" void kernel_launch(void* const* d_in, const int* in_sizes, int n_in, void* d_out, int out_size, void* d_ws, size_t ws_size, hipStream_t stream) {
    static int grid = 0;
    if (grid == 0) {
        if (n_in != 32 || out_size != M * D || ws_size < WS_END) { fprintf(stderr, "kernel_launch: unexpected shapes (n_in %d out %d ws %zu)\n", n_in, out_size, ws_size); grid = -1; return; }
        int dev = 0, cus = 0, per_cu = 0;
        if (hipGetDevice(&dev) != hipSuccess || hipDeviceGetAttribute(&cus, hipDeviceAttributeMultiprocessorCount, dev) != hipSuccess) { grid = -1; return; }
        if (hipFuncSetAttribute((const void*)mega_fwd, hipFuncAttributeMaxDynamicSharedMemorySize, LDS_BYTES) != hipSuccess) { fprintf(stderr, "kernel_launch: hipFuncSetAttribute failed\n"); grid = -1; return; }
        if (hipOccupancyMaxActiveBlocksPerMultiprocessor(&per_cu, (const void*)mega_fwd, NTHR, LDS_BYTES) != hipSuccess || per_cu < 1) { fprintf(stderr, "kernel_launch: occupancy query says %d\n", per_cu); }
        (void)hipGetLastError();
        grid = cus;
    }
    if (grid < 0) return;
    if (hipMemsetAsync((char*)d_ws + WS_CTL, 0, CTL_ZERO_BYTES, stream) != hipSuccess) return;
    Args a{};
    for (int i = 0; i < 32; ++i) a.in[i] = (const float*)d_in[i];
    a.out = (float*)d_out; a.ws = (unsigned char*)d_ws;
    hipLaunchKernelGGL(mega_fwd, dim3(grid), dim3(NTHR), LDS_BYTES, stream, a);
}
```

```cpp
#include <hip/hip_runtime.h>
#include <stdint.h>
#include <stdio.h>

#define LAS __attribute__((address_space(3)))
#define GAS __attribute__((address_space(1)))
typedef unsigned short bf16_t;
typedef short bf16x8 __attribute__((ext_vector_type(8)));
typedef float f32x4 __attribute__((ext_vector_type(4)));
typedef float f32x2 __attribute__((ext_vector_type(2)));
typedef unsigned u32x4 __attribute__((ext_vector_type(4)));
typedef unsigned u32x2 __attribute__((ext_vector_type(2)));
typedef GAS unsigned gu32;

constexpr int D = 2048, NB = 4, L = 4096, M = NB * L, NMEM = 256, MROWS = NB * NMEM;
constexpr int AW = 1024, S5G = 64, EVEN_IN = 4096;
constexpr int HD = 64, NQH = 32, NKVH = 4, ODD_IN = 2560;
constexpr int XH = 4, XHD = 512, DFF = 5632, NGU = 2 * DFF;
constexpr float EPS = 1e-5f;
constexpr int NWAVES = 8, NTHR = 512;

constexpr size_t MiB = 1u << 20;
constexpr size_t WS_CTL = 0, CTL_ZERO_BYTES = 32768;
constexpr size_t WS_QKVB = 1 * MiB;
constexpr size_t WS_GXS = 1 * MiB + 64 * 1024;
constexpr size_t WS_WIN_T = 2 * MiB;
constexpr size_t WS_EWOUT_T = 34 * MiB;
constexpr size_t WS_WQKV_T = 50 * MiB;
constexpr size_t WS_OWOUT_T = 70 * MiB;
constexpr size_t WS_WS = 86 * MiB;
constexpr size_t WS_VW = 150 * MiB;
constexpr size_t WS_WGU_T = 214 * MiB;
constexpr size_t WS_WDOWN_T = 390 * MiB;
constexpr size_t WS_H = 478 * MiB;
constexpr size_t WS_HB = 606 * MiB;
constexpr size_t WS_YY = 670 * MiB;
constexpr size_t WS_BIG = 734 * MiB;
constexpr size_t WS_WQ_BF = WS_H;
constexpr size_t WS_WKV_T = WS_H + 32 * MiB;
constexpr size_t WS_WO_T = WS_H + 96 * MiB;
constexpr size_t WS_KVM = 952 * MiB;
constexpr size_t WS_MEMN = 984 * MiB;
constexpr size_t WS_HALO_G = 910 * MiB;
constexpr size_t WS_HALO_U = 934 * MiB;
constexpr size_t WS_S5P = 946 * MiB;
constexpr size_t WS_SS = 948 * MiB;
constexpr size_t WS_END = 990 * MiB;

constexpr int CW_BAR = 4096;

constexpr int RING_BYTES = 131072;
constexpr int LDS_BYTES = 163840;
constexpr int MISC_OFF = LDS_BYTES - 256;
constexpr int F1_CWT_OFF = RING_BYTES, F1_RST_OFF = RING_BYTES + 12 * 2048, F1_SLOT_OFF = F1_RST_OFF + 3 * 1024;

#define RLX_AGENT __ATOMIC_RELAXED, __HIP_MEMORY_SCOPE_AGENT
#define LDS_WAIT() asm volatile("s_waitcnt lgkmcnt(0)" ::: "memory")
#define VM_WAIT() asm volatile("s_waitcnt vmcnt(0)" ::: "memory")
__device__ __forceinline__ unsigned cvt_pk_bf16(float lo, float hi) { unsigned r; asm volatile("v_cvt_pk_bf16_f32 %0, %1, %2" : "=v"(r) : "v"(lo), "v"(hi)); return r; }
__device__ __forceinline__ float bf_lo(unsigned w) { return __uint_as_float(w << 16); }
__device__ __forceinline__ float bf_hi(unsigned w) { return __uint_as_float(w & 0xffff0000u); }
__device__ __forceinline__ float bf1(bf16_t b) { return __uint_as_float(((unsigned)b) << 16); }
__device__ __forceinline__ float shx(float v, int mask, int lane) { return __builtin_bit_cast(float, __builtin_amdgcn_ds_bpermute((lane ^ mask) << 2, __builtin_bit_cast(int, v))); }
__device__ __forceinline__ float shl_(float v, int src, int lane) { (void)lane; return __builtin_bit_cast(float, __builtin_amdgcn_ds_bpermute(src << 2, __builtin_bit_cast(int, v))); }
__device__ __forceinline__ float wave_sum(float v, int lane) {
#pragma unroll
    for (int o = 1; o < 64; o <<= 1) v += shx(v, o, lane);
    return v;
}
__device__ __forceinline__ float wave_max(float v, int lane) {
#pragma unroll
    for (int o = 1; o < 64; o <<= 1) v = fmaxf(v, shx(v, o, lane));
    return v;
}
__device__ __forceinline__ float fast_exp(float x) { return __builtin_amdgcn_exp2f(x * 1.4426950408889634f); }
__device__ __forceinline__ float fast_sigmoid(float x) { return __builtin_amdgcn_rcpf(1.0f + fast_exp(-x)); }
__device__ __forceinline__ float gelu_tanh_f(float y) { const float u = 0.7978845608028654f * (y + 0.044715f * y * y * y); return y * fast_sigmoid(2.0f * u); }

__device__ const unsigned char kBucket[128] = {
 0,1,2,3,4,5,6,7,8,9,10,11,12,13,14,15,
 16,16,16,17,17,18,18,18,19,19,19,20,20,20,20,21,21,21,21,22,22,22,22,22,
 23,23,23,23,23,23,24,24,24,24,24,24,25,25,25,25,25,25,25,26,26,26,26,26,
 26,26,26,27,27,27,27,27,27,27,27,27,27,28,28,28,28,28,28,28,28,28,28,29,
 29,29,29,29,29,29,29,29,29,29,29,30,30,30,30,30,30,30,30,30,30,30,30,30,
 30,31,31,31,31,31,31,31,31,31,31,31,31,31,31,31};

typedef long long i64;
constexpr float SS_SCALE = 16777216.0f, SS_INV = 1.0f / (16777216.0f * 2048.0f);
__device__ __forceinline__ float rstd_of(const i64 v) { return __builtin_amdgcn_rsqf((float)v * SS_INV + EPS); }
__device__ __forceinline__ int lane_id() { return (int)__builtin_amdgcn_mbcnt_hi(~0u, __builtin_amdgcn_mbcnt_lo(~0u, 0u)); }
#define XB_TMO      128
#define XB_XCNT(j)  (256  + 64 * (j))
#define XB_XSUB(j)  (1280 + 64 * (j))
#define XB_XGEN(j)  (2304 + 64 * (j))
#define XB_TOP      3328
#define XB_TOPGEN   3392
#define XCD_BAR_WORDS 3456
#define XB_SPIN_CAP (1u << 22)

__device__ __forceinline__ unsigned xb_ld(unsigned* p)              { return __hip_atomic_load(p, __ATOMIC_RELAXED, __HIP_MEMORY_SCOPE_AGENT); }
__device__ __forceinline__ unsigned xb_add(unsigned* p, unsigned v) { return __hip_atomic_fetch_add(p, v, __ATOMIC_RELAXED, __HIP_MEMORY_SCOPE_AGENT); }
__device__ __forceinline__ unsigned xb_xcc_id() { return (unsigned)__builtin_amdgcn_s_getreg((3 << 11) | 20) & 0xFu; }
#define XB_SPIN(cond, bar) do { unsigned _sp = 0; while (cond) { __builtin_amdgcn_s_sleep(1); \
    if ((++_sp & 255u) == 0u) { if (xb_ld(&(bar)[XB_TMO])) break; if (_sp > XB_SPIN_CAP) { atomicAdd(&(bar)[XB_TMO], 1u); break; } } } } while (0)

struct XcdBarrier { unsigned* bar; unsigned x; volatile LAS unsigned* st; int wave; };

__device__ __forceinline__ XcdBarrier xcd_barrier_post(unsigned* bar, volatile LAS unsigned* st, int wave) {
    XcdBarrier b; b.bar = bar; b.x = xb_xcc_id(); b.st = st; b.wave = wave;
    if (wave == 0 && lane_id() == 0) (void)xb_add(&bar[XB_XCNT(b.x)], 1u);
    return b;
}
__device__ __forceinline__ void xcd_barrier_complete(unsigned* bar, unsigned x, unsigned& nloc, unsigned& nx) {
    const unsigned G = gridDim.x * gridDim.y * gridDim.z;
    unsigned sum, cnt, mine, sp = 0u;
    for (;;) {
        sum = 0u; cnt = 0u; mine = 0u;
#pragma unroll
        for (unsigned j = 0; j < 16; ++j) { const unsigned c = xb_ld(&bar[XB_XCNT(j)]); sum += c; cnt += (c > 0u) ? 1u : 0u; mine = (j == x) ? c : mine; }
        if (sum == G) break;
        __builtin_amdgcn_s_sleep(1);
        if ((++sp & 255u) == 0u) { if (xb_ld(&bar[XB_TMO])) break; if (sp > XB_SPIN_CAP) { atomicAdd(&bar[XB_TMO], 1u); break; } }
    }
    nloc = mine > 0u ? mine : 1u; nx = cnt > 0u ? cnt : 1u;
}
__device__ __forceinline__ void xcd_barrier(const XcdBarrier& b) {
    asm volatile("s_waitcnt vmcnt(0)" ::: "memory");
    __syncthreads();
    int wv = b.wave; asm volatile("" : "+s"(wv));
    if (wv == 0 && lane_id() == 0) {
        unsigned* bar = b.bar; asm volatile("" : "+s"(bar));
        const unsigned bx = xb_xcc_id();
        __builtin_amdgcn_s_waitcnt(0);
        unsigned nloc = b.st[0], nx = b.st[1];
        if (nloc == 0u) { xcd_barrier_complete(bar, bx, nloc, nx); b.st[0] = nloc; b.st[1] = nx; }
        const unsigned old = xb_add(&bar[XB_XSUB(bx)], 1u);
        const unsigned gen = old / nloc;
        if (old + 1u == (gen + 1u) * nloc) {
            __builtin_amdgcn_fence(__ATOMIC_RELEASE, "agent");
            asm volatile("s_waitcnt vmcnt(0)" ::: "memory");
            const unsigned og = xb_add(&bar[XB_TOP], 1u);
            const unsigned tg = og / nx;
            if (og + 1u == (tg + 1u) * nx) xb_add(&bar[XB_TOPGEN], 1u);
            else XB_SPIN(xb_ld(&bar[XB_TOPGEN]) == tg, bar);
            __builtin_amdgcn_fence(__ATOMIC_ACQUIRE, "agent");
            xb_add(&bar[XB_XGEN(bx)], 1u);
            asm volatile("s_waitcnt vmcnt(0)" ::: "memory");
        } else {
            XB_SPIN(xb_ld(&bar[XB_XGEN(bx)]) == gen, bar);
            __builtin_amdgcn_fence(__ATOMIC_ACQUIRE, "agent");
            asm volatile("s_waitcnt vmcnt(0)" ::: "memory");
        }
    }
    __syncthreads();
}

namespace pg8 {
constexpr int BM = 256, BK = 64, HALF = 128, HTB = HALF * BK * 2, STAGE_BYTES = 8 * HTB, NXCD = 8, WGM = 8;
__host__ __device__ __forceinline__ int lds_byte(int r, int c) { const int st = (r >> 4) * 2 + (c >> 5), rr = r & 15, cc = c & 31, ob = rr * 64 + cc * 2; return st * 1024 + (ob ^ (((ob >> 9) & 1) << 5)); }
__host__ __device__ __forceinline__ void stage_rc(int b, int& R, int& C) { const int st = b / 1024, sb = b % 1024, swz = sb ^ (((sb >> 9) & 1) << 5); R = (st >> 1) * 16 + swz / 64; C = (st & 1) * 32 + (swz % 64) / 2; }
__host__ __device__ __forceinline__ int perm32(int rho) { const int n = rho >> 4, i = rho & 15; return 8 * (i >> 2) + 4 * n + (i & 3); }

struct Unit { const char* A; const char* B; char* C; const float* vec; int row0, col0, aux; };

__device__ __forceinline__ void tile_of(int wgid, int nM, int nN, int& pm, int& pn, const int WGM = 8) {
    const int nwg = nM * nN;
    { const int q = nwg / NXCD, r = nwg % NXCD, xcd = wgid % NXCD, off = wgid / NXCD; wgid = (xcd < r ? xcd * (q + 1) : r * (q + 1) + (xcd - r) * q) + off; }
    const int nig = WGM * nN, gid = wgid / nig, fm = gid * WGM, gsz = (nM - fm) < WGM ? (nM - fm) : WGM;
    pm = fm + ((wgid % nig) % gsz); pn = (wgid % nig) / gsz;
}

template <class Epi, class Sched, bool ALIGN_EPI>
__device__ __forceinline__ void gemm_phase(LAS unsigned char* lds, const int wave_, const int lda, const int ldb, const int K, const Sched& S, const Epi& E) {
    int lane_ = lane_id(); asm volatile("" : "+v"(lane_));
    int wv_ = wave_; asm volatile("" : "+s"(wv_));
    const int wid = wv_, lane = lane_, tid = wid * 64 + lane, wr = wid >> 2, wc = wid & 3, fr = lane & 15, fq = lane >> 4;
    const int nt = K / BK;
    unsigned voffA[2], voffB[2];
#pragma unroll
    for (int i = 0; i < 2; ++i) { int R, C; stage_rc(tid * 16 + i * 8192, R, C); const int Rb = (R & ~31) + perm32(R & 31);
        const int Ra = Epi::APERM ? ((R & ~63) + 4 * (R & 15) + ((R >> 4) & 3)) : R;
        voffA[i] = (unsigned)(Ra * lda + C) * 2u; voffB[i] = (unsigned)(Rb * ldb + C) * 2u; }
    const size_t kstep = (size_t)(BK * 2);
    const size_t hsA = (size_t)HALF * lda * 2, hsB = (size_t)HALF * ldb * 2;
    const unsigned ldsw = (unsigned)wid * 1024u;
    const int aoff = lds_byte(wr * 64 + fr, fq * 8), boff = lds_byte(wc * 32 + fr, fq * 8);
#define PG8_SA(b, h) (((b) * 2 + (h)) * HTB)
#define PG8_SB(b, h) ((4 + (b) * 2 + (h)) * HTB)
#define PG8_STAGE(bufoff, gbase, voff) do { _Pragma("unroll") for (int _i = 0; _i < 2; ++_i) \
        __builtin_amdgcn_global_load_lds((const unsigned*)((const char*)(gbase) + (voff)[_i]), (LAS unsigned*)(lds + (bufoff) + ldsw + _i * 8192), 16, 0, 0); } while (0)
#define PG8_LDA(dst, b, h) do { _Pragma("unroll") for (int m = 0; m < 4; ++m) _Pragma("unroll") for (int k = 0; k < 2; ++k) dst[m][k] = *(const LAS bf16x8*)(lds + PG8_SA(b, h) + aoff + m * 2048 + k * 1024); } while (0)
#define PG8_LDB(dst, b, h) do { _Pragma("unroll") for (int n = 0; n < 2; ++n) _Pragma("unroll") for (int k = 0; k < 2; ++k) dst[n][k] = *(const LAS bf16x8*)(lds + PG8_SB(b, h) + boff + n * 2048 + k * 1024); } while (0)
#define PG8_MMA(ai, bj, At, Bt) do { __builtin_amdgcn_s_setprio(1); _Pragma("unroll") for (int m = 0; m < 4; ++m) _Pragma("unroll") for (int n = 0; n < 2; ++n) _Pragma("unroll") for (int k = 0; k < 2; ++k) \
        acc[ai][bj][m][n] = __builtin_amdgcn_mfma_f32_16x16x32_bf16(Bt[n][k], At[m][k], acc[ai][bj][m][n], 0, 0, 0); __builtin_amdgcn_s_setprio(0); } while (0)
#define PG8_WAIT_V(n) asm volatile("s_waitcnt vmcnt(" #n ")" ::: "memory")
#define PG8_WAIT_L(n) asm volatile("s_waitcnt lgkmcnt(" #n ")" ::: "memory")
#define PG8_BAR __builtin_amdgcn_s_barrier()
#define PG8_SCHED __builtin_amdgcn_sched_barrier(0)
    Unit cur, nxt; int ui = 0;
    if (!S.next(0, cur)) return;
    f32x4 acc[2][2][4][2];
    if constexpr (Epi::PRELOAD) E.preload(acc, cur, wr, wc);
    else {
#pragma unroll
    for (int a = 0; a < 2; ++a)
#pragma unroll
        for (int b = 0; b < 2; ++b)
#pragma unroll
            for (int m = 0; m < 4; ++m)
#pragma unroll
                for (int n = 0; n < 2; ++n) acc[a][b][m][n] = (f32x4){0.f, 0.f, 0.f, 0.f};
    }
    bf16x8 At[4][2], B0[2][2], B1[2][2];
    const char* cA = cur.A; const char* cB = cur.B;
#ifndef GEMM_SP2
#define GEMM_SP2 1
#endif
    constexpr bool SP2 = GEMM_SP2;
    if constexpr (SP2) {
    PG8_STAGE(PG8_SB(0, 0), cB, voffB); PG8_STAGE(PG8_SB(0, 1), cB + hsB, voffB); PG8_STAGE(PG8_SA(0, 0), cA, voffA); PG8_STAGE(PG8_SA(0, 1), cA + hsA, voffA);
    if (wr == 1) PG8_BAR;
    PG8_WAIT_V(2); PG8_BAR;
    PG8_STAGE(PG8_SB(1, 0), cB + kstep, voffB); PG8_STAGE(PG8_SA(1, 0), cA + kstep, voffA); PG8_STAGE(PG8_SB(1, 1), cB + hsB + kstep, voffB);
    PG8_WAIT_V(6); PG8_BAR;
    } else {
    PG8_STAGE(PG8_SB(0, 0), cB, voffB); PG8_STAGE(PG8_SA(0, 0), cA, voffA); PG8_STAGE(PG8_SB(0, 1), cB + hsB, voffB); PG8_STAGE(PG8_SA(0, 1), cA + hsA, voffA);
    if (wr == 1) PG8_BAR;
    PG8_WAIT_V(4); PG8_BAR;
    PG8_STAGE(PG8_SB(1, 0), cB + kstep, voffB); PG8_STAGE(PG8_SA(1, 0), cA + kstep, voffA); PG8_STAGE(PG8_SB(1, 1), cB + hsB + kstep, voffB);
    PG8_WAIT_V(6); PG8_BAR;
    }
    for (;;) {
        const bool has_next = S.next(ui + 1, nxt);
        const char* nA = has_next ? nxt.A : cA; const char* nB = has_next ? nxt.B : cB;
#ifndef KLOOP_ALIGN
#define KLOOP_ALIGN 8
#endif
#define PG8_STR2(x) #x
#define PG8_STR(x) PG8_STR2(x)
        asm volatile(".p2align " PG8_STR(KLOOP_ALIGN));
        for (int t = 0; t < nt; t += 2) {
            const bool last = (t == nt - 2);
            const char* a1 = cA + (size_t)(t + 1) * kstep;
            const char* a2 = last ? nA : cA + (size_t)(t + 2) * kstep; const char* b2 = last ? nB : cB + (size_t)(t + 2) * kstep;
            const char* a3 = a2 + kstep; const char* b3 = b2 + kstep;
            if constexpr (SP2) {
            PG8_LDB(B0, 0, 0); PG8_LDB(B1, 0, 1); PG8_SCHED; PG8_LDA(At, 0, 0); PG8_STAGE(PG8_SA(1, 1), a1 + hsA, voffA);
            PG8_WAIT_V(8); PG8_WAIT_L(0); PG8_BAR; PG8_MMA(0, 0, At, B0); PG8_MMA(0, 1, At, B1); PG8_BAR; PG8_SCHED;
            PG8_LDA(At, 0, 1); PG8_STAGE(PG8_SB(0, 0), b2, voffB); PG8_STAGE(PG8_SB(0, 1), b2 + hsB, voffB); PG8_STAGE(PG8_SA(0, 0), a2, voffA);
            PG8_WAIT_V(8); PG8_WAIT_L(0); PG8_BAR; PG8_MMA(1, 0, At, B0); PG8_MMA(1, 1, At, B1); PG8_BAR; PG8_SCHED;
            PG8_LDB(B0, 1, 0); PG8_LDB(B1, 1, 1); PG8_SCHED; PG8_LDA(At, 1, 0); PG8_STAGE(PG8_SA(0, 1), a2 + hsA, voffA);
            PG8_WAIT_V(8); PG8_WAIT_L(0); PG8_BAR; PG8_MMA(0, 0, At, B0); PG8_MMA(0, 1, At, B1); PG8_BAR; PG8_SCHED;
            PG8_LDA(At, 1, 1); PG8_STAGE(PG8_SB(1, 0), b3, voffB); PG8_STAGE(PG8_SB(1, 1), b3 + hsB, voffB); PG8_STAGE(PG8_SA(1, 0), a3, voffA);
            PG8_WAIT_V(8); PG8_WAIT_L(0); PG8_BAR; PG8_MMA(1, 0, At, B0); PG8_MMA(1, 1, At, B1); PG8_BAR; PG8_SCHED;
            } else {
            PG8_LDB(B0, 0, 0); PG8_SCHED; PG8_LDA(At, 0, 0); PG8_STAGE(PG8_SA(1, 1), a1 + hsA, voffA);
            PG8_WAIT_L(8); PG8_BAR; PG8_WAIT_L(0); PG8_MMA(0, 0, At, B0); PG8_BAR; PG8_SCHED;
            PG8_LDB(B1, 0, 1); PG8_STAGE(PG8_SB(0, 0), b2, voffB);
            PG8_BAR; PG8_WAIT_L(0); PG8_MMA(0, 1, At, B1); PG8_BAR;
            PG8_LDA(At, 0, 1); PG8_STAGE(PG8_SA(0, 0), a2, voffA);
            PG8_BAR; PG8_WAIT_L(0); PG8_MMA(1, 0, At, B0); PG8_BAR; PG8_SCHED;
            PG8_STAGE(PG8_SB(0, 1), b2 + hsB, voffB);
            PG8_WAIT_V(6); PG8_BAR; PG8_MMA(1, 1, At, B1); PG8_BAR;
            PG8_LDB(B0, 1, 0); PG8_SCHED; PG8_LDA(At, 1, 0); PG8_STAGE(PG8_SA(0, 1), a2 + hsA, voffA);
            PG8_WAIT_L(8); PG8_BAR; PG8_WAIT_L(0); PG8_MMA(0, 0, At, B0); PG8_BAR; PG8_SCHED;
            PG8_LDB(B1, 1, 1); PG8_STAGE(PG8_SB(1, 0), b3, voffB);
            PG8_BAR; PG8_WAIT_L(0); PG8_MMA(0, 1, At, B1); PG8_BAR;
            PG8_LDA(At, 1, 1); PG8_STAGE(PG8_SA(1, 0), a3, voffA);
            PG8_BAR; PG8_WAIT_L(0); PG8_MMA(1, 0, At, B0); PG8_BAR; PG8_SCHED;
            PG8_STAGE(PG8_SB(1, 1), b3 + hsB, voffB);
            PG8_WAIT_V(6); PG8_BAR; PG8_MMA(1, 1, At, B1); PG8_BAR;
            }
        }
        if constexpr (ALIGN_EPI) { if (wr == 0) PG8_BAR; }
        if constexpr (Epi::FUSEDPRE) { Unit pu = cur; if (has_next) pu = nxt; E.epi_pre(acc, cur, pu, has_next, wr, wc); if (!has_next) break; }
        else {
        if constexpr (!Epi::AFTER_DRAIN) { E(acc, cur, wr, wc, fr, fq); }
        if (!has_next) break;
        }
        if constexpr (Epi::FUSEDPRE) {}
        else if constexpr (Epi::PRELOAD) E.preload(acc, nxt, wr, wc);
        else {
#pragma unroll
        for (int a = 0; a < 2; ++a)
#pragma unroll
            for (int b = 0; b < 2; ++b)
#pragma unroll
                for (int m = 0; m < 4; ++m)
#pragma unroll
                    for (int n = 0; n < 2; ++n) acc[a][b][m][n] = (f32x4){0.f, 0.f, 0.f, 0.f};
        }
        cur = nxt; cA = nA; cB = nB; ++ui;
        if constexpr (ALIGN_EPI) { if (wr == 1) PG8_BAR; }
    }
    PG8_WAIT_V(0);
    if constexpr (!ALIGN_EPI) { if (wr == 0) PG8_BAR; }
    PG8_BAR;
    if constexpr (Epi::AFTER_DRAIN) { E.fused(acc, cur, wr, wc, fr, fq, lds, wid, lane); }
#undef PG8_SA
#undef PG8_SB
#undef PG8_STAGE
#undef PG8_LDA
#undef PG8_LDB
#undef PG8_MMA
#undef PG8_WAIT_V
#undef PG8_WAIT_L
#undef PG8_BAR
#undef PG8_SCHED
}
}
#ifndef DEF_WGM
#define DEF_WGM 4
#endif
namespace pg8 {
struct SchedMain {
    const char* A; const char* B; char* C; size_t tA, tB, bB, tC, cC; int nM, nN, bdiv, ccols, G, c, wgm = DEF_WGM;
    __device__ __forceinline__ bool next(int i, Unit& u) const {
        const long Lx = (long)i * G + c; if (Lx >= (long)nM * nN) return false;
        int pm, pn; tile_of((int)Lx, nM, nN, pm, pn, wgm);
        u.A = A + (size_t)pm * tA; u.B = B + (size_t)pn * tB + (size_t)(pm / bdiv) * bB; u.C = C + (size_t)pm * tC + (size_t)pn * cC;
        u.row0 = pm * BM; u.col0 = pn * ccols; u.aux = i; u.vec = nullptr; return true;
    }
};

struct EpiRowScale {
    static constexpr bool AFTER_DRAIN = false, PRELOAD = false, APERM = false, FUSEDPRE = false;
    const i64* ss; const float* bias; int ldc;
    __device__ __forceinline__ void operator()(f32x4 (&acc)[2][2][4][2], const Unit& u, int wr, int wc, int fr_, int fq_) const {
        int lane_ = lane_id(); asm volatile("" : "+v"(lane_)); const int fr = lane_ & 15, fq = lane_ >> 4; (void)fr_; (void)fq_;
        const int colw = wc * 32 + 8 * fq; const unsigned loff = (unsigned)((wr * 64 + fr) * ldc + colw) * 2u; const unsigned soff = (unsigned)(wr * 64 + fr) * 8u;
        i64 sv[2][4];
#pragma unroll
        for (int ai = 0; ai < 2; ++ai)
#pragma unroll
            for (int m = 0; m < 4; ++m) sv[ai][m] = *(const i64*)((const char*)(ss + u.row0 + ai * HALF + m * 16) + soff);
        f32x4 bv[2][2];
#pragma unroll
        for (int bj = 0; bj < 2; ++bj)
#pragma unroll
            for (int n = 0; n < 2; ++n) bv[bj][n] = bias ? *(const f32x4*)(bias + u.col0 + colw + bj * HALF + 4 * n) : (f32x4){0.f, 0.f, 0.f, 0.f};
#pragma unroll
        for (int ai = 0; ai < 2; ++ai)
#pragma unroll
            for (int m = 0; m < 4; ++m) {
                const int rb = ai * HALF + m * 16;
                const float rs = rstd_of(sv[ai][m]);
                char* rowp = u.C + (size_t)rb * ldc * 2 + loff;
#pragma unroll
                for (int bj = 0; bj < 2; ++bj) {
                    const f32x4 v0 = acc[ai][bj][m][0] * rs + bv[bj][0], v1 = acc[ai][bj][m][1] * rs + bv[bj][1];
                    u32x4 w; w.x = cvt_pk_bf16(v0[0], v0[1]); w.y = cvt_pk_bf16(v0[2], v0[3]); w.z = cvt_pk_bf16(v1[0], v1[1]); w.w = cvt_pk_bf16(v1[2], v1[3]);
                    *(u32x4*)(rowp + bj * HALF * 2) = w;
                }
            }
    }
};

struct EpiPlain {
    static constexpr bool AFTER_DRAIN = false, PRELOAD = false, APERM = false, FUSEDPRE = false;
    __device__ __forceinline__ void operator()(f32x4 (&acc)[2][2][4][2], const Unit& u, int wr, int wc, int fr_, int fq_) const {
        int lane_ = lane_id(); asm volatile("" : "+v"(lane_)); const int fr = lane_ & 15, fq = lane_ >> 4; (void)fr_; (void)fq_;
        const int colw = wc * 32 + 8 * fq, ldc = u.aux; const float* cs = (const float*)u.vec; const unsigned loff = (unsigned)((wr * 64 + fr) * ldc + colw) * 2u;
        f32x4 sv[2][2];
#pragma unroll
        for (int bj = 0; bj < 2; ++bj)
#pragma unroll
            for (int n = 0; n < 2; ++n) sv[bj][n] = cs ? *(const f32x4*)(cs + u.col0 + colw + bj * HALF + 4 * n) : (f32x4){1.f, 1.f, 1.f, 1.f};
#pragma unroll
        for (int ai = 0; ai < 2; ++ai)
#pragma unroll
            for (int m = 0; m < 4; ++m) {
                char* rowp = u.C + (size_t)(ai * HALF + m * 16) * ldc * 2 + loff;
#pragma unroll
                for (int bj = 0; bj < 2; ++bj) {
                    const f32x4 v0 = acc[ai][bj][m][0] * sv[bj][0], v1 = acc[ai][bj][m][1] * sv[bj][1];
                    u32x4 w; w.x = cvt_pk_bf16(v0[0], v0[1]); w.y = cvt_pk_bf16(v0[2], v0[3]); w.z = cvt_pk_bf16(v1[0], v1[1]); w.w = cvt_pk_bf16(v1[2], v1[3]);
                    *(u32x4*)(rowp + bj * HALF * 2) = w;
                }
            }
    }
};

struct EpiRes {
    static constexpr bool AFTER_DRAIN = false, PRELOAD = true, APERM = false, FUSEDPRE = true;
    bf16_t* hb; bf16_t* hbo; i64* ssout; LAS unsigned char* lds_spare;
    __device__ __forceinline__ void preload(f32x4 (&acc)[2][2][4][2], const Unit& u, int wr, int wc) const {
        int lane_ = lane_id(); asm volatile("" : "+v"(lane_)); const int fr = lane_ & 15, fq = lane_ >> 4;
        const unsigned l2 = (unsigned)((wr * 64 + fr) * D + wc * 32 + 8 * fq) * 2u;
#pragma unroll
        for (int ai = 0; ai < 2; ++ai)
#pragma unroll
            for (int m = 0; m < 4; ++m) { const char* pin = (const char*)(hb + (size_t)(u.row0 + ai * HALF + m * 16) * D + u.col0) + l2;
#pragma unroll
                for (int bj = 0; bj < 2; ++bj) { const u32x4 w = *(const u32x4*)(pin + bj * HALF * 2);
                    acc[ai][bj][m][0] = (f32x4){bf_lo(w.x), bf_hi(w.x), bf_lo(w.y), bf_hi(w.y)}; acc[ai][bj][m][1] = (f32x4){bf_lo(w.z), bf_hi(w.z), bf_lo(w.w), bf_hi(w.w)}; } }
    }
    __device__ __forceinline__ void operator()(f32x4 (&)[2][2][4][2], const Unit&, int, int, int, int) const {}
    __device__ __forceinline__ void epi_pre(f32x4 (&acc)[2][2][4][2], const Unit& u, const Unit& nu, const bool has_next, int wr, int wc) const {
        int lane_ = lane_id(); asm volatile("" : "+v"(lane_)); const int fr = lane_ & 15, fq = lane_ >> 4;
        const unsigned l2 = (unsigned)((wr * 64 + fr) * D + wc * 32 + 8 * fq) * 2u;
        LAS float* T = (LAS float*)(lds_spare);
        u32x4 raw[2][4][2];
        if (has_next) {
#pragma unroll
        for (int ai = 0; ai < 2; ++ai)
#pragma unroll
            for (int m = 0; m < 4; ++m) { const char* pin = (const char*)(hb + (size_t)(nu.row0 + ai * HALF + m * 16) * D + nu.col0) + l2;
                asm volatile("global_load_dwordx4 %0, %2, off\n\tglobal_load_dwordx4 %1, %2, off offset:256" : "=&v"(raw[ai][m][0]), "=&v"(raw[ai][m][1]) : "v"(pin) : "memory"); }
        }
#pragma unroll
        for (int ai = 0; ai < 2; ++ai)
#pragma unroll
            for (int m = 0; m < 4; ++m) {
                char* pb = (char*)(hbo + (size_t)(u.row0 + ai * HALF + m * 16) * D + u.col0) + l2;
                float s = 0.f;
#pragma unroll
                for (int bj = 0; bj < 2; ++bj) {
                    const f32x4 o0 = acc[ai][bj][m][0], o1 = acc[ai][bj][m][1];
                    u32x4 w; w.x = cvt_pk_bf16(o0[0], o0[1]); w.y = cvt_pk_bf16(o0[2], o0[3]); w.z = cvt_pk_bf16(o1[0], o1[1]); w.w = cvt_pk_bf16(o1[2], o1[3]);
                    *(u32x4*)(pb + bj * HALF * 2) = w;
                    s += (o0[0] * o0[0] + o0[1] * o0[1]) + (o0[2] * o0[2] + o0[3] * o0[3]) + (o1[0] * o1[0] + o1[1] * o1[1]) + (o1[2] * o1[2] + o1[3] * o1[3]);
                }
                s += shx(s, 16, lane_); s += shx(s, 32, lane_);
                if (fq == 0) T[(ai * HALF + wr * 64 + m * 16 + fr) * 4 + wc] = s;
            }
        asm volatile("s_waitcnt lgkmcnt(0)" ::: "memory"); __builtin_amdgcn_s_barrier(); asm volatile("" ::: "memory");
        if (lane_ < 32) { const int row = (wr * 4 + wc) * 32 + lane_; const f32x4 p = *(const LAS f32x4*)(T + row * 4);
            __hip_atomic_fetch_add(ssout + u.row0 + row, (i64)(((p[0] + p[1]) + (p[2] + p[3])) * SS_SCALE), __ATOMIC_RELAXED, __HIP_MEMORY_SCOPE_AGENT); }
        if (!has_next) return;
        asm volatile("s_waitcnt vmcnt(16)" : "+v"(raw[0][0][0]), "+v"(raw[0][0][1]), "+v"(raw[0][1][0]), "+v"(raw[0][1][1]), "+v"(raw[0][2][0]), "+v"(raw[0][2][1]), "+v"(raw[0][3][0]), "+v"(raw[0][3][1]),
                                           "+v"(raw[1][0][0]), "+v"(raw[1][0][1]), "+v"(raw[1][1][0]), "+v"(raw[1][1][1]), "+v"(raw[1][2][0]), "+v"(raw[1][2][1]), "+v"(raw[1][3][0]), "+v"(raw[1][3][1]) :: "memory");
#pragma unroll
        for (int ai = 0; ai < 2; ++ai)
#pragma unroll
            for (int m = 0; m < 4; ++m)
#pragma unroll
                for (int bj = 0; bj < 2; ++bj) { const u32x4 w = raw[ai][m][bj];
                    acc[ai][bj][m][0] = (f32x4){bf_lo(w.x), bf_hi(w.x), bf_lo(w.y), bf_hi(w.y)}; acc[ai][bj][m][1] = (f32x4){bf_lo(w.z), bf_hi(w.z), bf_lo(w.w), bf_hi(w.w)}; }
    }
};

struct EpiSoftmax {
    static constexpr bool AFTER_DRAIN = true, PRELOAD = false, APERM = false, FUSEDPRE = false;
    const i64* ss; int ldc;
    __device__ __forceinline__ void operator()(f32x4 (&)[2][2][4][2], const Unit&, int, int, int, int) const {}
    __device__ __forceinline__ void fused(f32x4 (&acc)[2][2][4][2], const Unit& u, int wr, int wc, int fr_, int fq_, LAS unsigned char* lds, int wid, int lane) const {
        int lane_ = lane_id(); asm volatile("" : "+v"(lane_)); const int fr = lane_ & 15, fq = lane_ >> 4; (void)fr_; (void)fq_;
        LAS f32x2* T = (LAS f32x2*)lds;
        const unsigned loff = (unsigned)((wr * 64 + fr) * ldc + wc * 32 + 8 * fq) * 2u, soff = (unsigned)(wr * 64 + fr) * 8u;
        float mown[2][4]; i64 sv[2][4];
#pragma unroll
        for (int ai = 0; ai < 2; ++ai)
#pragma unroll
            for (int m = 0; m < 4; ++m) sv[ai][m] = *(const i64*)((const char*)(ss + u.row0 + ai * HALF + m * 16) + soff);
#pragma unroll
        for (int ai = 0; ai < 2; ++ai)
#pragma unroll
            for (int m = 0; m < 4; ++m) {
                const int r = ai * HALF + wr * 64 + m * 16 + fr;
                const float rs = rstd_of(sv[ai][m]);
                float mx = -3.0e38f;
#pragma unroll
                for (int bj = 0; bj < 2; ++bj)
#pragma unroll
                    for (int n = 0; n < 2; ++n) { f32x4 v = acc[ai][bj][m][n] * rs; acc[ai][bj][m][n] = v; mx = fmaxf(fmaxf(mx, fmaxf(v[0], v[1])), fmaxf(v[2], v[3])); }
                mx = fmaxf(mx, shx(mx, 16, lane_)); mx = fmaxf(mx, shx(mx, 32, lane_));
                float l = 0.f;
#pragma unroll
                for (int bj = 0; bj < 2; ++bj)
#pragma unroll
                    for (int n = 0; n < 2; ++n) { f32x4 v = acc[ai][bj][m][n]; v[0] = fast_exp(v[0] - mx); v[1] = fast_exp(v[1] - mx); v[2] = fast_exp(v[2] - mx); v[3] = fast_exp(v[3] - mx); acc[ai][bj][m][n] = v; l += (v[0] + v[1]) + (v[2] + v[3]); }
                l += shx(l, 16, lane_); l += shx(l, 32, lane_);
                mown[ai][m] = mx;
                if (fq == 0) T[r * 4 + wc] = (f32x2){mx, l};
            }
        asm volatile("s_waitcnt lgkmcnt(0)" ::: "memory"); __builtin_amdgcn_s_barrier(); asm volatile("" ::: "memory");
#pragma unroll
        for (int ai = 0; ai < 2; ++ai)
#pragma unroll
            for (int m = 0; m < 4; ++m) {
                const int r = ai * HALF + wr * 64 + m * 16 + fr;
                const f32x2 a = T[r * 4 + 0], b = T[r * 4 + 1], c = T[r * 4 + 2], d = T[r * 4 + 3];
                const float Mx = fmaxf(fmaxf(a.x, b.x), fmaxf(c.x, d.x));
                const float Ls = a.y * fast_exp(a.x - Mx) + b.y * fast_exp(b.x - Mx) + c.y * fast_exp(c.x - Mx) + d.y * fast_exp(d.x - Mx);
                const float f = fast_exp(mown[ai][m] - Mx) * __builtin_amdgcn_rcpf(Ls);
                char* rowp = u.C + (size_t)(ai * HALF + m * 16) * ldc * 2 + loff;
#pragma unroll
                for (int bj = 0; bj < 2; ++bj) {
                    const f32x4 v0 = acc[ai][bj][m][0] * f, v1 = acc[ai][bj][m][1] * f;
                    u32x4 w; w.x = cvt_pk_bf16(v0[0], v0[1]); w.y = cvt_pk_bf16(v0[2], v0[3]); w.z = cvt_pk_bf16(v1[0], v1[1]); w.w = cvt_pk_bf16(v1[2], v1[3]);
                    *(u32x4*)(rowp + bj * HALF * 2) = w;
                }
            }
    }
};

__device__ __forceinline__ float dpp_shr1z(float x) { return __builtin_bit_cast(float, __builtin_amdgcn_update_dpp(0, __builtin_bit_cast(int, x), 0x111  , 0xf, 0xf, true)); }
struct EpiMLP {
    static constexpr bool AFTER_DRAIN = false, PRELOAD = false, APERM = true, FUSEDPRE = false;
    LAS unsigned char* lds; float* halo_g; float* halo_u;
    __device__ __forceinline__ void operator()(f32x4 (&acc)[2][2][4][2], const Unit& u, int wr, int wc, int fr_, int fq_) const {
        int lane_ = lane_id(); asm volatile("" : "+v"(lane_)); const int fr = lane_ & 15, fq = lane_ >> 4; (void)fr_; (void)fq_;
        const int colw = wc * 32 + 8 * fq, ch0 = u.col0 + colw;
        const unsigned loff = (unsigned)((wr * 64 + 4 * fr) * DFF + colw) * 2u;
        const float LN2 = 0.6931471805599453f;
        const LAS float* cwt = (const LAS float*)(lds + F1_CWT_OFF) + u.aux * 512 + colw;
        const int slot = *(const LAS int*)(lds + F1_SLOT_OFF + u.aux * 4);
        const LAS float* rst = (const LAS float*)(lds + F1_RST_OFF) + slot * 256 + wr * 64 + 4 * fr;
        f32x4 w0[2], w1[2], w2[2], bb[2];
#pragma unroll
        for (int n = 0; n < 2; ++n) { w0[n] = *(const LAS f32x4*)(cwt + 4 * n); w1[n] = *(const LAS f32x4*)(cwt + 128 + 4 * n); w2[n] = *(const LAS f32x4*)(cwt + 256 + 4 * n); bb[n] = *(const LAS f32x4*)(cwt + 384 + 4 * n); }
#pragma unroll
        for (int ai = 0; ai < 2; ++ai) {
            const int rb = u.row0 + ai * HALF + wr * 64, blk = rb >> 6;
            const f32x4 rsv = *(const LAS f32x4*)(rst + ai * HALF);
            float rs[4], irsu[4];
#pragma unroll
            for (int m = 0; m < 4; ++m) { rs[m] = rsv[m]; irsu[m] = __builtin_amdgcn_rcpf(rs[m] * LN2); }
#pragma unroll
            for (int n = 0; n < 2; ++n) {
                f32x4 g[4];
#pragma unroll
                for (int m = 0; m < 4; ++m) g[m] = acc[ai][0][m][n] * rs[m];
                if (fr == 15) { *(f32x4*)(halo_g + ((size_t)blk * 4 + 0) * DFF + ch0 + 4 * n) = g[2]; *(f32x4*)(halo_g + ((size_t)blk * 4 + 1) * DFF + ch0 + 4 * n) = g[3]; }
                if (fr == 0) { *(f32x4*)(halo_g + ((size_t)blk * 4 + 2) * DFF + ch0 + 4 * n) = g[0]; *(f32x4*)(halo_g + ((size_t)blk * 4 + 3) * DFF + ch0 + 4 * n) = g[1];
                               *(f32x4*)(halo_u + ((size_t)blk * 2 + 0) * DFF + ch0 + 4 * n) = acc[ai][1][0][n] * rs[0]; *(f32x4*)(halo_u + ((size_t)blk * 2 + 1) * DFF + ch0 + 4 * n) = acc[ai][1][1][n] * rs[1]; }
                f32x4 pre[4];
#pragma unroll
                for (int j = 0; j < 4; ++j) {
                    const float s3 = dpp_shr1z(g[3][j]), s2 = dpp_shr1z(g[2][j]);
                    pre[0][j] = __builtin_fmaf(w2[n][j], g[0][j], __builtin_fmaf(w1[n][j], s3, __builtin_fmaf(w0[n][j], s2, bb[n][j])));
                    pre[1][j] = __builtin_fmaf(w2[n][j], g[1][j], __builtin_fmaf(w1[n][j], g[0][j], __builtin_fmaf(w0[n][j], s3, bb[n][j])));
                    pre[2][j] = __builtin_fmaf(w2[n][j], g[2][j], __builtin_fmaf(w1[n][j], g[1][j], __builtin_fmaf(w0[n][j], g[0][j], bb[n][j])));
                    pre[3][j] = __builtin_fmaf(w2[n][j], g[3][j], __builtin_fmaf(w1[n][j], g[2][j], __builtin_fmaf(w0[n][j], g[1][j], bb[n][j])));
                }
#pragma unroll
                for (int m = 0; m < 4; ++m) {
                    f32x4 a;
#pragma unroll
                    for (int j = 0; j < 4; ++j) { const float p = pre[m][j]; a[j] = (p * acc[ai][1][m][n][j]) * __builtin_amdgcn_rcpf(__builtin_fmaf(__builtin_amdgcn_exp2f(-p), irsu[m], irsu[m])); }
                    acc[ai][0][m][n] = a;
                }
            }
#pragma unroll
            for (int m = 0; m < 4; ++m) {
                const f32x4 v0 = acc[ai][0][m][0], v1 = acc[ai][0][m][1];
                u32x4 w; w.x = cvt_pk_bf16(v0[0], v0[1]); w.y = cvt_pk_bf16(v0[2], v0[3]); w.z = cvt_pk_bf16(v1[0], v1[1]); w.w = cvt_pk_bf16(v1[2], v1[3]);
                *(u32x4*)(u.C + (size_t)(ai * HALF + m) * DFF * 2 + loff) = w;
            }
        }
    }
};
struct EpiEven {
    static constexpr bool AFTER_DRAIN = false, PRELOAD = false, APERM = true, FUSEDPRE = false;
    const i64* ss; const float* cw; bf16_t* YY; bf16_t* UB; float* HV; float* HGB;
    __device__ __forceinline__ void operator()(f32x4 (&acc)[2][2][4][2], const Unit& u, int wr, int wc, int fr_, int fq_) const {
        int lane_ = lane_id(); asm volatile("" : "+v"(lane_)); const int fr = lane_ & 15, fq = lane_ >> 4; (void)fr_; (void)fq_;
        const int ch = u.col0 + 16 * wc + 4 * fq, g = (u.col0 >> 4) + wc;
        const unsigned soff = (unsigned)(wr * 64 + 4 * fr) * 8u;
        i64 sv[2][4];
#pragma unroll
        for (int ai = 0; ai < 2; ++ai)
#pragma unroll
            for (int m = 0; m < 4; ++m) sv[ai][m] = *(const i64*)((const char*)(ss + u.row0 + ai * HALF + m) + soff);
        const f32x4 w0 = *(const f32x4*)(cw + ch), w1 = *(const f32x4*)(cw + AW + ch), w2 = *(const f32x4*)(cw + 2 * AW + ch);
#pragma unroll
        for (int ai = 0; ai < 2; ++ai) {
            const int rb = u.row0 + ai * HALF + wr * 64, blk = rb >> 6;
            f32x4 gb[4], v[4], y[4];
#pragma unroll
            for (int m = 0; m < 4; ++m) { const float rs = rstd_of(sv[ai][m]); gb[m] = acc[ai][0][m][0] * rs; v[m] = (acc[ai][0][m][1] * rs) * (acc[ai][1][m][0] * rs); acc[ai][1][m][1] = acc[ai][1][m][1] * rs; }
            if (fr == 15) { *(f32x4*)(HV + ((size_t)blk * 4 + 0) * AW + ch) = v[2]; *(f32x4*)(HV + ((size_t)blk * 4 + 1) * AW + ch) = v[3]; }
            if (fr == 0) { *(f32x4*)(HV + ((size_t)blk * 4 + 2) * AW + ch) = v[0]; *(f32x4*)(HV + ((size_t)blk * 4 + 3) * AW + ch) = v[1];
                           *(f32x4*)(HGB + ((size_t)blk * 2 + 0) * AW + ch) = gb[0]; *(f32x4*)(HGB + ((size_t)blk * 2 + 1) * AW + ch) = gb[1]; }
#pragma unroll
            for (int j = 0; j < 4; ++j) {
                const float s3 = dpp_shr1z(v[3][j]), s2 = dpp_shr1z(v[2][j]);
                y[0][j] = w2[j] * v[0][j] + w1[j] * s3 + w0[j] * s2;
                y[1][j] = w2[j] * v[1][j] + w1[j] * v[0][j] + w0[j] * s3;
                y[2][j] = w2[j] * v[2][j] + w1[j] * v[1][j] + w0[j] * v[0][j];
                y[3][j] = w2[j] * v[3][j] + w1[j] * v[2][j] + w0[j] * v[1][j];
            }
#pragma unroll
            for (int m = 0; m < 4; ++m) {
                const size_t row = (size_t)(rb + 4 * fr + m);
                const f32x4 a = gb[m] * y[m], uu = acc[ai][1][m][1];
                u32x2 wa; wa.x = cvt_pk_bf16(a[0], a[1]); wa.y = cvt_pk_bf16(a[2], a[3]);
                u32x2 wu; wu.x = cvt_pk_bf16(uu[0], uu[1]); wu.y = cvt_pk_bf16(uu[2], uu[3]);
                *(u32x2*)(YY + row * D + ch) = wa;
                *(u32x2*)(UB + ((size_t)g * M + row) * 16 + 4 * fq) = wu;
            }
        }
    }
};
struct EpiNull { static constexpr bool AFTER_DRAIN = false, PRELOAD = false, APERM = false, FUSEDPRE = false;
    __device__ __forceinline__ void operator()(f32x4 (&acc)[2][2][4][2], const Unit& u, int, int, int fr, int) const {
        f32x4 s = (f32x4){0.f, 0.f, 0.f, 0.f};
#pragma unroll
        for (int a = 0; a < 2; ++a)
#pragma unroll
            for (int b = 0; b < 2; ++b)
#pragma unroll
                for (int m = 0; m < 4; ++m)
#pragma unroll
                    for (int n = 0; n < 2; ++n) s += acc[a][b][m][n];
        if (s[0] + s[1] + s[2] + s[3] == 1.2345e-30f && fr == 7) *(float*)u.C = 0.f; } };
}
struct Args { const float* in[32]; float* out; unsigned char* ws; };

struct Frame {
    LAS unsigned char* lds;
    int wave, G, bid;
    int gw, ngw;
    int ngt;
};
#define PHASE_TID(F, tid, lane, gt) int lane = lane_id(); asm volatile("" : "+v"(lane)); const int tid = (F).wave * 64 + lane; const int gt = (F).bid * NTHR + tid; (void)tid; (void)gt


struct MatDesc { const float* W; const float* gk; bf16_t* WT; int K, N, rs, roff, nsplit; float nsc; int transpose, rmode; };
__device__ __forceinline__ int even_row(int ng) { const int part = ng >> 10, ch = ng & 1023, pn = ch >> 6, r = ch & 63; return 256 * pn + 128 * (part >> 1) + 32 * (r >> 4) + 8 * ((r >> 2) & 3) + 4 * (part & 1) + (r & 3); }
__device__ __forceinline__ void tr_load(const MatDesc& d, int item, int lane, f32x4 (&v)[16], float (&gs)[16]) {
    const int nblk = d.N / 64, kb = item / nblk, nb = item % nblk, k0 = 64 * kb, n0 = 64 * nb;
    const unsigned voff = (unsigned)((lane >> 4) * d.N + (lane & 15) * 4) * 4u;
    const char* sbase = (const char*)(d.W + (size_t)k0 * d.N + n0);
#pragma unroll
    for (int i = 0; i < 16; ++i) v[i] = __builtin_nontemporal_load((const f32x4*)(sbase + (size_t)(4 * i) * d.N * 4 + voff));
    if (d.gk) {
#pragma unroll
        for (int i = 0; i < 16; ++i) gs[i] = d.gk[k0 + 4 * i + (lane >> 4)];
    } else {
#pragma unroll
        for (int i = 0; i < 16; ++i) gs[i] = 1.0f;
    }
}
__device__ __forceinline__ void tr_store(const MatDesc& d, LAS float* scr, int item, int lane, const f32x4 (&v)[16], const float (&gs)[16]) {
    const int nblk = d.N / 64, kb = item / nblk, nb = item % nblk, k0 = 64 * kb, n0 = 64 * nb;
    LAS float* wp = scr + (lane >> 4) * 65 + (lane & 15) * 4;
#pragma unroll
    for (int i = 0; i < 16; ++i) { const f32x4 x = v[i] * gs[i];
        wp[(4 * i) * 65 + 0] = x[0]; wp[(4 * i) * 65 + 1] = x[1]; wp[(4 * i) * 65 + 2] = x[2]; wp[(4 * i) * 65 + 3] = x[3]; }
    LDS_WAIT(); asm volatile("" ::: "memory");
    const int c = lane & 7;
#pragma unroll
    for (int j = 0; j < 8; ++j) { const int n = (lane >> 3) + 8 * j, ng = n0 + n; const LAS float* s = scr + (8 * c) * 65 + n;
        const float sc = (ng < d.nsplit) ? d.nsc : 1.0f;
        u32x4 o; o.x = cvt_pk_bf16(s[0 * 65] * sc, s[1 * 65] * sc); o.y = cvt_pk_bf16(s[2 * 65] * sc, s[3 * 65] * sc); o.z = cvt_pk_bf16(s[4 * 65] * sc, s[5 * 65] * sc); o.w = cvt_pk_bf16(s[6 * 65] * sc, s[7 * 65] * sc);
        const int drow = d.rmode ? even_row(ng) : (ng / 128) * d.rs + d.roff + (ng % 128);
        __builtin_nontemporal_store(o, (u32x4*)(d.WT + (size_t)drow * d.K + k0 + 8 * c)); }
    LDS_WAIT(); asm volatile("" ::: "memory");
}
__device__ __forceinline__ void get_mat(const Args& a, int id, MatDesc& d) {
    unsigned char* ws = a.ws;
    d.gk = nullptr; d.rs = 128; d.roff = 0; d.nsplit = 0; d.nsc = 1.f; d.transpose = 1; d.rmode = 0; d.K = D; d.N = D;
    if (id < 2)       { const int i = id;      d.W = a.in[8] + (size_t)i * D * EVEN_IN; d.N = EVEN_IN; d.rmode = 1; d.gk = a.in[2] + (2 * i) * D; d.WT = (bf16_t*)(ws + WS_WIN_T) + (size_t)i * EVEN_IN * D; }
    else if (id < 4)  { const int i = id - 2;  d.W = a.in[19] + (size_t)i * D * D; d.WT = (bf16_t*)(ws + WS_EWOUT_T) + (size_t)i * D * D; }
    else if (id < 6)  { const int i = id - 4;  d.W = a.in[20] + (size_t)i * D * ODD_IN; d.N = ODD_IN; d.gk = a.in[2] + (2 * i + 1) * D; d.nsplit = NQH * HD; d.nsc = 0.125f; d.WT = (bf16_t*)(ws + WS_WQKV_T) + (size_t)i * ODD_IN * D; }
    else if (id < 8)  { const int i = id - 6;  d.W = a.in[23] + (size_t)i * D * D; d.WT = (bf16_t*)(ws + WS_OWOUT_T) + (size_t)i * D * D; }
    else if (id < 12) { const int l = id - 8;  d.W = a.in[25] + (size_t)l * D * 2 * D; d.N = 2 * D; d.WT = (bf16_t*)(ws + WS_WKV_T) + (size_t)l * 2 * D * D; }
    else if (id < 16) { const int l = id - 12; d.W = a.in[26] + (size_t)l * D * D; d.WT = (bf16_t*)(ws + WS_WO_T) + (size_t)l * D * D; }
    else if (id < 20) { const int l = id - 16; d.W = a.in[27] + (size_t)l * D * DFF; d.N = DFF; d.gk = a.in[4] + l * D; d.rs = 256; d.WT = (bf16_t*)(ws + WS_WGU_T) + (size_t)l * NGU * D; }
    else if (id < 24) { const int l = id - 20; d.W = a.in[28] + (size_t)l * D * DFF; d.N = DFF; d.gk = a.in[4] + l * D; d.rs = 256; d.roff = 128; d.WT = (bf16_t*)(ws + WS_WGU_T) + (size_t)l * NGU * D; }
    else if (id < 28) { const int l = id - 24; d.W = a.in[31] + (size_t)l * DFF * D; d.K = DFF; d.WT = (bf16_t*)(ws + WS_WDOWN_T) + (size_t)l * D * DFF; }
    else              { const int l = id - 28; d.W = a.in[24] + (size_t)l * D * D; d.transpose = 0; d.WT = (bf16_t*)(ws + WS_WQ_BF) + (size_t)l * D * D; }
}

__device__ __forceinline__ void p0_prologue(const Args& a, Frame& F) {
    unsigned char* ws = a.ws;
    PHASE_TID(F, tid, lane, gt);
    LAS float* scr = (LAS float*)(F.lds + F.wave * 16640);
    if (F.wave == 7) { float* sp = (float*)(ws + WS_S5P);
      for (int i = F.bid + F.G * lane; i < 2 * 64 * 64; i += F.G * 64) {
          const int g = (i >> 6) & 63, li_ = i >> 12;
          const double lr = a.in[10][i], li = a.in[11][i], dt = exp((double)a.in[12][li_ * 64 + g]);
          const double er = exp(lr * dt), abr = er * cos(li * dt), abi = er * sin(li * dt);
          const double xr_ = abr - 1.0, xi_ = abi, den = lr * lr + li * li;
          const double fr = (xr_ * lr + xi_ * li) / den, fi = (xi_ * lr - xr_ * li) / den;
          float* o = sp + (size_t)i * 34; o[0] = (float)abr; o[1] = (float)abi;
          for (int h = 0; h < 16; ++h) { const double br = a.in[13][(size_t)i * 16 + h], bi = a.in[14][(size_t)i * 16 + h]; o[2 + h] = (float)(fr * br - fi * bi); o[18 + h] = (float)(fr * bi + fi * br); } } }
    { int id = 0, base = 0; MatDesc d; get_mat(a, 0, d); int nit = (d.K / 64) * (d.N / 64);
      constexpr int TOTAL = 2 * (32 * 64 + 32 * 32 + 32 * 40 + 32 * 32) + 4 * (32 * 64 + 32 * 32 + 3 * 32 * 88);
      MatDesc dn = d; int idn = 0, basen = 0, nitn = nit;
      f32x4 vc[16], vn[16]; float gc[16], gn[16];
      int gi = F.gw;
      if (gi < TOTAL) {
          while (gi >= basen + nitn) { basen += nitn; ++idn; get_mat(a, idn, dn); nitn = (dn.K / 64) * (dn.N / 64); }
          d = dn; base = basen;
          tr_load(d, gi - base, lane, vc, gc);
          for (;;) {
              const int gnx = gi + F.ngw; const bool has_next = gnx < TOTAL;
              if (has_next) { while (gnx >= basen + nitn) { basen += nitn; ++idn; get_mat(a, idn, dn); nitn = (dn.K / 64) * (dn.N / 64); }
                              tr_load(dn, gnx - basen, lane, vn, gn); }
              tr_store(d, scr, gi - base, lane, vc, gc);
              if (!has_next) break;
#pragma unroll
              for (int i = 0; i < 16; ++i) { vc[i] = vn[i]; gc[i] = gn[i]; }
              d = dn; base = basen; gi = gnx;
          }
      } }
#if defined(PROBE_TR) && PROBE_TR
    { int id = 0, base = 0; MatDesc d; get_mat(a, 0, d); int nit = (d.K / 64) * (d.N / 64);
      constexpr int TOTAL = 2 * (32 * 64 + 32 * 32 + 32 * 40 + 32 * 32) + 4 * (32 * 64 + 32 * 32 + 3 * 32 * 88);
      f32x4 accp = (f32x4){0.f, 0.f, 0.f, 0.f};
      for (int gi = F.gw; gi < TOTAL; gi += F.ngw) {
          while (gi >= base + nit) { base += nit; ++id; get_mat(a, id, d); nit = (d.K / 64) * (d.N / 64); }
          f32x4 va[16]; float gs[16]; tr_load(d, gi - base, lane, va, gs);
          if (PROBE_TR == 1) {
#pragma unroll
              for (int i = 0; i < 16; ++i) accp += va[i] * gs[i];
          } else {
              const int item = gi - base, nblk = d.N / 64, kb = item / nblk, nb = item % nblk, k0 = 64 * kb, n0 = 64 * nb, c = lane & 7;
#pragma unroll
              for (int j = 0; j < 8; ++j) { const int n = (lane >> 3) + 8 * j, ng = n0 + n; const int drow = (ng / 128) * d.rs + d.roff + (ng % 128);
                  u32x4 o; o.x = (unsigned)gi; o.y = o.z = o.w = 0u;
                  *(u32x4*)((bf16_t*)(ws + WS_END) + ((size_t)(d.WT - (bf16_t*)(ws + WS_WIN_T)) % (32u << 20)) + (size_t)drow * d.K + k0 + 8 * c) = o; }
          } }
      if (accp[0] + accp[1] + accp[2] + accp[3] == 1.2345e-30f) *(float*)(ws + WS_END) = 0.f; }
#endif
    for (int id = 28; id < 32; ++id) {
        MatDesc d; get_mat(a, id, d);
        const size_t n8 = (size_t)d.K * d.N / 8;
        for (size_t i = gt; i < n8; i += F.ngt) { const f32x4 x0 = *(const f32x4*)(d.W + i * 8), x1 = *(const f32x4*)(d.W + i * 8 + 4);
            u32x4 o; o.x = cvt_pk_bf16(x0[0], x0[1]); o.y = cvt_pk_bf16(x0[2], x0[3]); o.z = cvt_pk_bf16(x1[0], x1[1]); o.w = cvt_pk_bf16(x1[2], x1[3]); *(u32x4*)(d.WT + i * 8) = o; }
    }
    { u32x4* z = (u32x4*)(ws + WS_SS + (size_t)M * 8); for (int i = gt; i < 13 * M * 8 / 16; i += F.ngt) z[i] = (u32x4){0u, 0u, 0u, 0u}; }
    { const float* x = a.in[0]; bf16_t* HB = (bf16_t*)(ws + WS_HB); i64* ss0 = (i64*)(ws + WS_SS);
      for (int row = F.gw; row < M; row += F.ngw) {
          const f32x4* xr = (const f32x4*)(x + (size_t)row * D); float s = 0.f;
#pragma unroll
          for (int j = 0; j < 4; ++j) { const f32x4 v0 = xr[(j * 64 + lane) * 2], v1 = xr[(j * 64 + lane) * 2 + 1];
              s += (v0[0] * v0[0] + v0[1] * v0[1]) + (v0[2] * v0[2] + v0[3] * v0[3]) + (v1[0] * v1[0] + v1[1] * v1[1]) + (v1[2] * v1[2] + v1[3] * v1[3]);
              u32x4 o; o.x = cvt_pk_bf16(v0[0], v0[1]); o.y = cvt_pk_bf16(v0[2], v0[3]); o.z = cvt_pk_bf16(v1[0], v1[1]); o.w = cvt_pk_bf16(v1[2], v1[3]);
              *(u32x4*)(HB + (size_t)row * D + (j * 64 + lane) * 8) = o; }
          s = wave_sum(s, lane); if (lane == 0) ss0[row] = (i64)(s * SS_SCALE); } }
    { const float* mem = a.in[1]; const float* gm = a.in[6]; bf16_t* MN = (bf16_t*)(ws + WS_MEMN);
      for (int row = F.gw; row < MROWS; row += F.ngw) {
          const f32x4* xr = (const f32x4*)(mem + (size_t)row * D); f32x4 v[8]; float s = 0.f;
#pragma unroll
          for (int j = 0; j < 4; ++j) { v[2 * j] = xr[(j * 64 + lane) * 2]; v[2 * j + 1] = xr[(j * 64 + lane) * 2 + 1];
              const f32x4 v0 = v[2 * j], v1 = v[2 * j + 1]; s += (v0[0] * v0[0] + v0[1] * v0[1]) + (v0[2] * v0[2] + v0[3] * v0[3]) + (v1[0] * v1[0] + v1[1] * v1[1]) + (v1[2] * v1[2] + v1[3] * v1[3]); }
          s = wave_sum(s, lane); const float r = 1.0f / sqrtf(s * (1.0f / D) + EPS);
#pragma unroll
          for (int j = 0; j < 4; ++j) { const f32x4 g0 = *(const f32x4*)(gm + (j * 64 + lane) * 8), g1 = *(const f32x4*)(gm + (j * 64 + lane) * 8 + 4);
              const f32x4 v0 = v[2 * j] * r * g0, v1 = v[2 * j + 1] * r * g1;
              u32x4 o; o.x = cvt_pk_bf16(v0[0], v0[1]); o.y = cvt_pk_bf16(v0[2], v0[3]); o.z = cvt_pk_bf16(v1[0], v1[1]); o.w = cvt_pk_bf16(v1[2], v1[3]);
              *(u32x4*)(MN + (size_t)row * D + (j * 64 + lane) * 8) = o; } } }
    { float* qb = (float*)(ws + WS_QKVB); const float* b = a.in[21];
      for (int i = gt; i < 2 * ODD_IN; i += F.ngt) qb[i] = b[i] * (((i % ODD_IN) < NQH * HD) ? 0.125f : 1.0f); }
    { float* gxs = (float*)(ws + WS_GXS); const float* gx = a.in[3];
      for (int i = gt; i < 4 * D; i += F.ngt) gxs[i] = gx[i] * 0.044194173824159216f; }
}

__device__ __forceinline__ void unpack8(const u32x4 w, float (&f)[8]) { f[0] = bf_lo(w.x); f[1] = bf_hi(w.x); f[2] = bf_lo(w.y); f[3] = bf_hi(w.y); f[4] = bf_lo(w.z); f[5] = bf_hi(w.z); f[6] = bf_lo(w.w); f[7] = bf_hi(w.w); }
__device__ __forceinline__ void phase_convgate(const bf16_t* Z, const float* cw, bf16_t* YY, Frame& F) {
    PHASE_TID(F, tid, lane, gt);
    for (int idx = gt; idx < M * (AW / 8); idx += F.ngt) {
        const int row = idx >> 7, c8 = (idx & 127) * 8, t = row & (L - 1);
        const bf16_t* zr = Z + (size_t)row * EVEN_IN + c8;
        float gb[8], a0[8], b0[8], a1[8], b1[8], a2[8], b2[8];
        unpack8(*(const u32x4*)zr, gb); unpack8(*(const u32x4*)(zr + AW), a0); unpack8(*(const u32x4*)(zr + 2 * AW), b0);
        const u32x4 zero = (u32x4){0u, 0u, 0u, 0u};
        unpack8(t >= 1 ? *(const u32x4*)(zr - EVEN_IN + AW) : zero, a1); unpack8(t >= 1 ? *(const u32x4*)(zr - EVEN_IN + 2 * AW) : zero, b1);
        unpack8(t >= 2 ? *(const u32x4*)(zr - 2 * EVEN_IN + AW) : zero, a2); unpack8(t >= 2 ? *(const u32x4*)(zr - 2 * EVEN_IN + 2 * AW) : zero, b2);
        float o[8];
#pragma unroll
        for (int j = 0; j < 8; ++j) o[j] = gb[j] * (cw[2 * AW + c8 + j] * (a0[j] * b0[j]) + cw[AW + c8 + j] * (a1[j] * b1[j]) + cw[c8 + j] * (a2[j] * b2[j]));
        u32x4 w; w.x = cvt_pk_bf16(o[0], o[1]); w.y = cvt_pk_bf16(o[2], o[3]); w.z = cvt_pk_bf16(o[4], o[5]); w.w = cvt_pk_bf16(o[6], o[7]);
        *(u32x4*)(YY + (size_t)row * D + c8) = w;
    }
}

__device__ __forceinline__ void phase_mlp_fixup(const float* HG, const float* HU, const float* cw, const float* cb, bf16_t* ACT, Frame& F) {
    PHASE_TID(F, tid, lane, gt);
    for (int idx = gt; idx < 512 * (DFF / 4); idx += F.ngt) {
        const int ri = idx / (DFF / 4), c = (idx % (DFF / 4)) * 4, blk = ri >> 1, e = ri & 1, r = blk * 64 + e, t = r & (L - 1);
        const f32x4 zero = (f32x4){0.f, 0.f, 0.f, 0.f};
        f32x4 gm2, gm1, g0;
        if (e == 0) { gm2 = (t >= 2) ? *(const f32x4*)(HG + ((size_t)(blk - 1) * 4 + 0) * DFF + c) : zero; gm1 = (t >= 1) ? *(const f32x4*)(HG + ((size_t)(blk - 1) * 4 + 1) * DFF + c) : zero; g0 = *(const f32x4*)(HG + ((size_t)blk * 4 + 2) * DFF + c); }
        else        { gm2 = (t >= 2) ? *(const f32x4*)(HG + ((size_t)(blk - 1) * 4 + 1) * DFF + c) : zero; gm1 = *(const f32x4*)(HG + ((size_t)blk * 4 + 2) * DFF + c); g0 = *(const f32x4*)(HG + ((size_t)blk * 4 + 3) * DFF + c); }
        const f32x4 up = *(const f32x4*)(HU + ((size_t)blk * 2 + e) * DFF + c);
        const f32x4 w0 = *(const f32x4*)(cw + c), w1 = *(const f32x4*)(cw + DFF + c), w2 = *(const f32x4*)(cw + 2 * DFF + c), bb = *(const f32x4*)(cb + c);
        f32x4 pre = w2 * g0 + w1 * gm1 + w0 * gm2 + bb, a;
#pragma unroll
        for (int j = 0; j < 4; ++j) a[j] = pre[j] * fast_sigmoid(pre[j]) * up[j];
        u32x2 w; w.x = cvt_pk_bf16(a[0], a[1]); w.y = cvt_pk_bf16(a[2], a[3]);
        *(u32x2*)(ACT + (size_t)r * DFF + c) = w;
    }
}

__device__ __forceinline__ void phase_ya_fixup(const float* HV, const float* HGB, const float* cw, bf16_t* YY, Frame& F) {
    PHASE_TID(F, tid, lane, gt);
    for (int idx = gt; idx < 512 * (AW / 4); idx += F.ngt) {
        const int ri = idx >> 8, c = (idx & 255) * 4, blk = ri >> 1, e = ri & 1, r = blk * 64 + e, t = r & (L - 1);
        const f32x4 zero = (f32x4){0.f, 0.f, 0.f, 0.f};
        f32x4 vm2, vm1, v0;
        if (e == 0) { vm2 = (t >= 2) ? *(const f32x4*)(HV + ((size_t)(blk - 1) * 4 + 0) * AW + c) : zero; vm1 = (t >= 1) ? *(const f32x4*)(HV + ((size_t)(blk - 1) * 4 + 1) * AW + c) : zero; v0 = *(const f32x4*)(HV + ((size_t)blk * 4 + 2) * AW + c); }
        else        { vm2 = (t >= 2) ? *(const f32x4*)(HV + ((size_t)(blk - 1) * 4 + 1) * AW + c) : zero; vm1 = *(const f32x4*)(HV + ((size_t)blk * 4 + 2) * AW + c); v0 = *(const f32x4*)(HV + ((size_t)blk * 4 + 3) * AW + c); }
        const f32x4 gb = *(const f32x4*)(HGB + ((size_t)blk * 2 + e) * AW + c);
        const f32x4 w0 = *(const f32x4*)(cw + c), w1 = *(const f32x4*)(cw + AW + c), w2 = *(const f32x4*)(cw + 2 * AW + c);
        const f32x4 a = gb * (w2 * v0 + w1 * vm1 + w0 * vm2);
        u32x2 w; w.x = cvt_pk_bf16(a[0], a[1]); w.y = cvt_pk_bf16(a[2], a[3]);
        *(u32x2*)(YY + (size_t)r * D + c) = w;
    }
}

__device__ __forceinline__ void phase_final(const bf16_t* HB, const i64* ss, const float* g, float* out, Frame& F) {
    PHASE_TID(F, tid, lane, gt);
    for (size_t i = gt; i < (size_t)M * D / 8; i += F.ngt) {
        const int row = (int)(i >> 8), c = (int)(i & 255) * 8;
        const float rs = 1.0f / sqrtf((float)ss[row] * SS_INV + EPS);
        float h[8]; unpack8(*(const u32x4*)(HB + i * 8), h);
        const f32x4 g0 = *(const f32x4*)(g + c), g1 = *(const f32x4*)(g + c + 4);
        *(f32x4*)(out + i * 8) = (f32x4){h[0], h[1], h[2], h[3]} * rs * g0; *(f32x4*)(out + i * 8 + 4) = (f32x4){h[4], h[5], h[6], h[7]} * rs * g1;
    }
}

typedef float f32x16 __attribute__((ext_vector_type(16)));
constexpr int SWA_KSTR = 144, SWA_VSTR = 520, SWA_K_OFF = 0, SWA_V_OFF = 256 * SWA_KSTR, SWA_T_OFF = SWA_V_OFF + 64 * SWA_VSTR, SWA_TLEN = 192;
__device__ __forceinline__ void phase_swa(const bf16_t* QKV, const float* rel_bias, const float* sinks, bf16_t* O, Frame& F) {
    PHASE_TID(F, tid, lane, gt);
    const float LOG2E = 1.4426950408889634f;
    LAS unsigned char* lds = F.lds;
    const int q31 = lane & 31, hf = lane >> 5;
    for (int unit = F.bid; unit < NB * 32 * NKVH; unit += F.G) {
        const int b = unit >> 7, n = (unit >> 2) & 31, kvh = unit & 3, row0 = b * L + n * 128;
#pragma unroll
        for (int i = 0; i < 4; ++i) { const int it = tid + i * NTHR, key = it >> 3, ch = it & 7;
            u32x4 v = (u32x4){0u, 0u, 0u, 0u};
            if (n > 0 || key >= 128) v = *(const u32x4*)(QKV + (size_t)(row0 - 128 + key) * ODD_IN + NQH * HD + kvh * HD + ch * 8);
            *(LAS u32x4*)(lds + SWA_K_OFF + key * SWA_KSTR + ch * 16) = v; }
#pragma unroll
        for (int i = 0; i < 2; ++i) { const int it = tid + i * NTHR, dc = it & 7, kp = it >> 3;
            u32x4 v0 = (u32x4){0u, 0u, 0u, 0u}, v1 = v0;
            if (n > 0 || kp >= 64) { const bf16_t* vp = QKV + (size_t)(row0 - 128 + 2 * kp) * ODD_IN + (NQH + NKVH) * HD + kvh * HD + dc * 8; v0 = *(const u32x4*)vp; v1 = *(const u32x4*)(vp + ODD_IN); }
            LAS unsigned char* dst = lds + SWA_V_OFF + (dc * 8) * SWA_VSTR + kp * 4;
            *(LAS unsigned*)(dst + 0 * SWA_VSTR) = (v0.x & 0xffffu) | (v1.x << 16); *(LAS unsigned*)(dst + 1 * SWA_VSTR) = (v0.x >> 16) | (v1.x & 0xffff0000u);
            *(LAS unsigned*)(dst + 2 * SWA_VSTR) = (v0.y & 0xffffu) | (v1.y << 16); *(LAS unsigned*)(dst + 3 * SWA_VSTR) = (v0.y >> 16) | (v1.y & 0xffff0000u);
            *(LAS unsigned*)(dst + 4 * SWA_VSTR) = (v0.z & 0xffffu) | (v1.z << 16); *(LAS unsigned*)(dst + 5 * SWA_VSTR) = (v0.z >> 16) | (v1.z & 0xffff0000u);
            *(LAS unsigned*)(dst + 6 * SWA_VSTR) = (v0.w & 0xffffu) | (v1.w << 16); *(LAS unsigned*)(dst + 7 * SWA_VSTR) = (v0.w >> 16) | (v1.w & 0xffff0000u); }
        for (int idx = tid; idx < 8 * SWA_TLEN; idx += NTHR) { const int g = idx / SWA_TLEN, e = idx % SWA_TLEN, rel = e - 31;
            const float v = (rel >= 0 && rel < 128) ? rel_bias[kBucket[rel] * NQH + kvh * 8 + g] * LOG2E : -1e30f;
            *(LAS float*)(lds + SWA_T_OFF + idx * 4) = v; }
        __syncthreads();
        const int hq = kvh * 8 + F.wave; const float sink2 = sinks[hq] * LOG2E;
        bf16x8 qn[4];
        { const bf16_t* qp = QKV + (size_t)(row0 + q31) * ODD_IN + hq * HD + 8 * hf;
#pragma unroll
          for (int s = 0; s < 4; ++s) qn[s] = *(const bf16x8*)(qp + 16 * s); }
#pragma unroll 1
        for (int qt = 0; qt < 4; ++qt) {
            bf16x8 qf[4];
#pragma unroll
            for (int s = 0; s < 4; ++s) qf[s] = qn[s];
            if (qt < 3) { const bf16_t* qp = QKV + (size_t)(row0 + 32 * (qt + 1) + q31) * ODD_IN + hq * HD + 8 * hf;
#pragma unroll
                for (int s = 0; s < 4; ++s) qn[s] = *(const bf16x8*)(qp + 16 * s); }
            f32x16 S[5];
#pragma unroll
            for (int dt = 0; dt < 5; ++dt) {
                const int kt = qt + dt;
                if (n == 0 && kt < 4) {
#pragma unroll
                    for (int i = 0; i < 16; ++i) S[dt][i] = -1e30f;
                } else {
                    f32x16 acc;
#pragma unroll
                    for (int i = 0; i < 16; ++i) acc[i] = 0.f;
#pragma unroll
                    for (int s = 0; s < 4; ++s) { const bf16x8 kf = *(const LAS bf16x8*)(lds + SWA_K_OFF + (32 * kt + q31) * SWA_KSTR + (16 * s + 8 * hf) * 2);
                        acc = __builtin_amdgcn_mfma_f32_32x32x16_bf16(kf, qf[s], acc, 0, 0, 0); }
                    const LAS unsigned char* tb = lds + SWA_T_OFF + (F.wave * SWA_TLEN + 159 - 32 * dt + q31 - 4 * hf - 27) * 4;
#pragma unroll
                    for (int i = 0; i < 16; ++i) S[dt][i] = acc[i] * LOG2E + *(const LAS float*)(tb + (27 - (8 * (i >> 2) + (i & 3))) * 4);
                }
            }
            float mx = sink2;
#pragma unroll
            for (int dt = 0; dt < 5; ++dt)
#pragma unroll
                for (int i = 0; i < 16; ++i) mx = fmaxf(mx, S[dt][i]);
            mx = fmaxf(mx, shx(mx, 32, lane));
            float l = 0.f;
#pragma unroll
            for (int dt = 0; dt < 5; ++dt)
#pragma unroll
                for (int i = 0; i < 16; ++i) { const float p = __builtin_amdgcn_exp2f(S[dt][i] - mx); S[dt][i] = p; l += p; }
            l += shx(l, 32, lane);
            const float inv = __builtin_amdgcn_rcpf(l + __builtin_amdgcn_exp2f(sink2 - mx));
            f32x16 oa[2];
#pragma unroll
            for (int dd = 0; dd < 2; ++dd)
#pragma unroll
                for (int i = 0; i < 16; ++i) oa[dd][i] = 0.f;
#pragma unroll
            for (int dt = 0; dt < 5; ++dt) {
                const int kt = qt + dt;
                if (!(n == 0 && kt < 4)) {
#pragma unroll
                    for (int s = 0; s < 2; ++s) {
                        u32x4 pw; pw.x = cvt_pk_bf16(S[dt][8 * s + 0], S[dt][8 * s + 1]); pw.y = cvt_pk_bf16(S[dt][8 * s + 2], S[dt][8 * s + 3]); pw.z = cvt_pk_bf16(S[dt][8 * s + 4], S[dt][8 * s + 5]); pw.w = cvt_pk_bf16(S[dt][8 * s + 6], S[dt][8 * s + 7]);
                        const bf16x8 pb = __builtin_bit_cast(bf16x8, pw);
#pragma unroll
                        for (int dd = 0; dd < 2; ++dd) {
                            const LAS unsigned char* vp = lds + SWA_V_OFF + (32 * dd + q31) * SWA_VSTR + (32 * kt + 16 * s + 4 * hf) * 2;
                            const u32x2 a0 = *(const LAS u32x2*)vp, a1 = *(const LAS u32x2*)(vp + 16);
                            const bf16x8 va = __builtin_bit_cast(bf16x8, (u32x4){a0.x, a0.y, a1.x, a1.y});
                            oa[dd] = __builtin_amdgcn_mfma_f32_32x32x16_bf16(va, pb, oa[dd], 0, 0, 0);
                        }
                    }
                }
            }
            bf16_t* op = O + (size_t)(row0 + 32 * qt + q31) * D + hq * HD + 4 * hf;
#pragma unroll
            for (int dd = 0; dd < 2; ++dd)
#pragma unroll
                for (int g4 = 0; g4 < 4; ++g4) { u32x2 w; w.x = cvt_pk_bf16(oa[dd][4 * g4 + 0] * inv, oa[dd][4 * g4 + 1] * inv); w.y = cvt_pk_bf16(oa[dd][4 * g4 + 2] * inv, oa[dd][4 * g4 + 3] * inv);
                    *(u32x2*)(op + 32 * dd + 8 * g4) = w; }
        }
        __syncthreads();
    }
}

constexpr int S5_PW_OFF = 0, S5_KC_OFF = 4608, S5_SL_OFF = 9216, S5_XB_OFF = 41984, S5_XSTR = 272, S5_PT_OFF = 59392, S5_UL_OFF = 94208, S5_USTR = 264, S5_UBUF = 64 * 264;
__device__ __forceinline__ float bfe(const bf16x8& v, int j) { return __uint_as_float(((unsigned)(unsigned short)v[j]) << 16); }
template <int RT>
__device__ __forceinline__ void s5_unit(const bf16_t* Z, const float* s5p, const float* c_re, const float* c_im, const float* dvec, const float* glu, bf16_t* YY, LAS unsigned char* lds,
                                        const int b, const int g, const int wave, const int tid, const int lane) {
    const int q31 = lane & 31, hf = lane >> 5, mtl = wave >> 2;
    LAS f32x2* PW = (LAS f32x2*)(lds + S5_PW_OFF);
    { const int p = tid & 63, j = tid >> 6; const float ar = s5p[(size_t)(g * 64 + p) * 34], ai = s5p[(size_t)(g * 64 + p) * 34 + 1];
      float pr = 1.f, pi = 0.f;
      for (int k = 0; k < j; ++k) { const float nr = pr * ar - pi * ai, ni = pr * ai + pi * ar; pr = nr; pi = ni; }
      PW[j * 64 + p] = (f32x2){pr, pi};
      if (j == 7) PW[8 * 64 + p] = (f32x2){pr * ar - pi * ai, pr * ai + pi * ar}; }
    __syncthreads();
    { LAS bf16_t* KC = (LAS bf16_t*)(lds + S5_KC_OFF);
      { const int jj0 = tid >> 8, h = (tid >> 4) & 15, hp = tid & 15;
        const float* cr = c_re + (size_t)(g * 16 + h) * 64; const float* ci = c_im + (size_t)(g * 16 + h) * 64; const float* bb = s5p + (size_t)(g * 64) * 34 + 2 + hp;
        float sum[4] = {0.f, 0.f, 0.f, 0.f};
#pragma unroll 16
        for (int p = 0; p < 64; ++p) { const float ca = cr[p], cc = ci[p], br = bb[p * 34], bi = bb[p * 34 + 16];
            const float cbx = ca * br - cc * bi, cby = ca * bi + cc * br;
#pragma unroll
            for (int q = 0; q < 4; ++q) { const f32x2 pw = PW[(jj0 + 2 * q) * 64 + p]; sum[q] += pw.x * cbx - pw.y * cby; } }
        const int pos = 8 * ((hp >> 2) & 1) + 4 * (hp >> 3) + (hp & 3);
#pragma unroll
        for (int q = 0; q < 4; ++q) KC[((jj0 + 2 * q) * 16 + h) * 16 + pos] = (bf16_t)(cvt_pk_bf16(sum[q], 0.f) & 0xffffu); }
      if (tid < 128) ((LAS unsigned*)(KC + 8 * 256))[tid] = 0u; }
    __syncthreads();
    bf16x8 qf[8], ga[2]; float d8[8];
    {
      const int comp = 32 * RT + q31, p = comp & 63; const bool im = comp >= 64; const float* bbp = s5p + (size_t)(g * 64 + p) * 34 + 2;
      float br[8], bi[8];
#pragma unroll
      for (int j4 = 0; j4 < 2; ++j4) { const f32x2* q0 = (const f32x2*)(bbp + 8 * j4 + 4 * hf); const f32x2* q1 = (const f32x2*)(bbp + 16 + 8 * j4 + 4 * hf);
          const f32x2 r0 = q0[0], r1 = q0[1], i0 = q1[0], i1 = q1[1];
          br[4 * j4] = r0.x; br[4 * j4 + 1] = r0.y; br[4 * j4 + 2] = r1.x; br[4 * j4 + 3] = r1.y; bi[4 * j4] = i0.x; bi[4 * j4 + 1] = i0.y; bi[4 * j4 + 2] = i1.x; bi[4 * j4 + 3] = i1.y; }
#pragma unroll
      for (int s = 0; s < 8; ++s) { const f32x2 pw = PW[(7 - s) * 64 + p]; float v[8];
#pragma unroll
          for (int j = 0; j < 8; ++j) v[j] = im ? (pw.x * bi[j] + pw.y * br[j]) : (pw.x * br[j] - pw.y * bi[j]);
          u32x4 w; w.x = cvt_pk_bf16(v[0], v[1]); w.y = cvt_pk_bf16(v[2], v[3]); w.z = cvt_pk_bf16(v[4], v[5]); w.w = cvt_pk_bf16(v[6], v[7]);
          if (mtl == 0) *(LAS u32x4*)(lds + S5_PT_OFF + comp * S5_XSTR + s * 32 + hf * 16) = w; } }
    {
      const int t2 = 2 * RT + (q31 >> 4), h = q31 & 15; const float* cr = c_re + (size_t)(g * 16 + h) * 64; const float* ci = c_im + (size_t)(g * 16 + h) * 64;
#pragma unroll
      for (int ks = 0; ks < 4; ++ks) { float vr[8], vi[8];
          const f32x4 ca0 = *(const f32x4*)(cr + 16 * ks + 8 * hf), ca1 = *(const f32x4*)(cr + 16 * ks + 8 * hf + 4), cc0 = *(const f32x4*)(ci + 16 * ks + 8 * hf), cc1 = *(const f32x4*)(ci + 16 * ks + 8 * hf + 4);
#pragma unroll
          for (int j = 0; j < 8; ++j) { const int p = 16 * ks + 8 * hf + j; const f32x2 pw = PW[(t2 + 1) * 64 + p]; const float a = j < 4 ? ca0[j & 3] : ca1[j & 3], c = j < 4 ? cc0[j & 3] : cc1[j & 3]; vr[j] = a * pw.x - c * pw.y; vi[j] = -(a * pw.y + c * pw.x); }
          u32x4 w; w.x = cvt_pk_bf16(vr[0], vr[1]); w.y = cvt_pk_bf16(vr[2], vr[3]); w.z = cvt_pk_bf16(vr[4], vr[5]); w.w = cvt_pk_bf16(vr[6], vr[7]); qf[ks] = __builtin_bit_cast(bf16x8, w);
          w.x = cvt_pk_bf16(vi[0], vi[1]); w.y = cvt_pk_bf16(vi[2], vi[3]); w.z = cvt_pk_bf16(vi[4], vi[5]); w.w = cvt_pk_bf16(vi[6], vi[7]); qf[ks + 4] = __builtin_bit_cast(bf16x8, w); }
      const int o = q31 & 15, t2p = q31 >> 4;
#pragma unroll
      for (int ks = 0; ks < 2; ++ks) { float v[8];
#pragma unroll
          for (int j = 0; j < 8; ++j) { const int hh = 8 * (j >> 2) + 4 * hf + (j & 3); v[j] = (t2p == ks) ? glu[g * 256 + hh * 16 + o] : 0.f; }
          u32x4 w; w.x = cvt_pk_bf16(v[0], v[1]); w.y = cvt_pk_bf16(v[2], v[3]); w.z = cvt_pk_bf16(v[4], v[5]); w.w = cvt_pk_bf16(v[6], v[7]); ga[ks] = __builtin_bit_cast(bf16x8, w); }
#pragma unroll
      for (int j4 = 0; j4 < 2; ++j4) { const f32x4 dv = *(const f32x4*)(dvec + g * 16 + 8 * j4 + 4 * hf); d8[4 * j4] = dv[0]; d8[4 * j4 + 1] = dv[1]; d8[4 * j4 + 2] = dv[2]; d8[4 * j4 + 3] = dv[3]; } }
    const f32x2 a8 = PW[8 * 64 + lane];
    float Sre = 0.f, Sim = 0.f;
    LAS float* SL = (LAS float*)(lds + S5_SL_OFF);
    bf16x8 uf[8];
    u32x4 gU0, gU1;
    const bf16_t* ubase = Z + ((size_t)g * M + (size_t)b * L) * 16 + (size_t)tid * 16;
#define S5_GLOADU(SEG) do { const u32x4* gp_ = (const u32x4*)(ubase + (size_t)(SEG) * 8192); gU0 = gp_[0]; gU1 = gp_[1]; } while (0)
#define S5_STOREU(SEG) do { LAS unsigned char* up_ = lds + S5_UL_OFF + ((SEG) & 1) * S5_UBUF + (tid >> 3) * S5_USTR + (tid & 7) * 32; \
        *(LAS u32x2*)(up_) = (u32x2){gU0.x, gU0.y}; *(LAS u32x2*)(up_ + 8) = (u32x2){gU0.z, gU0.w}; *(LAS u32x2*)(up_ + 16) = (u32x2){gU1.x, gU1.y}; *(LAS u32x2*)(up_ + 24) = (u32x2){gU1.z, gU1.w}; } while (0)
#define S5_READU(SEG) do { const LAS unsigned char* up_ = lds + S5_UL_OFF + ((SEG) & 1) * S5_UBUF + (mtl * 32 + q31) * S5_USTR + hf * 8; \
        _Pragma("unroll") for (int s = 0; s < 8; ++s) { const u32x2 lo = *(const LAS u32x2*)(up_ + s * 32), hi = *(const LAS u32x2*)(up_ + s * 32 + 16); uf[s] = __builtin_bit_cast(bf16x8, (u32x4){lo.x, lo.y, hi.x, hi.y}); } } while (0)
#define S5_SEG(SEG) do { \
        const int seg = (SEG); const int mloc = mtl * 32 + q31; const size_t tok0 = (size_t)b * L + 8 * (seg * 64 + mloc); \
        { f32x16 acc; \
          _Pragma("unroll") for (int i = 0; i < 16; ++i) acc[i] = 0.f; \
          S5_READU(seg); \
          _Pragma("unroll") for (int s = 0; s < 8; ++s) acc = __builtin_amdgcn_mfma_f32_32x32x16_bf16(uf[s], *(const LAS bf16x8*)(lds + S5_PT_OFF + (32 * RT + q31) * S5_XSTR + s * 32 + hf * 16), acc, 0, 0, 0); \
          if (seg < 7) S5_STOREU(seg + 1); \
          if (seg < 6) S5_GLOADU(seg + 2); \
          _Pragma("unroll") for (int i = 0; i < 16; ++i) SL[(mtl * 32 + 8 * (i >> 2) + 4 * hf + (i & 3)) * 128 + 32 * RT + q31] = acc[i]; } \
        __syncthreads(); \
        if (wave == 0) { \
            _Pragma("unroll 1") for (int blk = 0; blk < 8; ++blk) { float lr[8], li[8]; \
                _Pragma("unroll") for (int k = 0; k < 8; ++k) { lr[k] = SL[(blk * 8 + k) * 128 + lane]; li[k] = SL[(blk * 8 + k) * 128 + 64 + lane]; } \
                _Pragma("unroll") for (int k = 0; k < 8; ++k) { LAS bf16_t* xr = (LAS bf16_t*)(lds + S5_XB_OFF + (blk * 8 + k) * S5_XSTR); \
                    const unsigned w = cvt_pk_bf16(Sre, Sim); xr[lane] = (bf16_t)(w & 0xffffu); xr[64 + lane] = (bf16_t)(w >> 16); \
                    const float nr = a8.x * Sre - a8.y * Sim + lr[k], ni = a8.x * Sim + a8.y * Sre + li[k]; Sre = nr; Sim = ni; } } } \
        __syncthreads(); \
        { f32x16 acc; \
          _Pragma("unroll") for (int i = 0; i < 16; ++i) acc[i] = 0.f; \
          _Pragma("unroll") for (int s = 0; s < 2 * RT + 2; ++s) { int jj = t2r - s; jj = jj < 0 ? 8 : jj; \
              const bf16x8 kfs = *(const LAS bf16x8*)(lds + S5_KC_OFF + ((jj * 16 + hr) * 16 + 8 * hf) * 2); acc = __builtin_amdgcn_mfma_f32_32x32x16_bf16(kfs, uf[s], acc, 0, 0, 0); } \
          _Pragma("unroll") for (int ks = 0; ks < 8; ++ks) { const bf16x8 xf = *(const LAS bf16x8*)(lds + S5_XB_OFF + mloc * S5_XSTR + (16 * ks + 8 * hf) * 2); acc = __builtin_amdgcn_mfma_f32_32x32x16_bf16(qf[ks], xf, acc, 0, 0, 0); } \
          float yg[16]; \
          _Pragma("unroll") for (int i = 0; i < 16; ++i) yg[i] = gelu_tanh_f(acc[i] + d8[i & 7] * bfe(uf[2 * RT + (i >> 3)], i & 7)); \
          f32x16 gt; \
          _Pragma("unroll") for (int i = 0; i < 16; ++i) gt[i] = 0.f; \
          _Pragma("unroll") for (int ks = 0; ks < 2; ++ks) { u32x4 w; w.x = cvt_pk_bf16(yg[8 * ks + 0], yg[8 * ks + 1]); w.y = cvt_pk_bf16(yg[8 * ks + 2], yg[8 * ks + 3]); w.z = cvt_pk_bf16(yg[8 * ks + 4], yg[8 * ks + 5]); w.w = cvt_pk_bf16(yg[8 * ks + 6], yg[8 * ks + 7]); \
              gt = __builtin_amdgcn_mfma_f32_32x32x16_bf16(ga[ks], __builtin_bit_cast(bf16x8, w), gt, 0, 0, 0); } \
          bf16_t* op = YY + (tok0 + 2 * RT) * D + AW + g * 16 + 4 * hf; \
          _Pragma("unroll") for (int t2l = 0; t2l < 2; ++t2l) \
              _Pragma("unroll") for (int grp = 0; grp < 2; ++grp) { const int i0 = 8 * t2l + 4 * grp; float o[4]; \
                  _Pragma("unroll") for (int r = 0; r < 4; ++r) o[r] = yg[i0 + r] * fast_sigmoid(gt[i0 + r]); \
                  u32x2 w; w.x = cvt_pk_bf16(o[0], o[1]); w.y = cvt_pk_bf16(o[2], o[3]); \
                  *(u32x2*)(op + (size_t)t2l * D + 8 * grp) = w; } } \
    } while (0)
    const int t2r = 2 * RT + (q31 >> 4), hr = q31 & 15;
    S5_GLOADU(0); S5_STOREU(0); S5_GLOADU(1);
    __syncthreads();
#pragma unroll 1
    for (int sg = 0; sg < 8; ++sg) { S5_SEG(sg); }
#undef S5_SEG
#undef S5_GLOADU
#undef S5_STOREU
#undef S5_READU
    __syncthreads();
}
__device__ __forceinline__ void phase_s5(const bf16_t* Z, const float* s5p, const float* c_re, const float* c_im, const float* dvec, const float* glu, bf16_t* YY, Frame& F) {
    PHASE_TID(F, tid, lane, gt);
    for (int unit = F.bid; unit < NB * S5G; unit += F.G) {
        const int b = unit / S5G, g = unit % S5G;
        switch (F.wave & 3) {
            case 0: s5_unit<0>(Z, s5p, c_re, c_im, dvec, glu, YY, F.lds, b, g, F.wave, tid, lane); break;
            case 1: s5_unit<1>(Z, s5p, c_re, c_im, dvec, glu, YY, F.lds, b, g, F.wave, tid, lane); break;
            case 2: s5_unit<2>(Z, s5p, c_re, c_im, dvec, glu, YY, F.lds, b, g, F.wave, tid, lane); break;
            default: s5_unit<3>(Z, s5p, c_re, c_im, dvec, glu, YY, F.lds, b, g, F.wave, tid, lane); break;
        }
    }
}
namespace pg8 {
struct SchedKV {
    unsigned char* ws; int G, c;
    __device__ __forceinline__ bool next(int i, Unit& u) const {
        const long Lx = (long)i * G + c; if (Lx >= 256) return false;
        const int l = (int)Lx >> 6, rem = (int)Lx & 63, pm = rem >> 4, pn = rem & 15;
        u.A = (const char*)(ws + WS_MEMN) + (size_t)pm * 256 * D * 2;
        u.B = (const char*)(ws + WS_WKV_T) + ((size_t)l * 2 * D + pn * 256) * D * 2;
        u.C = (char*)(ws + WS_KVM) + (pn >= 8 ? 16 * MiB : 0) + (((size_t)l * MROWS + pm * 256) * D + (pn & 7) * 256) * 2;
        u.vec = nullptr; u.row0 = pm * 256; u.col0 = pn * 256; u.aux = D; return true;
    }
};
struct SchedWSVW {
    unsigned char* ws; const float* gx; int G, c;
    __device__ __forceinline__ bool next(int i, Unit& u) const {
        const long Lx = (long)i * G + c; if (Lx >= 1024) return false;
        const int j = (int)Lx & 511, z = j >> 3, pt = j & 7, l = z >> 4, b = (z >> 2) & 3, head = z & 3;
        if (Lx < 512) {
            u.A = (const char*)(ws + WS_KVM) + (((size_t)l * MROWS + b * 256) * D + head * XHD) * 2;
            u.B = (const char*)(ws + WS_WQ_BF) + (((size_t)l * D + pt * 256) * D + head * XHD) * 2;
            u.C = (char*)(ws + WS_WS) + ((((size_t)(l * 4 + b) * 1024 + head * 256) * D) + pt * 256) * 2;
            u.vec = gx + l * D; u.row0 = 0; u.col0 = pt * 256; u.aux = D;
        } else {
            u.A = (const char*)(ws + WS_WO_T) + (((size_t)l * D + pt * 256) * D + head * XHD) * 2;
            u.B = (const char*)(ws + WS_KVM) + 16 * MiB + (((size_t)l * MROWS + b * 256) * D + head * XHD) * 2;
            u.C = (char*)(ws + WS_VW) + ((((size_t)(l * 4 + b) * D + pt * 256) * 1024) + head * 256) * 2;
            u.vec = nullptr; u.row0 = 0; u.col0 = 0; u.aux = 1024;
        }
        return true;
    }
};
}

#ifndef NO_PKF32
#define NO_PKF32 1
#endif
#if NO_PKF32 && defined(__HIP_DEVICE_COMPILE__)
#define MEGA_TGT __attribute__((target("no-packed-fp32-ops")))
#else
#define MEGA_TGT
#endif
__global__ void __launch_bounds__(NTHR, 2) MEGA_TGT mega_fwd(Args a) {
    extern __shared__ __attribute__((aligned(16))) unsigned char lds_raw[];
    Frame F;
    F.lds = (LAS unsigned char*)lds_raw;
    const int tid0 = threadIdx.x; F.wave = __builtin_amdgcn_readfirstlane(tid0 >> 6);
    F.G = gridDim.x; F.bid = blockIdx.x;
    F.gw = F.bid * NWAVES + F.wave; F.ngw = F.G * NWAVES; F.ngt = F.G * NTHR;
    unsigned char* ws = a.ws;
    volatile LAS unsigned* MISC = (volatile LAS unsigned*)(F.lds + MISC_OFF);
    for (int u = tid0; u < (LDS_BYTES - MISC_OFF) / 4; u += NTHR) ((LAS unsigned*)(F.lds + MISC_OFF))[u] = 0u;
    __syncthreads();
    unsigned* ctl = (unsigned*)(ws + WS_CTL);
    const XcdBarrier bar = xcd_barrier_post(ctl + CW_BAR, MISC + 8, F.wave);
    static_assert(8 * 16640 <= MISC_OFF, "prologue scratch below the control words");
    static_assert((CW_BAR + XCD_BAR_WORDS) * 4 <= (int)CTL_ZERO_BYTES, "barrier words inside the memset region");
#define GRID_BAR() do { xcd_barrier(bar); if (PROBE_BAR) xcd_barrier(bar); } while (0)

    i64* SS = (i64*)(ws + WS_SS);
    bf16_t* HB = (bf16_t*)(ws + WS_HB); bf16_t* YY = (bf16_t*)(ws + WS_YY);
    bf16_t* BIG = (bf16_t*)(ws + WS_BIG);
    float* HG = (float*)(ws + WS_HALO_G); float* HU = (float*)(ws + WS_HALO_U);
    float* DUMF = (float*)(ws + WS_END); bf16_t* DUMB = (bf16_t*)(ws + WS_END); (void)DUMF; (void)DUMB;
    const int cid = (int)blockIdx.x;

#ifndef PHMASK
#define PHMASK 0xFFFF
#endif
#ifndef PROBE_DUP
#define PROBE_DUP 0
#endif
#ifndef PROBE_KONLY
#define PROBE_KONLY 0
#endif
#ifndef F1_ALIGN
#define F1_ALIGN true
#endif
#ifndef F2_WGM
#define F2_WGM 4
#endif
#ifndef PROBE_BAR
#define PROBE_BAR 0
#endif
#define REP(bit) for (int rep_ = 0; rep_ < (((PROBE_DUP) & (bit)) ? 2 : 1); ++rep_)
    REP(1) if (PHMASK & 1) p0_prologue(a, F);
    GRID_BAR();
    for (int l = 0; l < 4; ++l) {
        const int i = l >> 1;
        if ((l & 1) == 0) {
            if (l == 0 && (PHMASK & 2)) { pg8::SchedKV S{ws, F.G, cid}; pg8::EpiPlain E;
              pg8::gemm_phase<pg8::EpiPlain, pg8::SchedKV, true>(F.lds, F.wave, D, D, D, S, E); }
            REP(8) if (PHMASK & 8) { pg8::SchedMain S{(const char*)HB, (const char*)(ws + WS_WIN_T) + (size_t)i * EVEN_IN * D * 2, nullptr, (size_t)256 * D * 2, (size_t)256 * D * 2, 0, 0, 0, 64, 16, 64, 64, F.G, cid};
              pg8::EpiEven E{SS + (size_t)(3 * l) * M, a.in[9] + (size_t)i * 3 * AW, YY, BIG, HG, HG + 2 * MiB};
              pg8::gemm_phase<pg8::EpiEven, pg8::SchedMain, true>(F.lds, F.wave, D, D, D, S, E); }
            GRID_BAR();
            if (l == 0 && (PHMASK & 4)) { pg8::SchedWSVW S{ws, (const float*)(ws + WS_GXS), F.G, cid}; pg8::EpiPlain E;
              pg8::gemm_phase<pg8::EpiPlain, pg8::SchedWSVW, true>(F.lds, F.wave, D, D, XHD, S, E); }
            REP(16) if (PHMASK & 16) phase_ya_fixup(HG, HG + 2 * MiB, a.in[9] + (size_t)i * 3 * AW, YY, F);
            REP(32) if (PHMASK & 32) phase_s5(BIG, (const float*)(ws + WS_S5P) + (size_t)i * 4096 * 34, a.in[15] + (size_t)i * 65536, a.in[16] + (size_t)i * 65536, a.in[17] + i * 1024, a.in[18] + (size_t)i * 16384, YY, F);
            GRID_BAR();
        } else {
            REP(64) if (PHMASK & 64) { pg8::SchedMain S{(const char*)HB, (const char*)(ws + WS_WQKV_T) + (size_t)i * ODD_IN * D * 2, (char*)BIG, (size_t)256 * D * 2, (size_t)256 * D * 2, 0, (size_t)256 * ODD_IN * 2, 256 * 2, 64, 10, 64, 256, F.G, cid};
              pg8::EpiRowScale E{SS + (size_t)(3 * l) * M, (const float*)(ws + WS_QKVB) + i * ODD_IN, ODD_IN};
              pg8::gemm_phase<pg8::EpiRowScale, pg8::SchedMain, true>(F.lds, F.wave, D, D, D, S, E); }
            GRID_BAR();
            REP(128) if (PHMASK & 128) phase_swa(BIG, a.in[7], a.in[22] + i * NQH, YY, F);
            GRID_BAR();
        }
        REP(256) if (PHMASK & 256) { const char* Bw = (l & 1) ? (const char*)(ws + WS_OWOUT_T) + (size_t)i * D * D * 2 : (const char*)(ws + WS_EWOUT_T) + (size_t)i * D * D * 2;
          pg8::SchedMain S{(const char*)YY, Bw, nullptr, (size_t)256 * D * 2, (size_t)256 * D * 2, 0, 0, 0, 64, 8, 64, 256, F.G, cid};
          pg8::EpiRes E{HB, rep_ ? DUMB : HB, SS + (size_t)(rep_ ? 13 : 3 * l + 1) * M, F.lds + RING_BYTES};
          pg8::gemm_phase<pg8::EpiRes, pg8::SchedMain, true>(F.lds, F.wave, D, D, D, S, E); }
        GRID_BAR();
        REP(512) if (PHMASK & 512) { pg8::SchedMain S{(const char*)HB, (const char*)(ws + WS_WS) + (size_t)l * 4 * 1024 * D * 2, (char*)BIG, (size_t)256 * D * 2, (size_t)256 * D * 2, (size_t)1024 * D * 2, (size_t)256 * 1024 * 2, 256 * 2, 64, 4, 16, 256, F.G, cid};
          pg8::EpiSoftmax E{SS + (size_t)(3 * l + 1) * M, 1024};
          pg8::gemm_phase<pg8::EpiSoftmax, pg8::SchedMain, false>(F.lds, F.wave, D, D, D, S, E); }
        GRID_BAR();
        REP(1024) if (PHMASK & 1024) { pg8::SchedMain S{(const char*)BIG, (const char*)(ws + WS_VW) + (size_t)l * 4 * D * 1024 * 2, nullptr, (size_t)256 * 1024 * 2, (size_t)256 * 1024 * 2, (size_t)D * 1024 * 2, 0, 0, 64, 8, 16, 256, F.G, cid};
          pg8::EpiRes E{HB, rep_ ? DUMB : HB, SS + (size_t)(rep_ ? 13 : 3 * l + 2) * M, F.lds + RING_BYTES};
          pg8::gemm_phase<pg8::EpiRes, pg8::SchedMain, true>(F.lds, F.wave, 1024, 1024, 1024, S, E); }
        GRID_BAR();
        REP(2048) if (PHMASK & 2048) { pg8::SchedMain S{(const char*)HB, (const char*)(ws + WS_WGU_T) + (size_t)l * NGU * D * 2, (char*)BIG, (size_t)256 * D * 2, (size_t)256 * D * 2, 0, (size_t)256 * DFF * 2, 128 * 2, 64, 44, 64, 128, F.G, cid};
          {
            PHASE_TID(F, tid, lane, gt); pg8::Unit fu; int nslots = 0, lastpm = -1;
            const float* cwp = a.in[29] + (size_t)l * 3 * DFF; const float* cbp = a.in[30] + (size_t)l * DFF; const i64* ssp = SS + (size_t)(3 * l + 2) * M;
            for (int ui = 0; ui < 12 && S.next(ui, fu); ++ui) {
                const int pm = fu.row0 >> 8;
                if (pm != lastpm && nslots < 3) { if (tid < 256) ((LAS float*)(F.lds + F1_RST_OFF))[nslots * 256 + tid] = rstd_of(ssp[pm * 256 + tid]); ++nslots; lastpm = pm; }
                if (tid == 0) ((LAS int*)(F.lds + F1_SLOT_OFF))[ui] = nslots - 1;
                const int vec = tid >> 7, ch = tid & 127;
                ((LAS float*)(F.lds + F1_CWT_OFF))[ui * 512 + tid] = (vec < 3 ? cwp[vec * DFF + fu.col0 + ch] : cbp[fu.col0 + ch]) * 1.4426950408889634f;
            }
            LDS_WAIT(); __syncthreads(); }
          pg8::EpiMLP E{F.lds, HG, HU};
          pg8::gemm_phase<pg8::EpiMLP, pg8::SchedMain, F1_ALIGN>(F.lds, F.wave, D, D, D, S, E);
          if (PROBE_KONLY & 2048) { pg8::EpiNull E0; pg8::gemm_phase<pg8::EpiNull, pg8::SchedMain, true>(F.lds, F.wave, D, D, D, S, E0); } }
        GRID_BAR();
        if (PHMASK & 4096) phase_mlp_fixup(HG, HU, a.in[29] + (size_t)l * 3 * DFF, a.in[30] + (size_t)l * DFF, BIG, F);
        GRID_BAR();
        REP(8192) if (PHMASK & 8192) { pg8::SchedMain S{(const char*)BIG, (const char*)(ws + WS_WDOWN_T) + (size_t)l * D * DFF * 2, nullptr, (size_t)256 * DFF * 2, (size_t)256 * DFF * 2, 0, 0, 0, 64, 8, 64, 256, F.G, cid, F2_WGM};
          pg8::EpiRes E{HB, rep_ ? DUMB : HB, SS + (size_t)(rep_ ? 13 : 3 * l + 3) * M, F.lds + RING_BYTES};
          pg8::gemm_phase<pg8::EpiRes, pg8::SchedMain, true>(F.lds, F.wave, DFF, DFF, DFF, S, E); }
        GRID_BAR();
    }
    if (PHMASK & 16384) phase_final(HB, SS + (size_t)12 * M, a.in[5], a.out, F);
#undef GRID_BAR
}

extern "C" void kernel_launch(void* const* d_in, const int* in_sizes, int n_in, void* d_out, int out_size, void* d_ws, size_t ws_size, hipStream_t stream) {
    static int grid = 0;
    if (grid == 0) {
        if (n_in != 32 || out_size != M * D || ws_size < WS_END) { fprintf(stderr, "kernel_launch: unexpected shapes (n_in %d out %d ws %zu)\n", n_in, out_size, ws_size); grid = -1; return; }
        int dev = 0, cus = 0, per_cu = 0;
        if (hipGetDevice(&dev) != hipSuccess || hipDeviceGetAttribute(&cus, hipDeviceAttributeMultiprocessorCount, dev) != hipSuccess) { grid = -1; return; }
        if (hipFuncSetAttribute((const void*)mega_fwd, hipFuncAttributeMaxDynamicSharedMemorySize, LDS_BYTES) != hipSuccess) { fprintf(stderr, "kernel_launch: hipFuncSetAttribute failed\n"); grid = -1; return; }
        if (hipOccupancyMaxActiveBlocksPerMultiprocessor(&per_cu, (const void*)mega_fwd, NTHR, LDS_BYTES) != hipSuccess || per_cu < 1) { fprintf(stderr, "kernel_launch: occupancy query says %d\n", per_cu); }
        (void)hipGetLastError();
        grid = cus;
    }
    if (grid < 0) return;
    if (hipMemsetAsync((char*)d_ws + WS_CTL, 0, CTL_ZERO_BYTES, stream) != hipSuccess) return;
    Args a{};
    for (int i = 0; i < 32; ++i) a.in[i] = (const float*)d_in[i];
    a.out = (float*)d_out; a.ws = (unsigned char*)d_ws;
    hipLaunchKernelGGL(mega_fwd, dim3(grid), dim3(NTHR), LDS_BYTES, stream, a);
}
```
